# Optimizing an MI355X kernel written in HIP

```python
import jax, jax.numpy as jnp
from jax import lax
import numpy as np

D_MODEL = 1024
BATCH = 8
SEQ = 2048
DEPTH = 2

CHUNK = 64
N_MEM = 256

SB_HEADS = 8
SB_HEAD_DIM = 64
SB_WIDTH = SB_HEADS * SB_HEAD_DIM
SB_BLOCK = 128
CV_WIDTH = D_MODEL // 2
CV_KERNEL = 31
SC_WIDTH = D_MODEL // 2
SC_KERNEL = 3
N_BRANCH = 3
OFF_SB = 0
OFF_CV = OFF_SB + 3 * SB_WIDTH
OFF_SC = OFF_CV + 2 * CV_WIDTH
OFF_GATE = OFF_SC + 3 * SC_WIDTH
IN_WIDTH = OFF_GATE + N_BRANCH * D_MODEL
XA_HEADS = 4
XA_HEAD_DIM = D_MODEL // XA_HEADS
PEER_HEADS = 8
N_KEYS = 128
N_EXPERTS = N_KEYS * N_KEYS
PEER_KEY_DIM = 128
PEER_TOPK = 16
PEER_BLOCK = 128

kernel_name = "hybrid_sb_conformer_shortconv_peer_block"


def rmsnorm(x, g, eps=1e-6):
    xf = x.astype(jnp.float32)
    y = xf * lax.rsqrt(jnp.mean(xf * xf, axis=-1, keepdims=True) + eps)
    return (y * g.astype(jnp.float32)).astype(x.dtype)


def layernorm(x, g, b, eps=1e-5):
    xf = x.astype(jnp.float32)
    mu = jnp.mean(xf, axis=-1, keepdims=True)
    var = jnp.mean(jnp.square(xf - mu), axis=-1, keepdims=True)
    y = (xf - mu) * lax.rsqrt(var + eps)
    return (y * g.astype(jnp.float32) + b.astype(jnp.float32)).astype(x.dtype)


def causal_depthwise_conv(x, w):
    k, c = w.shape
    return lax.conv_general_dilated(
        x, w[:, None, :], window_strides=(1,), padding=[(k - 1, 0)],
        dimension_numbers=("NWC", "WIO", "NWC"), feature_group_count=c)


def stick_breaking_attention(q, k, v):
    q = q.transpose(0, 2, 1, 3)
    k = k.transpose(0, 2, 1, 3)
    v = v.transpose(0, 2, 1, 3)
    seq = q.shape[2]
    scale = SB_HEAD_DIM ** -0.5
    outs = []
    for i in range(seq // SB_BLOCK):
        lo, hi = i * SB_BLOCK, (i + 1) * SB_BLOCK
        qb, kb, vb = q[:, :, lo:hi], k[:, :, :hi], v[:, :, :hi]
        z = jnp.einsum("bhqd,bhkd->bhqk", qb, kb).astype(jnp.float32) * scale
        t_pos = lo + jnp.arange(SB_BLOCK)
        s_pos = jnp.arange(hi)
        mask = s_pos[None, :] < t_pos[:, None]
        log_beta = jax.nn.log_sigmoid(z)
        log_keep = jnp.where(mask, log_beta - z, 0.0)
        after = lax.cumsum(log_keep, axis=3, reverse=True) - log_keep
        a = jnp.where(mask, jnp.exp(log_beta + after), 0.0)
        outs.append(jnp.einsum("bhqk,bhkd->bhqd", a.astype(vb.dtype), vb))
    o = jnp.concatenate(outs, axis=2)
    return o.transpose(0, 2, 1, 3)


def hybrid_mixer(xn, w_in, conv_dw_w, conv_dw_b, conv_ln_g, conv_ln_b, sc_w, w_branch, b_gate, w_out):
    bsz, seq, _ = xn.shape
    p = xn @ w_in
    qkv = p[..., OFF_SB:OFF_CV].reshape(bsz, seq, 3, SB_HEADS, SB_HEAD_DIM)
    y_sb = stick_breaking_attention(qkv[:, :, 0], qkv[:, :, 1], qkv[:, :, 2]).reshape(bsz, seq, SB_WIDTH)
    cv_val, cv_gate = jnp.split(p[..., OFF_CV:OFF_SC], 2, axis=-1)
    u = cv_val * jax.nn.sigmoid(cv_gate)
    u = causal_depthwise_conv(u, conv_dw_w) + conv_dw_b
    y_cv = jax.nn.silu(layernorm(u, conv_ln_g, conv_ln_b))
    g_b, g_c, x_in = jnp.split(p[..., OFF_SC:OFF_GATE], 3, axis=-1)
    y_sc = g_b * causal_depthwise_conv(g_c * x_in, sc_w)
    branches = jnp.stack([y_sb, y_cv, y_sc], axis=2)
    proj = jnp.einsum("bsnc,ncd->bsnd", branches, w_branch)
    gates = jax.nn.sigmoid((p[..., OFF_GATE:] + b_gate).reshape(bsz, seq, N_BRANCH, D_MODEL))
    merged = jnp.sum(gates * proj, axis=2)
    return merged @ w_out


def memory_cross_attention(hn, mem, g_mem, wq, wkv, wo):
    bsz, seq, _ = hn.shape
    n_mem = mem.shape[1]
    q = (hn @ wq).reshape(bsz, seq, XA_HEADS, XA_HEAD_DIM)
    kv = (rmsnorm(mem, g_mem) @ wkv).reshape(bsz, n_mem, 2, XA_HEADS, XA_HEAD_DIM)
    k, v = kv[:, :, 0], kv[:, :, 1]
    s = jnp.einsum("bshd,bmhd->bhsm", q, k).astype(jnp.float32) * (XA_HEAD_DIM ** -0.5)
    a = jax.nn.softmax(s, axis=-1).astype(v.dtype)
    o = jnp.einsum("bhsm,bmhd->bshd", a, v).reshape(bsz, seq, D_MODEL)
    return o @ wo


def peer_ffn(hn, wq, sub_keys, u, v):
    bsz, seq, d = hn.shape
    q = (hn @ wq).reshape(bsz, seq, PEER_HEADS, 2, PEER_KEY_DIM)
    sc = jnp.einsum("bshpc,hpnc->bshpn", q, sub_keys).astype(jnp.float32)
    v1, i1 = lax.top_k(sc[..., 0, :], PEER_TOPK)
    v2, i2 = lax.top_k(sc[..., 1, :], PEER_TOPK)
    cand = (v1[..., :, None] + v2[..., None, :]).reshape(bsz, seq, PEER_HEADS, PEER_TOPK * PEER_TOPK)
    top, ci = lax.top_k(cand, PEER_TOPK)
    e1 = jnp.take_along_axis(i1, ci // PEER_TOPK, axis=-1)
    e2 = jnp.take_along_axis(i2, ci % PEER_TOPK, axis=-1)
    idx = e1 * N_KEYS + e2
    g = jax.nn.softmax(top, axis=-1).astype(hn.dtype)
    n_tok = bsz * seq
    n_sel = PEER_HEADS * PEER_TOPK
    xt = hn.reshape(n_tok // PEER_BLOCK, PEER_BLOCK, d)
    it = idx.reshape(n_tok // PEER_BLOCK, PEER_BLOCK, n_sel)
    gt = g.reshape(n_tok // PEER_BLOCK, PEER_BLOCK, n_sel)

    def block(args):
        xb, ib, gb = args
        a = jnp.einsum("td,ted->te", xb, u[ib])
        w = gb * jax.nn.gelu(a, approximate=False)
        return jnp.einsum("te,ted->td", w, v[ib])

    return lax.map(block, (xt, it, gt)).reshape(bsz, seq, d)


def setup_inputs(seed: int = 0) -> dict:
    key = jax.random.key(seed)
    ks = jax.random.split(key, 24)
    f32 = jnp.float32
    nrm = lambda k, shape, s: jax.random.normal(k, shape, f32) * s
    gain = lambda k, shape: 1.0 + 0.01 * jax.random.normal(k, shape, f32)
    L, D = DEPTH, D_MODEL
    return {
        "x": jax.random.normal(ks[0], (BATCH, SEQ, D), f32),
        "mem": jax.random.normal(ks[1], (BATCH, N_MEM, D), f32),
        "norm_mix_g": gain(ks[2], (L, D)),
        "w_in": nrm(ks[3], (L, D, IN_WIDTH), D ** -0.5),
        "conv_dw_w": nrm(ks[4], (L, CV_KERNEL, CV_WIDTH), CV_KERNEL ** -0.5),
        "conv_dw_b": nrm(ks[5], (L, CV_WIDTH), 0.01),
        "conv_ln_g": gain(ks[6], (L, CV_WIDTH)),
        "conv_ln_b": nrm(ks[7], (L, CV_WIDTH), 0.01),
        "sc_w": nrm(ks[8], (L, SC_KERNEL, SC_WIDTH), SC_KERNEL ** -0.5),
        "w_branch": nrm(ks[9], (L, N_BRANCH, SB_WIDTH, D), SB_WIDTH ** -0.5),
        "b_gate": nrm(ks[10], (L, N_BRANCH * D), 0.01),
        "w_out": nrm(ks[11], (L, D, D), D ** -0.5),
        "norm_xa_g": gain(ks[12], (L, D)),
        "norm_mem_g": gain(ks[13], (L, D)),
        "xa_wq": nrm(ks[14], (L, D, D), D ** -0.5),
        "xa_wkv": nrm(ks[15], (L, D, 2 * D), D ** -0.5),
        "xa_wo": nrm(ks[16], (L, D, D), D ** -0.5),
        "norm_ffn_g": gain(ks[17], (L, D)),
        "peer_wq": nrm(ks[18], (L, D, PEER_HEADS * 2 * PEER_KEY_DIM), D ** -0.5),
        "peer_keys": nrm(ks[19], (L, PEER_HEADS, 2, N_KEYS, PEER_KEY_DIM), PEER_KEY_DIM ** -0.5),
        "peer_u": nrm(ks[20], (L, N_EXPERTS, D), D ** -0.5),
        "peer_v": nrm(ks[21], (L, N_EXPERTS, D), PEER_HEADS ** -0.5),
        "final_g": gain(ks[22], (D,)),
    }


def reference(x, mem, norm_mix_g, w_in, conv_dw_w, conv_dw_b, conv_ln_g, conv_ln_b, sc_w,
              w_branch, b_gate, w_out, norm_xa_g, norm_mem_g, xa_wq, xa_wkv, xa_wo,
              norm_ffn_g, peer_wq, peer_keys, peer_u, peer_v, final_g):
    h = x
    for l in range(DEPTH):
        h = h + hybrid_mixer(rmsnorm(h, norm_mix_g[l]), w_in[l], conv_dw_w[l], conv_dw_b[l],
                             conv_ln_g[l], conv_ln_b[l], sc_w[l], w_branch[l], b_gate[l], w_out[l])
        h = h + memory_cross_attention(rmsnorm(h, norm_xa_g[l]), mem, norm_mem_g[l],
                                       xa_wq[l], xa_wkv[l], xa_wo[l])
        h = h + peer_ffn(rmsnorm(h, norm_ffn_g[l]), peer_wq[l], peer_keys[l], peer_u[l], peer_v[l])
    return rmsnorm(h, final_g)
```

```cpp
#include <hip/hip_runtime.h>
#include <stdint.h>
#include <math.h>

constexpr int D = 1024, BATCH = 8, SEQ = 2048, T = BATCH * SEQ, DEPTH = 2, NMEM = 256, TM = BATCH * NMEM;
constexpr int INW = 7168, OFF_CV = 1536, OFF_SC = 2560, OFF_GATE = 4096;
constexpr int YW = 1536;
constexpr int NEXP = 16384, PQW = 2048;
constexpr int NT = 512;

typedef uint16_t bf16_t;
typedef short bf16x8 __attribute__((ext_vector_type(8)));
typedef float f32x4 __attribute__((ext_vector_type(4)));
typedef unsigned u32x4 __attribute__((ext_vector_type(4)));
typedef unsigned u32x2 __attribute__((ext_vector_type(2)));

constexpr size_t MiB = 1u << 20;
constexpr size_t WS_CTL = 0;
constexpr size_t WS_WIN = 1 * MiB;
constexpr size_t WS_WBR = 15 * MiB;
constexpr size_t WS_WOUT = 18 * MiB;
constexpr size_t WS_WXQ = 20 * MiB;
constexpr size_t WS_WKV = 22 * MiB;
constexpr size_t WS_WO = 26 * MiB;
constexpr size_t WS_WPQ = 28 * MiB;
constexpr size_t WS_KEYS = 32 * MiB;
constexpr size_t WS_U = 33 * MiB;
constexpr size_t WS_V = 65 * MiB;
constexpr size_t WS_HB = 97 * MiB;
constexpr size_t WS_RS = 129 * MiB;
constexpr size_t WS_MEMRS = 129 * MiB + 65536;
constexpr size_t WS_MEMB = 130 * MiB;
constexpr size_t WS_KV = 134 * MiB;
constexpr size_t WS_Y = 142 * MiB;
constexpr size_t WS_MERGED = 190 * MiB;
constexpr size_t WS_P = 222 * MiB;
constexpr size_t WS_XQ = 222 * MiB;
constexpr size_t WS_XO = 254 * MiB;
constexpr size_t WS_PQ = 286 * MiB;
constexpr size_t WS_PIDX = 350 * MiB;
constexpr size_t WS_PG = 358 * MiB;
constexpr size_t WS_END = 446 * MiB;

struct P {
    const float *x, *mem, *norm_mix_g, *w_in, *conv_dw_w, *conv_dw_b, *conv_ln_g, *conv_ln_b, *sc_w, *w_branch, *b_gate, *w_out,
        *norm_xa_g, *norm_mem_g, *xa_wq, *xa_wkv, *xa_wo, *norm_ffn_g, *peer_wq, *peer_keys, *peer_u, *peer_v, *final_g;
    float* out;
    unsigned char* ws;
};

__device__ __forceinline__ unsigned f2bf(float f) { unsigned u = __float_as_uint(f); return (u + 0x7fffu + ((u >> 16) & 1u)) >> 16; }
__device__ __forceinline__ unsigned pk2(float lo, float hi) { return f2bf(lo) | (f2bf(hi) << 16); }
__device__ __forceinline__ float bflo(unsigned w) { return __uint_as_float(w << 16); }
__device__ __forceinline__ float bfhi(unsigned w) { return __uint_as_float(w & 0xffff0000u); }
__device__ __forceinline__ float bf2f(bf16_t h) { return __uint_as_float(((unsigned)h) << 16); }
__device__ __forceinline__ float wave_sum(float v) {
#pragma unroll
    for (int o = 1; o < 64; o <<= 1) v += __shfl_xor(v, o);
    return v;
}
__device__ __forceinline__ float wave_max(float v) {
#pragma unroll
    for (int o = 1; o < 64; o <<= 1) v = fmaxf(v, __shfl_xor(v, o));
    return v;
}
__device__ __forceinline__ float sigmoidf_(float z) { return 1.0f / (1.0f + __expf(-z)); }

__device__ __forceinline__ void row_to_bf16_rs(const float* src, float* dst_f32, bf16_t* dst_bf, float* rs_out, int lane) {
    const f32x4* s4 = (const f32x4*)src + lane;
    f32x4 v[4]; float ss = 0.f;
#pragma unroll
    for (int j = 0; j < 4; ++j) { v[j] = s4[64 * j]; ss += v[j].x * v[j].x + v[j].y * v[j].y + v[j].z * v[j].z + v[j].w * v[j].w; }
    ss = wave_sum(ss);
    if (dst_f32) {
#pragma unroll
        for (int j = 0; j < 4; ++j) ((f32x4*)dst_f32 + lane)[64 * j] = v[j];
    }
#pragma unroll
    for (int j = 0; j < 4; ++j) { u32x2 w; w.x = pk2(v[j].x, v[j].y); w.y = pk2(v[j].z, v[j].w); ((u32x2*)dst_bf + lane)[64 * j] = w; }
    if (lane == 0) *rs_out = rsqrtf(ss * (1.0f / D) + 1e-6f);
}
__device__ void ph_prologue(const P& p, int bid, int nb) {
    const int tid = threadIdx.x, lane = tid & 63, wid = tid >> 6;
    const int gw = bid * 8 + wid, ngw = nb * 8;
    bf16_t* hb = (bf16_t*)(p.ws + WS_HB); float* rs = (float*)(p.ws + WS_RS);
    bf16_t* memb = (bf16_t*)(p.ws + WS_MEMB); float* mrs = (float*)(p.ws + WS_MEMRS);
    for (int r = gw; r < T; r += ngw) row_to_bf16_rs(p.x + (size_t)r * D, p.out + (size_t)r * D, hb + (size_t)r * D, rs + r, lane);
    for (int r = gw; r < TM; r += ngw) row_to_bf16_rs(p.mem + (size_t)r * D, nullptr, memb + (size_t)r * D, mrs + r, lane);
}
__device__ void ph_rowprep(const P& p, int bid, int nb) {
    const int tid = threadIdx.x, lane = tid & 63, wid = tid >> 6;
    const int gw = bid * 8 + wid, ngw = nb * 8;
    bf16_t* hb = (bf16_t*)(p.ws + WS_HB); float* rs = (float*)(p.ws + WS_RS);
    for (int r = gw; r < T; r += ngw) row_to_bf16_rs(p.out + (size_t)r * D, nullptr, hb + (size_t)r * D, rs + r, lane);
}

__device__ __forceinline__ void transpose_tile(const float* W, const float* g, bf16_t* Wt, int K, int N, int tile, float* lds) {
    const int tid = threadIdx.x, tx = tid & 63, ty = tid >> 6;
    const int tn = N / 64, kb = tile / tn, nbk = tile % tn, k0 = kb * 64, n0 = nbk * 64;
#pragma unroll
    for (int i = 0; i < 8; ++i) { const int r = ty + 8 * i; float v = W[(size_t)(k0 + r) * N + n0 + tx]; if (g) v *= g[k0 + r]; lds[r * 65 + tx] = v; }
    __syncthreads();
#pragma unroll
    for (int i = 0; i < 8; ++i) { const int n = ty + 8 * i; Wt[(size_t)(n0 + n) * K + k0 + tx] = (bf16_t)f2bf(lds[tx * 65 + n]); }
    __syncthreads();
}
__device__ void ph_prep_weights(const P& p, int l, int bid, int nb, float* lds) {
    unsigned char* ws = p.ws;
    constexpr int T0 = 16 * 112, T1 = 8 * 16, T4 = 256, T6 = 16 * 32;
    constexpr int NTILES = T0 + 3 * T1 + T4 + T4 + T6 + T4 + T6;
    for (int it = bid; it < NTILES; it += nb) {
        int r = it;
        if (r < T0) { transpose_tile(p.w_in + (size_t)l * D * INW, p.norm_mix_g + l * D, (bf16_t*)(ws + WS_WIN), D, INW, r, lds); continue; } r -= T0;
        if (r < 3 * T1) { const int b = r / T1; transpose_tile(p.w_branch + ((size_t)l * 3 + b) * 512 * D, nullptr, (bf16_t*)(ws + WS_WBR) + (size_t)b * 1024 * 512, 512, D, r % T1, lds); continue; } r -= 3 * T1;
        if (r < T4) { transpose_tile(p.w_out + (size_t)l * D * D, nullptr, (bf16_t*)(ws + WS_WOUT), D, D, r, lds); continue; } r -= T4;
        if (r < T4) { transpose_tile(p.xa_wq + (size_t)l * D * D, p.norm_xa_g + l * D, (bf16_t*)(ws + WS_WXQ), D, D, r, lds); continue; } r -= T4;
        if (r < T6) { transpose_tile(p.xa_wkv + (size_t)l * D * 2 * D, p.norm_mem_g + l * D, (bf16_t*)(ws + WS_WKV), D, 2 * D, r, lds); continue; } r -= T6;
        if (r < T4) { transpose_tile(p.xa_wo + (size_t)l * D * D, nullptr, (bf16_t*)(ws + WS_WO), D, D, r, lds); continue; } r -= T4;
        transpose_tile(p.peer_wq + (size_t)l * D * PQW, p.norm_ffn_g + l * D, (bf16_t*)(ws + WS_WPQ), D, PQW, r, lds);
    }
    const size_t gt = (size_t)bid * NT + threadIdx.x, gn = (size_t)nb * NT;
    const f32x4* u4 = (const f32x4*)(p.peer_u + (size_t)l * NEXP * D); const f32x4* v4 = (const f32x4*)(p.peer_v + (size_t)l * NEXP * D);
    const f32x4* g4 = (const f32x4*)(p.norm_ffn_g + l * D);
    u32x2* ub = (u32x2*)(ws + WS_U); u32x2* vb = (u32x2*)(ws + WS_V);
    for (size_t i = gt; i < (size_t)NEXP * D / 4; i += gn) {
        const f32x4 a = u4[i], g = g4[i & 255], b = v4[i];
        u32x2 w; w.x = pk2(a.x * g.x, a.y * g.y); w.y = pk2(a.z * g.z, a.w * g.w); ub[i] = w;
        u32x2 z; z.x = pk2(b.x, b.y); z.y = pk2(b.z, b.w); vb[i] = z;
    }
    const f32x4* k4 = (const f32x4*)(p.peer_keys + (size_t)l * 8 * 2 * 128 * 128); u32x2* kb = (u32x2*)(ws + WS_KEYS);
    for (size_t i = gt; i < (size_t)8 * 2 * 128 * 128 / 4; i += gn) { const f32x4 a = k4[i]; u32x2 w; w.x = pk2(a.x, a.y); w.y = pk2(a.z, a.w); kb[i] = w; }
}

#define MFMA16(a, b, c) __builtin_amdgcn_mfma_f32_16x16x32_bf16((a), (b), (c), 0, 0, 0)
template <class Epi>
__device__ __forceinline__ void gemm_direct(const bf16_t* A, int lda, const bf16_t* Bt, int ldb, int M, int N, int K, const Epi& epi, int bid, int nb) {
    const int tid = threadIdx.x, lane = tid & 63, wid = tid >> 6, fr = lane & 15, fq = lane >> 4, wr = wid >> 2, wc = wid & 3;
    const int tn = N / 256, nunits = (M / 128) * tn;
    for (int unit = bid; unit < nunits; unit += nb) {
        const int pm = unit / tn, pn = unit % tn;
        const int row0 = pm * 128 + wr * 64, col0 = pn * 256 + wc * 64;
        f32x4 acc[4][4];
#pragma unroll
        for (int i = 0; i < 4; ++i)
#pragma unroll
            for (int j = 0; j < 4; ++j) acc[i][j] = (f32x4){0.f, 0.f, 0.f, 0.f};
        const bf16_t* ap = A + (size_t)(row0 + fr) * lda + fq * 8;
        const bf16_t* bp = Bt + (size_t)(col0 + fr) * ldb + fq * 8;
        for (int k0 = 0; k0 < K; k0 += 32) {
            bf16x8 a[4], b[4];
#pragma unroll
            for (int i = 0; i < 4; ++i) { a[i] = *(const bf16x8*)(ap + (size_t)i * 16 * lda + k0); b[i] = *(const bf16x8*)(bp + (size_t)i * 16 * ldb + k0); }
#pragma unroll
            for (int i = 0; i < 4; ++i)
#pragma unroll
                for (int j = 0; j < 4; ++j) acc[i][j] = MFMA16(b[j], a[i], acc[i][j]);
        }
#pragma unroll
        for (int i = 0; i < 4; ++i)
#pragma unroll
            for (int j = 0; j < 4; ++j) epi(row0 + i * 16 + fr, col0 + j * 16 + fq * 4, acc[i][j]);
    }
}
struct EpiScaleBf16 {
    bf16_t* O; int ldo; const float* rs; int ncol0; float s0;
    __device__ __forceinline__ void operator()(int m, int n0, f32x4 v) const {
        float s = rs[m]; if (n0 < ncol0) s *= s0;
        u32x2 w; w.x = pk2(v.x * s, v.y * s); w.y = pk2(v.z * s, v.w * s);
        *(u32x2*)(O + (size_t)m * ldo + n0) = w;
    }
};
struct EpiResidual {
    float* H;
    __device__ __forceinline__ void operator()(int m, int n0, f32x4 v) const { f32x4* q = (f32x4*)(H + (size_t)m * D + n0); f32x4 o = *q; o += v; *q = o; }
};

__device__ void ph_gemm_p(const P& p, int bid, int nb) {
    EpiScaleBf16 e{(bf16_t*)(p.ws + WS_P), INW, (const float*)(p.ws + WS_RS), 512, 0.125f};
    gemm_direct(( const bf16_t*)(p.ws + WS_HB), D, (const bf16_t*)(p.ws + WS_WIN), D, T, INW, D, e, bid, nb);
}
__device__ void ph_gemm_kv(const P& p, int bid, int nb) {
    EpiScaleBf16 e{(bf16_t*)(p.ws + WS_KV), 2 * D, (const float*)(p.ws + WS_MEMRS), 0, 1.f};
    gemm_direct((const bf16_t*)(p.ws + WS_MEMB), D, (const bf16_t*)(p.ws + WS_WKV), D, TM, 2 * D, D, e, bid, nb);
}
__device__ void ph_gemm_wout(const P& p, int bid, int nb) {
    EpiResidual e{p.out};
    gemm_direct((const bf16_t*)(p.ws + WS_MERGED), D, (const bf16_t*)(p.ws + WS_WOUT), D, T, D, D, e, bid, nb);
}
__device__ void ph_gemm_xq(const P& p, int bid, int nb) {
    EpiScaleBf16 e{(bf16_t*)(p.ws + WS_XQ), D, (const float*)(p.ws + WS_RS), D, 0.0625f};
    gemm_direct((const bf16_t*)(p.ws + WS_HB), D, (const bf16_t*)(p.ws + WS_WXQ), D, T, D, D, e, bid, nb);
}
__device__ void ph_gemm_wo(const P& p, int bid, int nb) {
    EpiResidual e{p.out};
    gemm_direct((const bf16_t*)(p.ws + WS_XO), D, (const bf16_t*)(p.ws + WS_WO), D, T, D, D, e, bid, nb);
}
__device__ void ph_gemm_pq(const P& p, int bid, int nb) {
    EpiScaleBf16 e{(bf16_t*)(p.ws + WS_PQ), PQW, (const float*)(p.ws + WS_RS), 0, 1.f};
    gemm_direct((const bf16_t*)(p.ws + WS_HB), D, (const bf16_t*)(p.ws + WS_WPQ), D, T, PQW, D, e, bid, nb);
}
__device__ void ph_merged(const P& p, int l, int bid, int nb) {
    const int tid = threadIdx.x, lane = tid & 63, wid = tid >> 6, fr = lane & 15, fq = lane >> 4, wr = wid >> 2, wc = wid & 3;
    const bf16_t* Y = (const bf16_t*)(p.ws + WS_Y); const bf16_t* Wb = (const bf16_t*)(p.ws + WS_WBR); const bf16_t* pp = (const bf16_t*)(p.ws + WS_P);
    bf16_t* Mg = (bf16_t*)(p.ws + WS_MERGED); const float* bg = p.b_gate + (size_t)l * 3 * D;
    constexpr int tn = D / 256, nunits = (T / 128) * tn;
    for (int unit = bid; unit < nunits; unit += nb) {
        const int pm = unit / tn, pn = unit % tn;
        const int row0 = pm * 128 + wr * 64, col0 = pn * 256 + wc * 64;
        f32x4 tot[4][4];
#pragma unroll
        for (int i = 0; i < 4; ++i)
#pragma unroll
            for (int j = 0; j < 4; ++j) tot[i][j] = (f32x4){0.f, 0.f, 0.f, 0.f};
        for (int b = 0; b < 3; ++b) {
            f32x4 acc[4][4];
#pragma unroll
            for (int i = 0; i < 4; ++i)
#pragma unroll
                for (int j = 0; j < 4; ++j) acc[i][j] = (f32x4){0.f, 0.f, 0.f, 0.f};
            const bf16_t* ap = Y + (size_t)(row0 + fr) * YW + b * 512 + fq * 8;
            const bf16_t* bp = Wb + (size_t)b * 1024 * 512 + (size_t)(col0 + fr) * 512 + fq * 8;
            for (int k0 = 0; k0 < 512; k0 += 32) {
                bf16x8 a[4], bb[4];
#pragma unroll
                for (int i = 0; i < 4; ++i) { a[i] = *(const bf16x8*)(ap + (size_t)i * 16 * YW + k0); bb[i] = *(const bf16x8*)(bp + (size_t)i * 16 * 512 + k0); }
#pragma unroll
                for (int i = 0; i < 4; ++i)
#pragma unroll
                    for (int j = 0; j < 4; ++j) acc[i][j] = MFMA16(bb[j], a[i], acc[i][j]);
            }
#pragma unroll
            for (int i = 0; i < 4; ++i)
#pragma unroll
                for (int j = 0; j < 4; ++j) {
                    const int m = row0 + i * 16 + fr, n0 = col0 + j * 16 + fq * 4;
                    const u32x2 gz = *(const u32x2*)(pp + (size_t)m * INW + OFF_GATE + b * D + n0);
                    const f32x4 bv = *(const f32x4*)(bg + b * D + n0);
                    tot[i][j].x += sigmoidf_(bflo(gz.x) + bv.x) * acc[i][j].x;
                    tot[i][j].y += sigmoidf_(bfhi(gz.x) + bv.y) * acc[i][j].y;
                    tot[i][j].z += sigmoidf_(bflo(gz.y) + bv.z) * acc[i][j].z;
                    tot[i][j].w += sigmoidf_(bfhi(gz.y) + bv.w) * acc[i][j].w;
                }
        }
#pragma unroll
        for (int i = 0; i < 4; ++i)
#pragma unroll
            for (int j = 0; j < 4; ++j) {
                const int m = row0 + i * 16 + fr, n0 = col0 + j * 16 + fq * 4;
                u32x2 w; w.x = pk2(tot[i][j].x, tot[i][j].y); w.y = pk2(tot[i][j].z, tot[i][j].w);
                *(u32x2*)(Mg + (size_t)m * D + n0) = w;
            }
    }
}

__device__ void ph_sb_attn(const P& p, int bid, int nb) {
    const int tid = threadIdx.x, lane = tid & 63, wid = __builtin_amdgcn_readfirstlane(tid >> 6);
    const bf16_t* pp = (const bf16_t*)(p.ws + WS_P); bf16_t* Y = (bf16_t*)(p.ws + WS_Y);
    const int gw = bid * 8 + wid, ngw = nb * 8;
    for (int task = gw; task < 64 * 32; task += ngw) {
        const int tb = 31 - (task >> 6), bh = task & 63, b = bh >> 3, h = bh & 7;
        const int t = tb * 64 + lane;
        float q[64], o[64];
        {
            const u32x4* qp = (const u32x4*)(pp + (size_t)(b * SEQ + t) * INW + h * 64);
#pragma unroll
            for (int i = 0; i < 8; ++i) { const u32x4 w = qp[i]; q[8 * i] = bflo(w.x); q[8 * i + 1] = bfhi(w.x); q[8 * i + 2] = bflo(w.y); q[8 * i + 3] = bfhi(w.y);
                q[8 * i + 4] = bflo(w.z); q[8 * i + 5] = bfhi(w.z); q[8 * i + 6] = bflo(w.w); q[8 * i + 7] = bfhi(w.w); }
        }
#pragma unroll
        for (int i = 0; i < 64; ++i) o[i] = 0.f;
        float carry = 0.f;
        for (int s = tb * 64 + 62; s >= 0; --s) {
            const unsigned* kp = (const unsigned*)(pp + (size_t)(b * SEQ + s) * INW + 512 + h * 64);
            const unsigned* vp = kp + 256;
            float z0 = 0.f, z1 = 0.f;
#pragma unroll
            for (int i = 0; i < 32; ++i) { const unsigned w = kp[i]; z0 = fmaf(q[2 * i], bflo(w), z0); z1 = fmaf(q[2 * i + 1], bfhi(w), z1); }
            const float z = z0 + z1;
            const bool valid = s < t;
            const float sp = fmaxf(z, 0.f) + log1pf(expf(-fabsf(z)));
            const float a = valid ? expf((z - sp) + carry) : 0.f;
            carry += valid ? -sp : 0.f;
#pragma unroll
            for (int i = 0; i < 32; ++i) { const unsigned w = vp[i]; o[2 * i] = fmaf(a, bflo(w), o[2 * i]); o[2 * i + 1] = fmaf(a, bfhi(w), o[2 * i + 1]); }
            if (__all(carry < -110.f)) break;
        }
        u32x4* yp = (u32x4*)(Y + (size_t)(b * SEQ + t) * YW + h * 64);
#pragma unroll
        for (int i = 0; i < 8; ++i) { u32x4 w; w.x = pk2(o[8 * i], o[8 * i + 1]); w.y = pk2(o[8 * i + 2], o[8 * i + 3]); w.z = pk2(o[8 * i + 4], o[8 * i + 5]); w.w = pk2(o[8 * i + 6], o[8 * i + 7]); yp[i] = w; }
    }
}
__device__ void ph_conv(const P& p, int l, int bid, int nb, float* lds) {
    const int tid = threadIdx.x, lane = tid & 63, wid = tid >> 6, c = tid;
    const bf16_t* pp = (const bf16_t*)(p.ws + WS_P); bf16_t* Y = (bf16_t*)(p.ws + WS_Y);
    const float* dw = p.conv_dw_w + (size_t)l * 31 * 512; const float* scw = p.sc_w + (size_t)l * 3 * 512;
    const float db = p.conv_dw_b[l * 512 + c], lg = p.conv_ln_g[l * 512 + c], lb = p.conv_ln_b[l * 512 + c];
    for (int tok = bid; tok < T; tok += nb) {
        const int t = tok % SEQ;
        float acc = db;
        for (int j = 0; j < 31; ++j) {
            const int tt = t - 30 + j;
            if (tt >= 0) {
                const bf16_t* r = pp + (size_t)(tok - 30 + j) * INW;
                const float val = bf2f(r[OFF_CV + c]), gt = bf2f(r[OFF_CV + 512 + c]);
                acc = fmaf(dw[j * 512 + c], val * sigmoidf_(gt), acc);
            }
        }
        float s = wave_sum(acc);
        if (lane == 0) lds[wid] = s;
        __syncthreads();
        float mean = 0.f;
#pragma unroll
        for (int i = 0; i < 8; ++i) mean += lds[i];
        mean *= (1.0f / 512.0f);
        const float d = acc - mean;
        float s2 = wave_sum(d * d);
        if (lane == 0) lds[8 + wid] = s2;
        __syncthreads();
        float var = 0.f;
#pragma unroll
        for (int i = 0; i < 8; ++i) var += lds[8 + i];
        var *= (1.0f / 512.0f);
        const float yv = d * rsqrtf(var + 1e-5f) * lg + lb;
        Y[(size_t)tok * YW + 512 + c] = (bf16_t)f2bf(yv * sigmoidf_(yv));
        float sc = 0.f;
#pragma unroll
        for (int j = 0; j < 3; ++j) {
            const int tt = t - 2 + j;
            if (tt >= 0) { const bf16_t* r = pp + (size_t)(tok - 2 + j) * INW; sc = fmaf(scw[j * 512 + c], bf2f(r[OFF_SC + 512 + c]) * bf2f(r[OFF_SC + 1024 + c]), sc); }
        }
        Y[(size_t)tok * YW + 1024 + c] = (bf16_t)f2bf(bf2f(pp[(size_t)tok * INW + OFF_SC + c]) * sc);
        __syncthreads();
    }
}

__device__ void ph_xattn(const P& p, int bid, int nb, float* lds) {
    const int tid = threadIdx.x, lane = tid & 63, wid = tid >> 6;
    const bf16_t* XQ = (const bf16_t*)(p.ws + WS_XQ); const bf16_t* KV = (const bf16_t*)(p.ws + WS_KV); bf16_t* XO = (bf16_t*)(p.ws + WS_XO);
    float* qs = lds + wid * 512; float* as = qs + 256;
    const int gw = bid * 8 + wid, ngw = nb * 8;
    for (int task = gw; task < T * 4; task += ngw) {
        const int tok = task >> 2, hd = task & 3, b = tok / SEQ;
        { const u32x2 w = *(const u32x2*)(XQ + (size_t)tok * D + hd * 256 + lane * 4); qs[lane * 4] = bflo(w.x); qs[lane * 4 + 1] = bfhi(w.x); qs[lane * 4 + 2] = bflo(w.y); qs[lane * 4 + 3] = bfhi(w.y); }
        __builtin_amdgcn_s_waitcnt(0);
        float sc[4];
#pragma unroll
        for (int j = 0; j < 4; ++j) {
            const int m = lane + 64 * j;
            const u32x4* kp = (const u32x4*)(KV + (size_t)(b * NMEM + m) * 2 * D + hd * 256);
            float z = 0.f;
#pragma unroll 4
            for (int i = 0; i < 32; ++i) { const u32x4 w = kp[i]; const float* qq = qs + 8 * i;
                z = fmaf(qq[0], bflo(w.x), z); z = fmaf(qq[1], bfhi(w.x), z); z = fmaf(qq[2], bflo(w.y), z); z = fmaf(qq[3], bfhi(w.y), z);
                z = fmaf(qq[4], bflo(w.z), z); z = fmaf(qq[5], bfhi(w.z), z); z = fmaf(qq[6], bflo(w.w), z); z = fmaf(qq[7], bfhi(w.w), z); }
            sc[j] = z;
        }
        const float mx = wave_max(fmaxf(fmaxf(sc[0], sc[1]), fmaxf(sc[2], sc[3])));
        float e[4], es = 0.f;
#pragma unroll
        for (int j = 0; j < 4; ++j) { e[j] = __expf(sc[j] - mx); es += e[j]; }
        es = wave_sum(es);
        const float inv = 1.0f / es;
#pragma unroll
        for (int j = 0; j < 4; ++j) as[lane + 64 * j] = e[j] * inv;
        __builtin_amdgcn_s_waitcnt(0);
        float o0 = 0.f, o1 = 0.f, o2 = 0.f, o3 = 0.f;
        const bf16_t* vb = KV + (size_t)(b * NMEM) * 2 * D + D + hd * 256 + lane * 4;
        for (int m = 0; m < NMEM; ++m) { const u32x2 w = *(const u32x2*)(vb + (size_t)m * 2 * D); const float a = as[m];
            o0 = fmaf(a, bflo(w.x), o0); o1 = fmaf(a, bfhi(w.x), o1); o2 = fmaf(a, bflo(w.y), o2); o3 = fmaf(a, bfhi(w.y), o3); }
        u32x2 w; w.x = pk2(o0, o1); w.y = pk2(o2, o3);
        *(u32x2*)(XO + (size_t)tok * D + hd * 256 + lane * 4) = w;
    }
}

__device__ __forceinline__ void wave_argmax(float& v, int& i) {
#pragma unroll
    for (int o = 1; o < 64; o <<= 1) { const float ov = __shfl_xor(v, o); const int oi = __shfl_xor(i, o); if (ov > v || (ov == v && oi < i)) { v = ov; i = oi; } }
}
__device__ void ph_peer_score(const P& p, int bid, int nb, float* lds) {
    const int tid = threadIdx.x, lane = tid & 63, wid = tid >> 6;
    const bf16_t* PQ = (const bf16_t*)(p.ws + WS_PQ); const bf16_t* KEYS = (const bf16_t*)(p.ws + WS_KEYS);
    int* PIDX = (int*)(p.ws + WS_PIDX); float* PG = (float*)(p.ws + WS_PG);
    float* qs = lds + wid * 512;
    float* sv = qs + 256;
    int* si = (int*)(sv + 32);
    float* st = sv + 64;
    int* sci = (int*)(sv + 80);
    const int gw = bid * 8 + wid, ngw = nb * 8;
    for (int task = gw; task < T * 8; task += ngw) {
        const int tok = task >> 3, h = task & 7;
        { const u32x2 w = *(const u32x2*)(PQ + (size_t)tok * PQW + h * 256 + lane * 4); qs[lane * 4] = bflo(w.x); qs[lane * 4 + 1] = bfhi(w.x); qs[lane * 4 + 2] = bflo(w.y); qs[lane * 4 + 3] = bfhi(w.y); }
        __builtin_amdgcn_s_waitcnt(0);
#pragma unroll
        for (int pp = 0; pp < 2; ++pp) {
            float a[2];
#pragma unroll
            for (int jj = 0; jj < 2; ++jj) {
                const int n = lane + 64 * jj;
                const u32x4* kp = (const u32x4*)(KEYS + ((size_t)(h * 2 + pp) * 128 + n) * 128);
                const float* qq = qs + pp * 128; float z = 0.f;
#pragma unroll 4
                for (int i = 0; i < 16; ++i) { const u32x4 w = kp[i]; const float* q8 = qq + 8 * i;
                    z = fmaf(q8[0], bflo(w.x), z); z = fmaf(q8[1], bfhi(w.x), z); z = fmaf(q8[2], bflo(w.y), z); z = fmaf(q8[3], bfhi(w.y), z);
                    z = fmaf(q8[4], bflo(w.z), z); z = fmaf(q8[5], bfhi(w.z), z); z = fmaf(q8[6], bflo(w.w), z); z = fmaf(q8[7], bfhi(w.w), z); }
                a[jj] = z;
            }
#pragma unroll 1
            for (int k = 0; k < 16; ++k) {
                float v; int i;
                if (a[0] >= a[1]) { v = a[0]; i = lane; } else { v = a[1]; i = lane + 64; }
                wave_argmax(v, i);
                if (i == lane) a[0] = -INFINITY;
                if (i == lane + 64) a[1] = -INFINITY;
                if (lane == 0) { sv[pp * 16 + k] = v; si[pp * 16 + k] = i; }
            }
        }
        __builtin_amdgcn_s_waitcnt(0);
        float cnd[4];
#pragma unroll
        for (int j = 0; j < 4; ++j) { const int ci = lane * 4 + j; cnd[j] = sv[ci >> 4] + sv[16 + (ci & 15)]; }
#pragma unroll 1
        for (int k = 0; k < 16; ++k) {
            float v = cnd[0]; int i = lane * 4;
#pragma unroll
            for (int j = 1; j < 4; ++j) if (cnd[j] > v) { v = cnd[j]; i = lane * 4 + j; }
            wave_argmax(v, i);
#pragma unroll
            for (int j = 0; j < 4; ++j) if (i == lane * 4 + j) cnd[j] = -INFINITY;
            if (lane == 0) { st[k] = v; sci[k] = i; }
        }
        __builtin_amdgcn_s_waitcnt(0);
        if (lane < 16) {
            const float mx = st[0]; float sum = 0.f;
#pragma unroll
            for (int k = 0; k < 16; ++k) sum += __expf(st[k] - mx);
            const int ci = sci[lane];
            PIDX[(size_t)tok * 128 + h * 16 + lane] = si[ci >> 4] * 128 + si[16 + (ci & 15)];
            PG[(size_t)tok * 128 + h * 16 + lane] = __expf(st[lane] - mx) / sum;
        }
        __builtin_amdgcn_s_waitcnt(0);
    }
}
__device__ void ph_peer_gather(const P& p, int l, int bid, int nb) {
    const int tid = threadIdx.x, lane = tid & 63, wid = __builtin_amdgcn_readfirstlane(tid >> 6);
    const bf16_t* HB = (const bf16_t*)(p.ws + WS_HB); float* RS = (float*)(p.ws + WS_RS);
    const bf16_t* U = (const bf16_t*)(p.ws + WS_U); const bf16_t* V = (const bf16_t*)(p.ws + WS_V);
    const int* PIDX = (const int*)(p.ws + WS_PIDX); const float* PG = (const float*)(p.ws + WS_PG);
    const int gw = bid * 8 + wid, ngw = nb * 8;
    for (int tok = gw; tok < T; tok += ngw) {
        float xv[16];
        {
            const u32x4 w0 = *(const u32x4*)(HB + (size_t)tok * D + lane * 8), w1 = *(const u32x4*)(HB + (size_t)tok * D + 512 + lane * 8);
            xv[0] = bflo(w0.x); xv[1] = bfhi(w0.x); xv[2] = bflo(w0.y); xv[3] = bfhi(w0.y); xv[4] = bflo(w0.z); xv[5] = bfhi(w0.z); xv[6] = bflo(w0.w); xv[7] = bfhi(w0.w);
            xv[8] = bflo(w1.x); xv[9] = bfhi(w1.x); xv[10] = bflo(w1.y); xv[11] = bfhi(w1.y); xv[12] = bflo(w1.z); xv[13] = bfhi(w1.z); xv[14] = bflo(w1.w); xv[15] = bfhi(w1.w);
        }
        const float rs = RS[tok];
        float o[16];
#pragma unroll
        for (int i = 0; i < 16; ++i) o[i] = 0.f;
        for (int e = 0; e < 128; ++e) {
            const int idx = __builtin_amdgcn_readfirstlane(PIDX[(size_t)tok * 128 + e]);
            const float g = PG[(size_t)tok * 128 + e];
            const u32x4 u0 = *(const u32x4*)(U + (size_t)idx * D + lane * 8), u1 = *(const u32x4*)(U + (size_t)idx * D + 512 + lane * 8);
            float d = xv[0] * bflo(u0.x);
            d = fmaf(xv[1], bfhi(u0.x), d); d = fmaf(xv[2], bflo(u0.y), d); d = fmaf(xv[3], bfhi(u0.y), d); d = fmaf(xv[4], bflo(u0.z), d); d = fmaf(xv[5], bfhi(u0.z), d);
            d = fmaf(xv[6], bflo(u0.w), d); d = fmaf(xv[7], bfhi(u0.w), d); d = fmaf(xv[8], bflo(u1.x), d); d = fmaf(xv[9], bfhi(u1.x), d); d = fmaf(xv[10], bflo(u1.y), d);
            d = fmaf(xv[11], bfhi(u1.y), d); d = fmaf(xv[12], bflo(u1.z), d); d = fmaf(xv[13], bfhi(u1.z), d); d = fmaf(xv[14], bflo(u1.w), d); d = fmaf(xv[15], bfhi(u1.w), d);
            const float a = wave_sum(d) * rs;
            const float w = g * 0.5f * a * (1.0f + erff(a * 0.70710678118654752f));
            const u32x4 v0 = *(const u32x4*)(V + (size_t)idx * D + lane * 8), v1 = *(const u32x4*)(V + (size_t)idx * D + 512 + lane * 8);
            o[0] = fmaf(w, bflo(v0.x), o[0]); o[1] = fmaf(w, bfhi(v0.x), o[1]); o[2] = fmaf(w, bflo(v0.y), o[2]); o[3] = fmaf(w, bfhi(v0.y), o[3]);
            o[4] = fmaf(w, bflo(v0.z), o[4]); o[5] = fmaf(w, bfhi(v0.z), o[5]); o[6] = fmaf(w, bflo(v0.w), o[6]); o[7] = fmaf(w, bfhi(v0.w), o[7]);
            o[8] = fmaf(w, bflo(v1.x), o[8]); o[9] = fmaf(w, bfhi(v1.x), o[9]); o[10] = fmaf(w, bflo(v1.y), o[10]); o[11] = fmaf(w, bfhi(v1.y), o[11]);
            o[12] = fmaf(w, bflo(v1.z), o[12]); o[13] = fmaf(w, bfhi(v1.z), o[13]); o[14] = fmaf(w, bflo(v1.w), o[14]); o[15] = fmaf(w, bfhi(v1.w), o[15]);
        }
        float* hrow = p.out + (size_t)tok * D;
        f32x4 h0 = *(f32x4*)(hrow + lane * 8), h1 = *(f32x4*)(hrow + lane * 8 + 4), h2 = *(f32x4*)(hrow + 512 + lane * 8), h3 = *(f32x4*)(hrow + 512 + lane * 8 + 4);
        h0.x += o[0]; h0.y += o[1]; h0.z += o[2]; h0.w += o[3]; h1.x += o[4]; h1.y += o[5]; h1.z += o[6]; h1.w += o[7];
        h2.x += o[8]; h2.y += o[9]; h2.z += o[10]; h2.w += o[11]; h3.x += o[12]; h3.y += o[13]; h3.z += o[14]; h3.w += o[15];
        float ss = h0.x * h0.x + h0.y * h0.y + h0.z * h0.z + h0.w * h0.w + h1.x * h1.x + h1.y * h1.y + h1.z * h1.z + h1.w * h1.w
                 + h2.x * h2.x + h2.y * h2.y + h2.z * h2.z + h2.w * h2.w + h3.x * h3.x + h3.y * h3.y + h3.z * h3.z + h3.w * h3.w;
        ss = wave_sum(ss);
        const float nrs = rsqrtf(ss * (1.0f / D) + 1e-6f);
        if (l == DEPTH - 1) {
            const f32x4 g0 = *(const f32x4*)(p.final_g + lane * 8), g1 = *(const f32x4*)(p.final_g + lane * 8 + 4), g2 = *(const f32x4*)(p.final_g + 512 + lane * 8), g3 = *(const f32x4*)(p.final_g + 512 + lane * 8 + 4);
            *(f32x4*)(hrow + lane * 8) = h0 * nrs * g0; *(f32x4*)(hrow + lane * 8 + 4) = h1 * nrs * g1;
            *(f32x4*)(hrow + 512 + lane * 8) = h2 * nrs * g2; *(f32x4*)(hrow + 512 + lane * 8 + 4) = h3 * nrs * g3;
        } else {
            *(f32x4*)(hrow + lane * 8) = h0; *(f32x4*)(hrow + lane * 8 + 4) = h1; *(f32x4*)(hrow + 512 + lane * 8) = h2; *(f32x4*)(hrow + 512 + lane * 8 + 4) = h3;
            u32x4 w0, w1;
            w0.x = pk2(h0.x, h0.y); w0.y = pk2(h0.z, h0.w); w0.z = pk2(h1.x, h1.y); w0.w = pk2(h1.z, h1.w);
            w1.x = pk2(h2.x, h2.y); w1.y = pk2(h2.z, h2.w); w1.z = pk2(h3.x, h3.y); w1.w = pk2(h3.z, h3.w);
            bf16_t* hb = (bf16_t*)(p.ws + WS_HB) + (size_t)tok * D;
            *(u32x4*)(hb + lane * 8) = w0; *(u32x4*)(hb + 512 + lane * 8) = w1;
            if (lane == 0) RS[tok] = nrs;
        }
    }
}

enum { PH_PROLOGUE, PH_PREPW, PH_GEMM_P, PH_GEMM_KV, PH_SB, PH_CONV, PH_MERGED, PH_WOUT, PH_ROWPREP, PH_XQ, PH_XATTN, PH_WO, PH_PQ, PH_PSCORE, PH_PGATHER };
template <int PH>
__global__ void __launch_bounds__(NT) k_phase(P p, int l) {
    __shared__ float lds[4160];
    const int bid = blockIdx.x, nb = gridDim.x;
    if (PH == PH_PROLOGUE) ph_prologue(p, bid, nb);
    if (PH == PH_PREPW) ph_prep_weights(p, l, bid, nb, lds);
    if (PH == PH_GEMM_P) ph_gemm_p(p, bid, nb);
    if (PH == PH_GEMM_KV) ph_gemm_kv(p, bid, nb);
    if (PH == PH_SB) ph_sb_attn(p, bid, nb);
    if (PH == PH_CONV) ph_conv(p, l, bid, nb, lds);
    if (PH == PH_MERGED) ph_merged(p, l, bid, nb);
    if (PH == PH_WOUT) ph_gemm_wout(p, bid, nb);
    if (PH == PH_ROWPREP) ph_rowprep(p, bid, nb);
    if (PH == PH_XQ) ph_gemm_xq(p, bid, nb);
    if (PH == PH_XATTN) ph_xattn(p, bid, nb, lds);
    if (PH == PH_WO) ph_gemm_wo(p, bid, nb);
    if (PH == PH_PQ) ph_gemm_pq(p, bid, nb);
    if (PH == PH_PSCORE) ph_peer_score(p, bid, nb, lds);
    if (PH == PH_PGATHER) ph_peer_gather(p, l, bid, nb);
}

extern "C" void kernel_launch(void* const* d_in, const int* in_sizes, int n_in, void* d_out, int out_size, void* d_ws, size_t ws_size, hipStream_t stream) {
    P p{};
    const float** pp = (const float**)&p;
    for (int i = 0; i < 23; ++i) pp[i] = (const float*)d_in[i];
    p.out = (float*)d_out; p.ws = (unsigned char*)d_ws;
    const int G = 1024;
#define LAUNCH(PH, grid, l) hipLaunchKernelGGL(k_phase<PH>, dim3(grid), dim3(NT), 0, stream, p, l)
    LAUNCH(PH_PROLOGUE, G, 0);
    for (int l = 0; l < DEPTH; ++l) {
        LAUNCH(PH_PREPW, G, l);
        LAUNCH(PH_GEMM_P, G, l);
        LAUNCH(PH_GEMM_KV, G, l);
        LAUNCH(PH_SB, 256, l);
        LAUNCH(PH_CONV, G, l);
        LAUNCH(PH_MERGED, G, l);
        LAUNCH(PH_WOUT, G, l);
        LAUNCH(PH_ROWPREP, G, l);
        LAUNCH(PH_XQ, G, l);
        LAUNCH(PH_XATTN, G, l);
        LAUNCH(PH_WO, G, l);
        LAUNCH(PH_ROWPREP, G, l);
        LAUNCH(PH_PQ, G, l);
        LAUNCH(PH_PSCORE, G, l);
        LAUNCH(PH_PGATHER, G, l);
    }
}
```

```cpp
#include <hip/hip_runtime.h>
#include <hip/hip_cooperative_groups.h>
#include <cstdio>
#include <stdint.h>
#include <math.h>

constexpr int D = 1024, BATCH = 8, SEQ = 2048, T = BATCH * SEQ, DEPTH = 2, NMEM = 256, TM = BATCH * NMEM;
constexpr int INW = 7168, OFF_CV = 1536, OFF_SC = 2560, OFF_GATE = 4096;
constexpr int YW = 1536;
constexpr int NEXP = 16384, PQW = 2048;
constexpr int NT = 512;

typedef uint16_t bf16_t;
typedef short bf16x8 __attribute__((ext_vector_type(8)));
typedef float f32x4 __attribute__((ext_vector_type(4)));
typedef unsigned u32x4 __attribute__((ext_vector_type(4)));
typedef unsigned u32x2 __attribute__((ext_vector_type(2)));

constexpr size_t MiB = 1u << 20;
constexpr size_t WS_CTL = 0;
constexpr size_t WS_WIN = 1 * MiB;
constexpr size_t WS_WBR = 15 * MiB;
constexpr size_t WS_WOUT = 18 * MiB;
constexpr size_t WS_WXQ = 20 * MiB;
constexpr size_t WS_WKV = 22 * MiB;
constexpr size_t WS_WO = 26 * MiB;
constexpr size_t WS_WPQ = 28 * MiB;
constexpr size_t WS_KEYS = 32 * MiB;
constexpr size_t WS_U = 33 * MiB;
constexpr size_t WS_V = 65 * MiB;
constexpr size_t WS_HB = 97 * MiB;
constexpr size_t WS_RS = 129 * MiB;
constexpr size_t WS_MEMRS = 129 * MiB + 65536;
constexpr size_t WS_MEMB = 130 * MiB;
constexpr size_t WS_KV = 134 * MiB;
constexpr size_t WS_Y = 142 * MiB;
constexpr size_t WS_MERGED = 190 * MiB;
constexpr size_t WS_P = 222 * MiB;
constexpr size_t WS_XQ = 222 * MiB;
constexpr size_t WS_XO = 254 * MiB;
constexpr size_t WS_PQ = 286 * MiB;
constexpr size_t WS_PIDX = 350 * MiB;
constexpr size_t WS_PG = 358 * MiB;
constexpr size_t WS_END = 446 * MiB;

struct P {
    const float *x, *mem, *norm_mix_g, *w_in, *conv_dw_w, *conv_dw_b, *conv_ln_g, *conv_ln_b, *sc_w, *w_branch, *b_gate, *w_out,
        *norm_xa_g, *norm_mem_g, *xa_wq, *xa_wkv, *xa_wo, *norm_ffn_g, *peer_wq, *peer_keys, *peer_u, *peer_v, *final_g;
    float* out;
    unsigned char* ws;
};

__device__ __forceinline__ unsigned f2bf(float f) { unsigned u = __float_as_uint(f); return (u + 0x7fffu + ((u >> 16) & 1u)) >> 16; }
__device__ __forceinline__ unsigned pk2(float lo, float hi) { return f2bf(lo) | (f2bf(hi) << 16); }
__device__ __forceinline__ float bflo(unsigned w) { return __uint_as_float(w << 16); }
__device__ __forceinline__ float bfhi(unsigned w) { return __uint_as_float(w & 0xffff0000u); }
__device__ __forceinline__ float bf2f(bf16_t h) { return __uint_as_float(((unsigned)h) << 16); }
__device__ __forceinline__ float wave_sum(float v) {
#pragma unroll
    for (int o = 1; o < 64; o <<= 1) v += __shfl_xor(v, o);
    return v;
}
__device__ __forceinline__ float wave_max(float v) {
#pragma unroll
    for (int o = 1; o < 64; o <<= 1) v = fmaxf(v, __shfl_xor(v, o));
    return v;
}
__device__ __forceinline__ int get_tid() { int t = threadIdx.x; asm volatile("" : "+v"(t)); return t; }
__device__ __forceinline__ float sigmoidf_(float z) { return 1.0f / (1.0f + __expf(-z)); }

__device__ __forceinline__ void row_to_bf16_rs(const float* src, float* dst_f32, bf16_t* dst_bf, float* rs_out, int lane) {
    const f32x4* s4 = (const f32x4*)src + lane;
    f32x4 v[4]; float ss = 0.f;
#pragma unroll
    for (int j = 0; j < 4; ++j) { v[j] = s4[64 * j]; ss += v[j].x * v[j].x + v[j].y * v[j].y + v[j].z * v[j].z + v[j].w * v[j].w; }
    ss = wave_sum(ss);
    if (dst_f32) {
#pragma unroll
        for (int j = 0; j < 4; ++j) ((f32x4*)dst_f32 + lane)[64 * j] = v[j];
    }
#pragma unroll
    for (int j = 0; j < 4; ++j) { u32x2 w; w.x = pk2(v[j].x, v[j].y); w.y = pk2(v[j].z, v[j].w); ((u32x2*)dst_bf + lane)[64 * j] = w; }
    if (lane == 0) *rs_out = rsqrtf(ss * (1.0f / D) + 1e-6f);
}
__device__ __forceinline__ void ph_prologue(const P& p, int bid, int nb) {
    const int tid = get_tid(), lane = tid & 63, wid = tid >> 6;
    const int gw = bid * 8 + wid, ngw = nb * 8;
    bf16_t* hb = (bf16_t*)(p.ws + WS_HB); float* rs = (float*)(p.ws + WS_RS);
    bf16_t* memb = (bf16_t*)(p.ws + WS_MEMB); float* mrs = (float*)(p.ws + WS_MEMRS);
    for (int r = gw; r < T; r += ngw) row_to_bf16_rs(p.x + (size_t)r * D, p.out + (size_t)r * D, hb + (size_t)r * D, rs + r, lane);
    for (int r = gw; r < TM; r += ngw) row_to_bf16_rs(p.mem + (size_t)r * D, nullptr, memb + (size_t)r * D, mrs + r, lane);
}
__device__ __forceinline__ void ph_rowprep(const P& p, int bid, int nb) {
    const int tid = get_tid(), lane = tid & 63, wid = tid >> 6;
    const int gw = bid * 8 + wid, ngw = nb * 8;
    bf16_t* hb = (bf16_t*)(p.ws + WS_HB); float* rs = (float*)(p.ws + WS_RS);
    for (int r = gw; r < T; r += ngw) row_to_bf16_rs(p.out + (size_t)r * D, nullptr, hb + (size_t)r * D, rs + r, lane);
}

__device__ __forceinline__ void transpose_tile(const float* W, const float* g, bf16_t* Wt, int K, int N, int tile, float* lds) {
    const int tid = get_tid(), tx = tid & 63, ty = tid >> 6;
    const int tn = N / 64, kb = tile / tn, nbk = tile % tn, k0 = kb * 64, n0 = nbk * 64;
#pragma unroll
    for (int i = 0; i < 8; ++i) { const int r = ty + 8 * i; float v = W[(size_t)(k0 + r) * N + n0 + tx]; if (g) v *= g[k0 + r]; lds[r * 65 + tx] = v; }
    __syncthreads();
#pragma unroll
    for (int i = 0; i < 8; ++i) { const int n = ty + 8 * i; Wt[(size_t)(n0 + n) * K + k0 + tx] = (bf16_t)f2bf(lds[tx * 65 + n]); }
    __syncthreads();
}
__device__ __forceinline__ void ph_prep_weights(const P& p, int l, int bid, int nb, float* lds) {
    unsigned char* ws = p.ws;
    constexpr int T0 = 16 * 112, T1 = 8 * 16, T4 = 256, T6 = 16 * 32;
    constexpr int NTILES = T0 + 3 * T1 + T4 + T4 + T6 + T4 + T6;
    for (int it = bid; it < NTILES; it += nb) {
        int r = it;
        if (r < T0) { transpose_tile(p.w_in + (size_t)l * D * INW, p.norm_mix_g + l * D, (bf16_t*)(ws + WS_WIN), D, INW, r, lds); continue; } r -= T0;
        if (r < 3 * T1) { const int b = r / T1; transpose_tile(p.w_branch + ((size_t)l * 3 + b) * 512 * D, nullptr, (bf16_t*)(ws + WS_WBR) + (size_t)b * 1024 * 512, 512, D, r % T1, lds); continue; } r -= 3 * T1;
        if (r < T4) { transpose_tile(p.w_out + (size_t)l * D * D, nullptr, (bf16_t*)(ws + WS_WOUT), D, D, r, lds); continue; } r -= T4;
        if (r < T4) { transpose_tile(p.xa_wq + (size_t)l * D * D, p.norm_xa_g + l * D, (bf16_t*)(ws + WS_WXQ), D, D, r, lds); continue; } r -= T4;
        if (r < T6) { transpose_tile(p.xa_wkv + (size_t)l * D * 2 * D, p.norm_mem_g + l * D, (bf16_t*)(ws + WS_WKV), D, 2 * D, r, lds); continue; } r -= T6;
        if (r < T4) { transpose_tile(p.xa_wo + (size_t)l * D * D, nullptr, (bf16_t*)(ws + WS_WO), D, D, r, lds); continue; } r -= T4;
        transpose_tile(p.peer_wq + (size_t)l * D * PQW, p.norm_ffn_g + l * D, (bf16_t*)(ws + WS_WPQ), D, PQW, r, lds);
    }
    const size_t gt = (size_t)bid * NT + get_tid(), gn = (size_t)nb * NT;
    const f32x4* u4 = (const f32x4*)(p.peer_u + (size_t)l * NEXP * D); const f32x4* v4 = (const f32x4*)(p.peer_v + (size_t)l * NEXP * D);
    const f32x4* g4 = (const f32x4*)(p.norm_ffn_g + l * D);
    u32x2* ub = (u32x2*)(ws + WS_U); u32x2* vb = (u32x2*)(ws + WS_V);
    for (size_t i = gt; i < (size_t)NEXP * D / 4; i += gn) {
        const f32x4 a = u4[i], g = g4[i & 255], b = v4[i];
        u32x2 w; w.x = pk2(a.x * g.x, a.y * g.y); w.y = pk2(a.z * g.z, a.w * g.w); ub[i] = w;
        u32x2 z; z.x = pk2(b.x, b.y); z.y = pk2(b.z, b.w); vb[i] = z;
    }
    const f32x4* k4 = (const f32x4*)(p.peer_keys + (size_t)l * 8 * 2 * 128 * 128); u32x2* kb = (u32x2*)(ws + WS_KEYS);
    for (size_t i = gt; i < (size_t)8 * 2 * 128 * 128 / 4; i += gn) { const f32x4 a = k4[i]; u32x2 w; w.x = pk2(a.x, a.y); w.y = pk2(a.z, a.w); kb[i] = w; }
}

#define MFMA16(a, b, c) __builtin_amdgcn_mfma_f32_16x16x32_bf16((a), (b), (c), 0, 0, 0)
template <class Epi>
__device__ __forceinline__ void gemm_direct(const bf16_t* A, int lda, const bf16_t* Bt, int ldb, int M, int N, int K, const Epi& epi, int bid, int nb) {
    const int tid = get_tid(), lane = tid & 63, wid = tid >> 6, fr = lane & 15, fq = lane >> 4, wr = wid >> 2, wc = wid & 3;
    const int tn = N / 256, nunits = (M / 128) * tn;
    for (int unit = bid; unit < nunits; unit += nb) {
        const int pm = unit / tn, pn = unit % tn;
        const int row0 = pm * 128 + wr * 64, col0 = pn * 256 + wc * 64;
        f32x4 acc[4][4];
#pragma unroll
        for (int i = 0; i < 4; ++i)
#pragma unroll
            for (int j = 0; j < 4; ++j) acc[i][j] = (f32x4){0.f, 0.f, 0.f, 0.f};
        const bf16_t* ap = A + (size_t)(row0 + fr) * lda + fq * 8;
        const bf16_t* bp = Bt + (size_t)(col0 + fr) * ldb + fq * 8;
        for (int k0 = 0; k0 < K; k0 += 32) {
            bf16x8 a[4], b[4];
#pragma unroll
            for (int i = 0; i < 4; ++i) { a[i] = *(const bf16x8*)(ap + (size_t)i * 16 * lda + k0); b[i] = *(const bf16x8*)(bp + (size_t)i * 16 * ldb + k0); }
#pragma unroll
            for (int i = 0; i < 4; ++i)
#pragma unroll
                for (int j = 0; j < 4; ++j) acc[i][j] = MFMA16(b[j], a[i], acc[i][j]);
        }
#pragma unroll
        for (int i = 0; i < 4; ++i)
#pragma unroll
            for (int j = 0; j < 4; ++j) epi(row0 + i * 16 + fr, col0 + j * 16 + fq * 4, acc[i][j]);
    }
}
struct EpiScaleBf16 {
    bf16_t* O; int ldo; const float* rs; int ncol0; float s0;
    __device__ __forceinline__ void operator()(int m, int n0, f32x4 v) const {
        float s = rs[m]; if (n0 < ncol0) s *= s0;
        u32x2 w; w.x = pk2(v.x * s, v.y * s); w.y = pk2(v.z * s, v.w * s);
        *(u32x2*)(O + (size_t)m * ldo + n0) = w;
    }
};
struct EpiResidual {
    float* H;
    __device__ __forceinline__ void operator()(int m, int n0, f32x4 v) const { f32x4* q = (f32x4*)(H + (size_t)m * D + n0); f32x4 o = *q; o += v; *q = o; }
};

__device__ __forceinline__ void ph_gemm_p(const P& p, int bid, int nb) {
    EpiScaleBf16 e{(bf16_t*)(p.ws + WS_P), INW, (const float*)(p.ws + WS_RS), 512, 0.125f};
    gemm_direct(( const bf16_t*)(p.ws + WS_HB), D, (const bf16_t*)(p.ws + WS_WIN), D, T, INW, D, e, bid, nb);
}
__device__ __forceinline__ void ph_gemm_kv(const P& p, int bid, int nb) {
    EpiScaleBf16 e{(bf16_t*)(p.ws + WS_KV), 2 * D, (const float*)(p.ws + WS_MEMRS), 0, 1.f};
    gemm_direct((const bf16_t*)(p.ws + WS_MEMB), D, (const bf16_t*)(p.ws + WS_WKV), D, TM, 2 * D, D, e, bid, nb);
}
__device__ __forceinline__ void ph_gemm_wout(const P& p, int bid, int nb) {
    EpiResidual e{p.out};
    gemm_direct((const bf16_t*)(p.ws + WS_MERGED), D, (const bf16_t*)(p.ws + WS_WOUT), D, T, D, D, e, bid, nb);
}
__device__ __forceinline__ void ph_gemm_xq(const P& p, int bid, int nb) {
    EpiScaleBf16 e{(bf16_t*)(p.ws + WS_XQ), D, (const float*)(p.ws + WS_RS), D, 0.0625f};
    gemm_direct((const bf16_t*)(p.ws + WS_HB), D, (const bf16_t*)(p.ws + WS_WXQ), D, T, D, D, e, bid, nb);
}
__device__ __forceinline__ void ph_gemm_wo(const P& p, int bid, int nb) {
    EpiResidual e{p.out};
    gemm_direct((const bf16_t*)(p.ws + WS_XO), D, (const bf16_t*)(p.ws + WS_WO), D, T, D, D, e, bid, nb);
}
__device__ __forceinline__ void ph_gemm_pq(const P& p, int bid, int nb) {
    EpiScaleBf16 e{(bf16_t*)(p.ws + WS_PQ), PQW, (const float*)(p.ws + WS_RS), 0, 1.f};
    gemm_direct((const bf16_t*)(p.ws + WS_HB), D, (const bf16_t*)(p.ws + WS_WPQ), D, T, PQW, D, e, bid, nb);
}
__device__ __forceinline__ void ph_merged(const P& p, int l, int bid, int nb) {
    const int tid = get_tid(), lane = tid & 63, wid = tid >> 6, fr = lane & 15, fq = lane >> 4, wr = wid >> 2, wc = wid & 3;
    const bf16_t* Y = (const bf16_t*)(p.ws + WS_Y); const bf16_t* Wb = (const bf16_t*)(p.ws + WS_WBR); const bf16_t* pp = (const bf16_t*)(p.ws + WS_P);
    bf16_t* Mg = (bf16_t*)(p.ws + WS_MERGED); const float* bg = p.b_gate + (size_t)l * 3 * D;
    constexpr int tn = D / 256, nunits = (T / 128) * tn;
    for (int unit = bid; unit < nunits; unit += nb) {
        const int pm = unit / tn, pn = unit % tn;
        const int row0 = pm * 128 + wr * 64, col0 = pn * 256 + wc * 64;
        f32x4 tot[4][4];
#pragma unroll
        for (int i = 0; i < 4; ++i)
#pragma unroll
            for (int j = 0; j < 4; ++j) tot[i][j] = (f32x4){0.f, 0.f, 0.f, 0.f};
        for (int b = 0; b < 3; ++b) {
            f32x4 acc[4][4];
#pragma unroll
            for (int i = 0; i < 4; ++i)
#pragma unroll
                for (int j = 0; j < 4; ++j) acc[i][j] = (f32x4){0.f, 0.f, 0.f, 0.f};
            const bf16_t* ap = Y + (size_t)(row0 + fr) * YW + b * 512 + fq * 8;
            const bf16_t* bp = Wb + (size_t)b * 1024 * 512 + (size_t)(col0 + fr) * 512 + fq * 8;
            for (int k0 = 0; k0 < 512; k0 += 32) {
                bf16x8 a[4], bb[4];
#pragma unroll
                for (int i = 0; i < 4; ++i) { a[i] = *(const bf16x8*)(ap + (size_t)i * 16 * YW + k0); bb[i] = *(const bf16x8*)(bp + (size_t)i * 16 * 512 + k0); }
#pragma unroll
                for (int i = 0; i < 4; ++i)
#pragma unroll
                    for (int j = 0; j < 4; ++j) acc[i][j] = MFMA16(bb[j], a[i], acc[i][j]);
            }
#pragma unroll
            for (int i = 0; i < 4; ++i)
#pragma unroll
                for (int j = 0; j < 4; ++j) {
                    const int m = row0 + i * 16 + fr, n0 = col0 + j * 16 + fq * 4;
                    const u32x2 gz = *(const u32x2*)(pp + (size_t)m * INW + OFF_GATE + b * D + n0);
                    const f32x4 bv = *(const f32x4*)(bg + b * D + n0);
                    tot[i][j].x += sigmoidf_(bflo(gz.x) + bv.x) * acc[i][j].x;
                    tot[i][j].y += sigmoidf_(bfhi(gz.x) + bv.y) * acc[i][j].y;
                    tot[i][j].z += sigmoidf_(bflo(gz.y) + bv.z) * acc[i][j].z;
                    tot[i][j].w += sigmoidf_(bfhi(gz.y) + bv.w) * acc[i][j].w;
                }
        }
#pragma unroll
        for (int i = 0; i < 4; ++i)
#pragma unroll
            for (int j = 0; j < 4; ++j) {
                const int m = row0 + i * 16 + fr, n0 = col0 + j * 16 + fq * 4;
                u32x2 w; w.x = pk2(tot[i][j].x, tot[i][j].y); w.y = pk2(tot[i][j].z, tot[i][j].w);
                *(u32x2*)(Mg + (size_t)m * D + n0) = w;
            }
    }
}

__device__ __forceinline__ void ph_sb_attn(const P& p, int bid, int nb) {
    const int tid = get_tid(), lane = tid & 63, wid = __builtin_amdgcn_readfirstlane(tid >> 6);
    const bf16_t* pp = (const bf16_t*)(p.ws + WS_P); bf16_t* Y = (bf16_t*)(p.ws + WS_Y);
    const int gw = bid * 8 + wid, ngw = nb * 8;
    for (int task = gw; task < 64 * 32; task += ngw) {
        const int tb = 31 - (task >> 6), bh = task & 63, b = bh >> 3, h = bh & 7;
        const int t = tb * 64 + lane;
        float q[64], o[64];
        {
            const u32x4* qp = (const u32x4*)(pp + (size_t)(b * SEQ + t) * INW + h * 64);
#pragma unroll
            for (int i = 0; i < 8; ++i) { const u32x4 w = qp[i]; q[8 * i] = bflo(w.x); q[8 * i + 1] = bfhi(w.x); q[8 * i + 2] = bflo(w.y); q[8 * i + 3] = bfhi(w.y);
                q[8 * i + 4] = bflo(w.z); q[8 * i + 5] = bfhi(w.z); q[8 * i + 6] = bflo(w.w); q[8 * i + 7] = bfhi(w.w); }
        }
#pragma unroll
        for (int i = 0; i < 64; ++i) o[i] = 0.f;
        float carry = 0.f;
        for (int s = tb * 64 + 62; s >= 0; --s) {
            const unsigned* kp = (const unsigned*)(pp + (size_t)(b * SEQ + s) * INW + 512 + h * 64);
            const unsigned* vp = kp + 256;
            float z0 = 0.f, z1 = 0.f;
#pragma unroll
            for (int i = 0; i < 32; ++i) { const unsigned w = kp[i]; z0 = fmaf(q[2 * i], bflo(w), z0); z1 = fmaf(q[2 * i + 1], bfhi(w), z1); }
            const float z = z0 + z1;
            const bool valid = s < t;
            const float sp = fmaxf(z, 0.f) + log1pf(expf(-fabsf(z)));
            const float a = valid ? expf((z - sp) + carry) : 0.f;
            carry += valid ? -sp : 0.f;
#pragma unroll
            for (int i = 0; i < 32; ++i) { const unsigned w = vp[i]; o[2 * i] = fmaf(a, bflo(w), o[2 * i]); o[2 * i + 1] = fmaf(a, bfhi(w), o[2 * i + 1]); }
            if (__all(carry < -110.f)) break;
        }
        u32x4* yp = (u32x4*)(Y + (size_t)(b * SEQ + t) * YW + h * 64);
#pragma unroll
        for (int i = 0; i < 8; ++i) { u32x4 w; w.x = pk2(o[8 * i], o[8 * i + 1]); w.y = pk2(o[8 * i + 2], o[8 * i + 3]); w.z = pk2(o[8 * i + 4], o[8 * i + 5]); w.w = pk2(o[8 * i + 6], o[8 * i + 7]); yp[i] = w; }
    }
}
__device__ __forceinline__ void ph_conv(const P& p, int l, int bid, int nb, float* lds) {
    const int tid = get_tid(), lane = tid & 63, wid = tid >> 6, c = tid;
    const bf16_t* pp = (const bf16_t*)(p.ws + WS_P); bf16_t* Y = (bf16_t*)(p.ws + WS_Y);
    const float* dw = p.conv_dw_w + (size_t)l * 31 * 512; const float* scw = p.sc_w + (size_t)l * 3 * 512;
    const float db = p.conv_dw_b[l * 512 + c], lg = p.conv_ln_g[l * 512 + c], lb = p.conv_ln_b[l * 512 + c];
    for (int tok = bid; tok < T; tok += nb) {
        const int t = tok % SEQ;
        float acc = db;
        for (int j = 0; j < 31; ++j) {
            const int tt = t - 30 + j;
            if (tt >= 0) {
                const bf16_t* r = pp + (size_t)(tok - 30 + j) * INW;
                const float val = bf2f(r[OFF_CV + c]), gt = bf2f(r[OFF_CV + 512 + c]);
                acc = fmaf(dw[j * 512 + c], val * sigmoidf_(gt), acc);
            }
        }
        float s = wave_sum(acc);
        if (lane == 0) lds[wid] = s;
        __syncthreads();
        float mean = 0.f;
#pragma unroll
        for (int i = 0; i < 8; ++i) mean += lds[i];
        mean *= (1.0f / 512.0f);
        const float d = acc - mean;
        float s2 = wave_sum(d * d);
        if (lane == 0) lds[8 + wid] = s2;
        __syncthreads();
        float var = 0.f;
#pragma unroll
        for (int i = 0; i < 8; ++i) var += lds[8 + i];
        var *= (1.0f / 512.0f);
        const float yv = d * rsqrtf(var + 1e-5f) * lg + lb;
        Y[(size_t)tok * YW + 512 + c] = (bf16_t)f2bf(yv * sigmoidf_(yv));
        float sc = 0.f;
#pragma unroll
        for (int j = 0; j < 3; ++j) {
            const int tt = t - 2 + j;
            if (tt >= 0) { const bf16_t* r = pp + (size_t)(tok - 2 + j) * INW; sc = fmaf(scw[j * 512 + c], bf2f(r[OFF_SC + 512 + c]) * bf2f(r[OFF_SC + 1024 + c]), sc); }
        }
        Y[(size_t)tok * YW + 1024 + c] = (bf16_t)f2bf(bf2f(pp[(size_t)tok * INW + OFF_SC + c]) * sc);
        __syncthreads();
    }
}

__device__ __forceinline__ void ph_xattn(const P& p, int bid, int nb, float* lds) {
    const int tid = get_tid(), lane = tid & 63, wid = tid >> 6;
    const bf16_t* XQ = (const bf16_t*)(p.ws + WS_XQ); const bf16_t* KV = (const bf16_t*)(p.ws + WS_KV); bf16_t* XO = (bf16_t*)(p.ws + WS_XO);
    float* qs = lds + wid * 512; float* as = qs + 256;
    const int gw = bid * 8 + wid, ngw = nb * 8;
    for (int task = gw; task < T * 4; task += ngw) {
        const int tok = task >> 2, hd = task & 3, b = tok / SEQ;
        { const u32x2 w = *(const u32x2*)(XQ + (size_t)tok * D + hd * 256 + lane * 4); qs[lane * 4] = bflo(w.x); qs[lane * 4 + 1] = bfhi(w.x); qs[lane * 4 + 2] = bflo(w.y); qs[lane * 4 + 3] = bfhi(w.y); }
        __builtin_amdgcn_s_waitcnt(0);
        float sc[4];
#pragma unroll
        for (int j = 0; j < 4; ++j) {
            const int m = lane + 64 * j;
            const u32x4* kp = (const u32x4*)(KV + (size_t)(b * NMEM + m) * 2 * D + hd * 256);
            float z = 0.f;
#pragma unroll 4
            for (int i = 0; i < 32; ++i) { const u32x4 w = kp[i]; const float* qq = qs + 8 * i;
                z = fmaf(qq[0], bflo(w.x), z); z = fmaf(qq[1], bfhi(w.x), z); z = fmaf(qq[2], bflo(w.y), z); z = fmaf(qq[3], bfhi(w.y), z);
                z = fmaf(qq[4], bflo(w.z), z); z = fmaf(qq[5], bfhi(w.z), z); z = fmaf(qq[6], bflo(w.w), z); z = fmaf(qq[7], bfhi(w.w), z); }
            sc[j] = z;
        }
        const float mx = wave_max(fmaxf(fmaxf(sc[0], sc[1]), fmaxf(sc[2], sc[3])));
        float e[4], es = 0.f;
#pragma unroll
        for (int j = 0; j < 4; ++j) { e[j] = __expf(sc[j] - mx); es += e[j]; }
        es = wave_sum(es);
        const float inv = 1.0f / es;
#pragma unroll
        for (int j = 0; j < 4; ++j) as[lane + 64 * j] = e[j] * inv;
        __builtin_amdgcn_s_waitcnt(0);
        float o0 = 0.f, o1 = 0.f, o2 = 0.f, o3 = 0.f;
        const bf16_t* vb = KV + (size_t)(b * NMEM) * 2 * D + D + hd * 256 + lane * 4;
        for (int m = 0; m < NMEM; ++m) { const u32x2 w = *(const u32x2*)(vb + (size_t)m * 2 * D); const float a = as[m];
            o0 = fmaf(a, bflo(w.x), o0); o1 = fmaf(a, bfhi(w.x), o1); o2 = fmaf(a, bflo(w.y), o2); o3 = fmaf(a, bfhi(w.y), o3); }
        u32x2 w; w.x = pk2(o0, o1); w.y = pk2(o2, o3);
        *(u32x2*)(XO + (size_t)tok * D + hd * 256 + lane * 4) = w;
    }
}

__device__ __forceinline__ void wave_argmax(float& v, int& i) {
#pragma unroll
    for (int o = 1; o < 64; o <<= 1) { const float ov = __shfl_xor(v, o); const int oi = __shfl_xor(i, o); if (ov > v || (ov == v && oi < i)) { v = ov; i = oi; } }
}
__device__ __forceinline__ void ph_peer_score(const P& p, int bid, int nb, float* lds) {
    const int tid = get_tid(), lane = tid & 63, wid = tid >> 6;
    const bf16_t* PQ = (const bf16_t*)(p.ws + WS_PQ); const bf16_t* KEYS = (const bf16_t*)(p.ws + WS_KEYS);
    int* PIDX = (int*)(p.ws + WS_PIDX); float* PG = (float*)(p.ws + WS_PG);
    float* qs = lds + wid * 512;
    float* sv = qs + 256;
    int* si = (int*)(sv + 32);
    float* st = sv + 64;
    int* sci = (int*)(sv + 80);
    const int gw = bid * 8 + wid, ngw = nb * 8;
    for (int task = gw; task < T * 8; task += ngw) {
        const int tok = task >> 3, h = task & 7;
        { const u32x2 w = *(const u32x2*)(PQ + (size_t)tok * PQW + h * 256 + lane * 4); qs[lane * 4] = bflo(w.x); qs[lane * 4 + 1] = bfhi(w.x); qs[lane * 4 + 2] = bflo(w.y); qs[lane * 4 + 3] = bfhi(w.y); }
        __builtin_amdgcn_s_waitcnt(0);
#pragma unroll
        for (int pp = 0; pp < 2; ++pp) {
            float a[2];
#pragma unroll
            for (int jj = 0; jj < 2; ++jj) {
                const int n = lane + 64 * jj;
                const u32x4* kp = (const u32x4*)(KEYS + ((size_t)(h * 2 + pp) * 128 + n) * 128);
                const float* qq = qs + pp * 128; float z = 0.f;
#pragma unroll 4
                for (int i = 0; i < 16; ++i) { const u32x4 w = kp[i]; const float* q8 = qq + 8 * i;
                    z = fmaf(q8[0], bflo(w.x), z); z = fmaf(q8[1], bfhi(w.x), z); z = fmaf(q8[2], bflo(w.y), z); z = fmaf(q8[3], bfhi(w.y), z);
                    z = fmaf(q8[4], bflo(w.z), z); z = fmaf(q8[5], bfhi(w.z), z); z = fmaf(q8[6], bflo(w.w), z); z = fmaf(q8[7], bfhi(w.w), z); }
                a[jj] = z;
            }
#pragma unroll 1
            for (int k = 0; k < 16; ++k) {
                float v; int i;
                if (a[0] >= a[1]) { v = a[0]; i = lane; } else { v = a[1]; i = lane + 64; }
                wave_argmax(v, i);
                if (i == lane) a[0] = -INFINITY;
                if (i == lane + 64) a[1] = -INFINITY;
                if (lane == 0) { sv[pp * 16 + k] = v; si[pp * 16 + k] = i; }
            }
        }
        __builtin_amdgcn_s_waitcnt(0);
        float cnd[4];
#pragma unroll
        for (int j = 0; j < 4; ++j) { const int ci = lane * 4 + j; cnd[j] = sv[ci >> 4] + sv[16 + (ci & 15)]; }
#pragma unroll 1
        for (int k = 0; k < 16; ++k) {
            float v = cnd[0]; int i = lane * 4;
#pragma unroll
            for (int j = 1; j < 4; ++j) if (cnd[j] > v) { v = cnd[j]; i = lane * 4 + j; }
            wave_argmax(v, i);
#pragma unroll
            for (int j = 0; j < 4; ++j) if (i == lane * 4 + j) cnd[j] = -INFINITY;
            if (lane == 0) { st[k] = v; sci[k] = i; }
        }
        __builtin_amdgcn_s_waitcnt(0);
        if (lane < 16) {
            const float mx = st[0]; float sum = 0.f;
#pragma unroll
            for (int k = 0; k < 16; ++k) sum += __expf(st[k] - mx);
            const int ci = sci[lane];
            PIDX[(size_t)tok * 128 + h * 16 + lane] = si[ci >> 4] * 128 + si[16 + (ci & 15)];
            PG[(size_t)tok * 128 + h * 16 + lane] = __expf(st[lane] - mx) / sum;
        }
        __builtin_amdgcn_s_waitcnt(0);
    }
}
__device__ __forceinline__ void ph_peer_gather(const P& p, int l, int bid, int nb) {
    const int tid = get_tid(), lane = tid & 63, wid = __builtin_amdgcn_readfirstlane(tid >> 6);
    const bf16_t* HB = (const bf16_t*)(p.ws + WS_HB); float* RS = (float*)(p.ws + WS_RS);
    const bf16_t* U = (const bf16_t*)(p.ws + WS_U); const bf16_t* V = (const bf16_t*)(p.ws + WS_V);
    const int* PIDX = (const int*)(p.ws + WS_PIDX); const float* PG = (const float*)(p.ws + WS_PG);
    const int gw = bid * 8 + wid, ngw = nb * 8;
    for (int tok = gw; tok < T; tok += ngw) {
        float xv[16];
        {
            const u32x4 w0 = *(const u32x4*)(HB + (size_t)tok * D + lane * 8), w1 = *(const u32x4*)(HB + (size_t)tok * D + 512 + lane * 8);
            xv[0] = bflo(w0.x); xv[1] = bfhi(w0.x); xv[2] = bflo(w0.y); xv[3] = bfhi(w0.y); xv[4] = bflo(w0.z); xv[5] = bfhi(w0.z); xv[6] = bflo(w0.w); xv[7] = bfhi(w0.w);
            xv[8] = bflo(w1.x); xv[9] = bfhi(w1.x); xv[10] = bflo(w1.y); xv[11] = bfhi(w1.y); xv[12] = bflo(w1.z); xv[13] = bfhi(w1.z); xv[14] = bflo(w1.w); xv[15] = bfhi(w1.w);
        }
        const float rs = RS[tok];
        float o[16];
#pragma unroll
        for (int i = 0; i < 16; ++i) o[i] = 0.f;
        for (int e = 0; e < 128; ++e) {
            const int idx = __builtin_amdgcn_readfirstlane(PIDX[(size_t)tok * 128 + e]);
            const float g = PG[(size_t)tok * 128 + e];
            const u32x4 u0 = *(const u32x4*)(U + (size_t)idx * D + lane * 8), u1 = *(const u32x4*)(U + (size_t)idx * D + 512 + lane * 8);
            float d = xv[0] * bflo(u0.x);
            d = fmaf(xv[1], bfhi(u0.x), d); d = fmaf(xv[2], bflo(u0.y), d); d = fmaf(xv[3], bfhi(u0.y), d); d = fmaf(xv[4], bflo(u0.z), d); d = fmaf(xv[5], bfhi(u0.z), d);
            d = fmaf(xv[6], bflo(u0.w), d); d = fmaf(xv[7], bfhi(u0.w), d); d = fmaf(xv[8], bflo(u1.x), d); d = fmaf(xv[9], bfhi(u1.x), d); d = fmaf(xv[10], bflo(u1.y), d);
            d = fmaf(xv[11], bfhi(u1.y), d); d = fmaf(xv[12], bflo(u1.z), d); d = fmaf(xv[13], bfhi(u1.z), d); d = fmaf(xv[14], bflo(u1.w), d); d = fmaf(xv[15], bfhi(u1.w), d);
            const float a = wave_sum(d) * rs;
            const float w = g * 0.5f * a * (1.0f + erff(a * 0.70710678118654752f));
            const u32x4 v0 = *(const u32x4*)(V + (size_t)idx * D + lane * 8), v1 = *(const u32x4*)(V + (size_t)idx * D + 512 + lane * 8);
            o[0] = fmaf(w, bflo(v0.x), o[0]); o[1] = fmaf(w, bfhi(v0.x), o[1]); o[2] = fmaf(w, bflo(v0.y), o[2]); o[3] = fmaf(w, bfhi(v0.y), o[3]);
            o[4] = fmaf(w, bflo(v0.z), o[4]); o[5] = fmaf(w, bfhi(v0.z), o[5]); o[6] = fmaf(w, bflo(v0.w), o[6]); o[7] = fmaf(w, bfhi(v0.w), o[7]);
            o[8] = fmaf(w, bflo(v1.x), o[8]); o[9] = fmaf(w, bfhi(v1.x), o[9]); o[10] = fmaf(w, bflo(v1.y), o[10]); o[11] = fmaf(w, bfhi(v1.y), o[11]);
            o[12] = fmaf(w, bflo(v1.z), o[12]); o[13] = fmaf(w, bfhi(v1.z), o[13]); o[14] = fmaf(w, bflo(v1.w), o[14]); o[15] = fmaf(w, bfhi(v1.w), o[15]);
        }
        float* hrow = p.out + (size_t)tok * D;
        f32x4 h0 = *(f32x4*)(hrow + lane * 8), h1 = *(f32x4*)(hrow + lane * 8 + 4), h2 = *(f32x4*)(hrow + 512 + lane * 8), h3 = *(f32x4*)(hrow + 512 + lane * 8 + 4);
        h0.x += o[0]; h0.y += o[1]; h0.z += o[2]; h0.w += o[3]; h1.x += o[4]; h1.y += o[5]; h1.z += o[6]; h1.w += o[7];
        h2.x += o[8]; h2.y += o[9]; h2.z += o[10]; h2.w += o[11]; h3.x += o[12]; h3.y += o[13]; h3.z += o[14]; h3.w += o[15];
        float ss = h0.x * h0.x + h0.y * h0.y + h0.z * h0.z + h0.w * h0.w + h1.x * h1.x + h1.y * h1.y + h1.z * h1.z + h1.w * h1.w
                 + h2.x * h2.x + h2.y * h2.y + h2.z * h2.z + h2.w * h2.w + h3.x * h3.x + h3.y * h3.y + h3.z * h3.z + h3.w * h3.w;
        ss = wave_sum(ss);
        const float nrs = rsqrtf(ss * (1.0f / D) + 1e-6f);
        if (l == DEPTH - 1) {
            const f32x4 g0 = *(const f32x4*)(p.final_g + lane * 8), g1 = *(const f32x4*)(p.final_g + lane * 8 + 4), g2 = *(const f32x4*)(p.final_g + 512 + lane * 8), g3 = *(const f32x4*)(p.final_g + 512 + lane * 8 + 4);
            *(f32x4*)(hrow + lane * 8) = h0 * nrs * g0; *(f32x4*)(hrow + lane * 8 + 4) = h1 * nrs * g1;
            *(f32x4*)(hrow + 512 + lane * 8) = h2 * nrs * g2; *(f32x4*)(hrow + 512 + lane * 8 + 4) = h3 * nrs * g3;
        } else {
            *(f32x4*)(hrow + lane * 8) = h0; *(f32x4*)(hrow + lane * 8 + 4) = h1; *(f32x4*)(hrow + 512 + lane * 8) = h2; *(f32x4*)(hrow + 512 + lane * 8 + 4) = h3;
            u32x4 w0, w1;
            w0.x = pk2(h0.x, h0.y); w0.y = pk2(h0.z, h0.w); w0.z = pk2(h1.x, h1.y); w0.w = pk2(h1.z, h1.w);
            w1.x = pk2(h2.x, h2.y); w1.y = pk2(h2.z, h2.w); w1.z = pk2(h3.x, h3.y); w1.w = pk2(h3.z, h3.w);
            bf16_t* hb = (bf16_t*)(p.ws + WS_HB) + (size_t)tok * D;
            *(u32x4*)(hb + lane * 8) = w0; *(u32x4*)(hb + 512 + lane * 8) = w1;
            if (lane == 0) RS[tok] = nrs;
        }
    }
}

namespace cg = cooperative_groups;
constexpr int LDS_BYTES = 147456;
__global__ void __launch_bounds__(NT) mega_fwd(P p) {
    extern __shared__ __attribute__((aligned(16))) unsigned char smem[];
    float* lds = (float*)smem;
    cg::grid_group grid = cg::this_grid();
    const int bid = blockIdx.x, nb = gridDim.x;
#define PH(call) do { P q = p; asm volatile("" : "+s"(q.ws), "+s"(q.out) :: "memory"); call; } while (0)
    PH(ph_prologue(q, bid, nb));
#pragma unroll 1
    for (int l = 0; l < DEPTH; ++l) {
        PH(ph_prep_weights(q, l, bid, nb, lds)); grid.sync();
        PH(ph_gemm_p(q, bid, nb)); PH(ph_gemm_kv(q, bid, nb)); grid.sync();
        PH(ph_sb_attn(q, bid, nb)); PH(ph_conv(q, l, bid, nb, lds)); grid.sync();
        PH(ph_merged(q, l, bid, nb)); grid.sync();
        PH(ph_gemm_wout(q, bid, nb)); grid.sync();
        PH(ph_rowprep(q, bid, nb)); grid.sync();
        PH(ph_gemm_xq(q, bid, nb)); grid.sync();
        PH(ph_xattn(q, bid, nb, lds)); grid.sync();
        PH(ph_gemm_wo(q, bid, nb)); grid.sync();
        PH(ph_rowprep(q, bid, nb)); grid.sync();
        PH(ph_gemm_pq(q, bid, nb)); grid.sync();
        PH(ph_peer_score(q, bid, nb, lds)); grid.sync();
        PH(ph_peer_gather(q, l, bid, nb)); grid.sync();
    }
#undef PH
}

extern "C" void kernel_launch(void* const* d_in, const int* in_sizes, int n_in, void* d_out, int out_size, void* d_ws, size_t ws_size, hipStream_t stream) {
    static int grid = 0;
    if (grid == 0) {
        int dev = 0, cus = 0, per_cu = 0;
        hipGetDevice(&dev);
        hipDeviceGetAttribute(&cus, hipDeviceAttributeMultiprocessorCount, dev);
        hipFuncSetAttribute((const void*)mega_fwd, hipFuncAttributeMaxDynamicSharedMemorySize, LDS_BYTES);
        hipOccupancyMaxActiveBlocksPerMultiprocessor(&per_cu, (const void*)mega_fwd, NT, LDS_BYTES);
        if (per_cu < 1) per_cu = 1;
        grid = cus * per_cu;
        if (ws_size < WS_END) { fprintf(stderr, "kernel_launch: workspace too small (%zu < %zu)\n", ws_size, (size_t)WS_END); grid = -1; }
    }
    if (grid < 0) return;
    P p{};
    const float** pp = (const float**)&p;
    for (int i = 0; i < 23; ++i) pp[i] = (const float*)d_in[i];
    p.out = (float*)d_out; p.ws = (unsigned char*)d_ws;
    void* args[] = {&p};
    hipError_t e = hipLaunchCooperativeKernel((void*)mega_fwd, dim3(grid), dim3(NT), args, LDS_BYTES, stream);
    if (e != hipSuccess) fprintf(stderr, "cooperative launch failed: %s (grid %d)\n", hipGetErrorString(e), grid);
}
```

```cpp
#include <hip/hip_runtime.h>
#include <hip/hip_cooperative_groups.h>
#include <cstdio>
#include <stdint.h>
#include <math.h>

constexpr int D = 1024, BATCH = 8, SEQ = 2048, T = BATCH * SEQ, DEPTH = 2, NMEM = 256, TM = BATCH * NMEM;
constexpr int INW = 7168, OFF_CV = 1536, OFF_SC = 2560, OFF_GATE = 4096;
constexpr int YW = 1536;
constexpr int NEXP = 16384, PQW = 2048;
constexpr int NT = 512;

typedef uint16_t bf16_t;
typedef short bf16x8 __attribute__((ext_vector_type(8)));
typedef float f32x4 __attribute__((ext_vector_type(4)));
typedef unsigned u32x4 __attribute__((ext_vector_type(4)));
typedef unsigned u32x2 __attribute__((ext_vector_type(2)));

constexpr size_t MiB = 1u << 20;
constexpr size_t WS_CTL = 0;
constexpr size_t WS_WIN = 1 * MiB;
constexpr size_t WS_WBR = 15 * MiB;
constexpr size_t WS_WOUT = 18 * MiB;
constexpr size_t WS_WXQ = 20 * MiB;
constexpr size_t WS_WKV = 22 * MiB;
constexpr size_t WS_WO = 26 * MiB;
constexpr size_t WS_WPQ = 28 * MiB;
constexpr size_t WS_KEYS = 32 * MiB;
constexpr size_t WS_U = 33 * MiB;
constexpr size_t WS_V = 65 * MiB;
constexpr size_t WS_HB = 97 * MiB;
constexpr size_t WS_SSQ = 129 * MiB;
constexpr size_t WS_MEMSSQ = 256 * 1024;
constexpr size_t WS_MEMB = 130 * MiB;
constexpr size_t WS_KV = 134 * MiB;
constexpr size_t WS_Y = 142 * MiB;
constexpr size_t WS_MERGED = 190 * MiB;
constexpr size_t WS_P = 222 * MiB;
constexpr size_t WS_XQ = 222 * MiB;
constexpr size_t WS_XO = 254 * MiB;
constexpr size_t WS_PQ = 286 * MiB;
constexpr size_t WS_PIDX = 350 * MiB;
constexpr size_t WS_PG = 358 * MiB;
constexpr size_t WS_END = 446 * MiB;

struct P {
    const float *x, *mem, *norm_mix_g, *w_in, *conv_dw_w, *conv_dw_b, *conv_ln_g, *conv_ln_b, *sc_w, *w_branch, *b_gate, *w_out,
        *norm_xa_g, *norm_mem_g, *xa_wq, *xa_wkv, *xa_wo, *norm_ffn_g, *peer_wq, *peer_keys, *peer_u, *peer_v, *final_g;
    float* out;
    unsigned char* ws;
};

__device__ __forceinline__ unsigned f2bf(float f) { unsigned u = __float_as_uint(f); return (u + 0x7fffu + ((u >> 16) & 1u)) >> 16; }
__device__ __forceinline__ unsigned pk2(float lo, float hi) { return f2bf(lo) | (f2bf(hi) << 16); }
__device__ __forceinline__ float bflo(unsigned w) { return __uint_as_float(w << 16); }
__device__ __forceinline__ float bfhi(unsigned w) { return __uint_as_float(w & 0xffff0000u); }
__device__ __forceinline__ float bf2f(bf16_t h) { return __uint_as_float(((unsigned)h) << 16); }
__device__ __forceinline__ float wave_sum(float v) {
#pragma unroll
    for (int o = 1; o < 64; o <<= 1) v += __shfl_xor(v, o);
    return v;
}
__device__ __forceinline__ float wave_max(float v) {
#pragma unroll
    for (int o = 1; o < 64; o <<= 1) v = fmaxf(v, __shfl_xor(v, o));
    return v;
}
__device__ __forceinline__ int get_tid() { int t = threadIdx.x; asm volatile("" : "+v"(t)); return t; }
__device__ __forceinline__ float sigmoidf_(float z) { return 1.0f / (1.0f + __expf(-z)); }

__device__ __forceinline__ void row_to_bf16_rs(const float* src, float* dst_f32, bf16_t* dst_bf, float* rs_out, int lane) {
    const f32x4* s4 = (const f32x4*)src + lane;
    f32x4 v[4]; float ss = 0.f;
#pragma unroll
    for (int j = 0; j < 4; ++j) { v[j] = s4[64 * j]; ss += v[j].x * v[j].x + v[j].y * v[j].y + v[j].z * v[j].z + v[j].w * v[j].w; }
    ss = wave_sum(ss);
    if (dst_f32) {
#pragma unroll
        for (int j = 0; j < 4; ++j) ((f32x4*)dst_f32 + lane)[64 * j] = v[j];
    }
#pragma unroll
    for (int j = 0; j < 4; ++j) { u32x2 w; w.x = pk2(v[j].x, v[j].y); w.y = pk2(v[j].z, v[j].w); ((u32x2*)dst_bf + lane)[64 * j] = w; }
    if (lane < 16) rs_out[lane] = lane == 0 ? ss : 0.f;
}
__device__ __forceinline__ void ph_prologue(const P& p, int bid, int nb) {
    const int tid = get_tid(), lane = tid & 63, wid = tid >> 6;
    const int gw = bid * 8 + wid, ngw = nb * 8;
    bf16_t* hb = (bf16_t*)(p.ws + WS_HB); float* rs = (float*)(p.ws + WS_SSQ);
    bf16_t* memb = (bf16_t*)(p.ws + WS_MEMB); float* mrs = (float*)(p.ws + WS_MEMSSQ);
    for (int r = gw; r < T; r += ngw) row_to_bf16_rs(p.x + (size_t)r * D, p.out + (size_t)r * D, hb + (size_t)r * D, rs + (size_t)r * 16, lane);
    for (int r = gw; r < TM; r += ngw) row_to_bf16_rs(p.mem + (size_t)r * D, nullptr, memb + (size_t)r * D, mrs + (size_t)r * 16, lane);
}
__device__ __forceinline__ void transpose_tile(const float* W, const float* g, bf16_t* Wt, int K, int N, int tile, float* lds) {
    const int tid = get_tid(), tx = tid & 63, ty = tid >> 6;
    const int tn = N / 64, kb = tile / tn, nbk = tile % tn, k0 = kb * 64, n0 = nbk * 64;
#pragma unroll
    for (int i = 0; i < 8; ++i) { const int r = ty + 8 * i; float v = W[(size_t)(k0 + r) * N + n0 + tx]; if (g) v *= g[k0 + r]; lds[r * 65 + tx] = v; }
    __syncthreads();
#pragma unroll
    for (int i = 0; i < 8; ++i) { const int n = ty + 8 * i; Wt[(size_t)(n0 + n) * K + k0 + tx] = (bf16_t)f2bf(lds[tx * 65 + n]); }
    __syncthreads();
}
__device__ __forceinline__ void ph_prep_weights(const P& p, int l, int bid, int nb, float* lds) {
    unsigned char* ws = p.ws;
    constexpr int T0 = 16 * 112, T1 = 8 * 16, T4 = 256, T6 = 16 * 32;
    constexpr int NTILES = T0 + 3 * T1 + T4 + T4 + T6 + T4 + T6;
    for (int it = bid; it < NTILES; it += nb) {
        int r = it;
        if (r < T0) { transpose_tile(p.w_in + (size_t)l * D * INW, p.norm_mix_g + l * D, (bf16_t*)(ws + WS_WIN), D, INW, r, lds); continue; } r -= T0;
        if (r < 3 * T1) { const int b = r / T1; transpose_tile(p.w_branch + ((size_t)l * 3 + b) * 512 * D, nullptr, (bf16_t*)(ws + WS_WBR) + (size_t)b * 1024 * 512, 512, D, r % T1, lds); continue; } r -= 3 * T1;
        if (r < T4) { transpose_tile(p.w_out + (size_t)l * D * D, nullptr, (bf16_t*)(ws + WS_WOUT), D, D, r, lds); continue; } r -= T4;
        if (r < T4) { transpose_tile(p.xa_wq + (size_t)l * D * D, p.norm_xa_g + l * D, (bf16_t*)(ws + WS_WXQ), D, D, r, lds); continue; } r -= T4;
        if (r < T6) { transpose_tile(p.xa_wkv + (size_t)l * D * 2 * D, p.norm_mem_g + l * D, (bf16_t*)(ws + WS_WKV), D, 2 * D, r, lds); continue; } r -= T6;
        if (r < T4) { transpose_tile(p.xa_wo + (size_t)l * D * D, nullptr, (bf16_t*)(ws + WS_WO), D, D, r, lds); continue; } r -= T4;
        transpose_tile(p.peer_wq + (size_t)l * D * PQW, p.norm_ffn_g + l * D, (bf16_t*)(ws + WS_WPQ), D, PQW, r, lds);
    }
    const size_t gt = (size_t)bid * NT + get_tid(), gn = (size_t)nb * NT;
    const f32x4* u4 = (const f32x4*)(p.peer_u + (size_t)l * NEXP * D); const f32x4* v4 = (const f32x4*)(p.peer_v + (size_t)l * NEXP * D);
    const f32x4* g4 = (const f32x4*)(p.norm_ffn_g + l * D);
    u32x2* ub = (u32x2*)(ws + WS_U); u32x2* vb = (u32x2*)(ws + WS_V);
    for (size_t i = gt; i < (size_t)NEXP * D / 4; i += gn) {
        const f32x4 a = u4[i], g = g4[i & 255], b = v4[i];
        u32x2 w; w.x = pk2(a.x * g.x, a.y * g.y); w.y = pk2(a.z * g.z, a.w * g.w); ub[i] = w;
        u32x2 z; z.x = pk2(b.x, b.y); z.y = pk2(b.z, b.w); vb[i] = z;
    }
    const f32x4* k4 = (const f32x4*)(p.peer_keys + (size_t)l * 8 * 2 * 128 * 128); u32x2* kb = (u32x2*)(ws + WS_KEYS);
    for (size_t i = gt; i < (size_t)8 * 2 * 128 * 128 / 4; i += gn) { const f32x4 a = k4[i]; u32x2 w; w.x = pk2(a.x, a.y); w.y = pk2(a.z, a.w); kb[i] = w; }
}

namespace pg8 {
#define PG8_LAS __attribute__((address_space(3)))
constexpr int BM = 256, BK = 64, HALF = 128, HTB = HALF * BK * 2  , STAGE_BYTES = 8 * HTB, NXCD = 8, WGM = 8;

__host__ __device__ __forceinline__ int lds_byte(int r, int c) { const int st = (r >> 4) * 2 + (c >> 5), rr = r & 15, cc = c & 31, ob = rr * 64 + cc * 2; return st * 1024 + (ob ^ (((ob >> 9) & 1) << 5)); }
__host__ __device__ __forceinline__ void stage_rc(int b, int& R, int& C) { const int st = b / 1024, sb = b % 1024, swz = sb ^ (((sb >> 9) & 1) << 5); R = (st >> 1) * 16 + swz / 64; C = (st & 1) * 32 + (swz % 64) / 2; }
__host__ __device__ __forceinline__ int perm32(int rho) { const int n = rho >> 4, i = rho & 15; return 8 * (i >> 2) + 4 * n + (i & 3); }

struct Unit { int pm, pn, pb; };
struct Gemm { const bf16_t* A; const bf16_t* Bt; int K; size_t a_bs, b_bs; };

struct StaticOrder {
    int nM, nN, nwg, G, c;
    __host__ __device__ void init(int M, int N, int G_, int c_) { nM = M / BM; nN = N / BM; nwg = nM * nN; G = G_; c = c_; }
    __host__ __device__ bool next(int i, Unit& u) const {
        const long L = (long)i * G + c; if (L >= nwg) return false;
        int wgid = (int)L; { const int q = nwg / NXCD, r = nwg % NXCD, xcd = wgid % NXCD, off = wgid / NXCD; wgid = (xcd < r ? xcd * (q + 1) : r * (q + 1) + (xcd - r) * q) + off; }
        const int nig = WGM * nN, gid = wgid / nig, fm = gid * WGM, gsz = (nM - fm) < WGM ? (nM - fm) : WGM;
        u.pm = fm + ((wgid % nig) % gsz); u.pn = (wgid % nig) / gsz; u.pb = 0; return true;
    }
    __device__ __forceinline__ void a_ready(const Unit&) const {}
    __device__ __forceinline__ void done(const Unit&) const {}
};
__device__ __forceinline__ unsigned cvt_pk_bf16(float lo, float hi) { unsigned r; asm volatile("v_cvt_pk_bf16_f32 %0, %1, %2" : "=v"(r) : "v"(lo), "v"(hi)); return r; }
template <class Epi, class Sched, bool ALIGN_EPI = false, bool SP2 = false>
__device__ __forceinline__ void gemm_phase(PG8_LAS unsigned char* lds, const Gemm g, const Sched& S, const Epi& E) {
    const int tid = get_tid(), wid = __builtin_amdgcn_readfirstlane(tid >> 6), lane = tid & 63, wr = wid >> 2, wc = wid & 3, fr = lane & 15, fq = lane >> 4;
    const int K = g.K, nt = K / BK;
    unsigned voffA[2], voffB[2];
#pragma unroll
    for (int i = 0; i < 2; ++i) { int R, C; stage_rc(tid * 16 + i * 8192, R, C); const int Rb = Epi::PERM ? ((R & ~31) + perm32(R & 31)) : R;
        voffA[i] = (unsigned)(R * K + C) * 2u; voffB[i] = (unsigned)(Rb * K + C) * 2u; }
    const size_t kstep = (size_t)(BK * 2);
    const size_t hstep = (size_t)HALF * K * 2;
    const size_t tstep = 2 * hstep;
    const unsigned ldsw = (unsigned)wid * 1024u;
    const int aoff = lds_byte(wr * 64 + fr, fq * 8), boff = lds_byte(wc * 32 + fr, fq * 8);
#define PG8_SA(b, h) (((b) * 2 + (h)) * HTB)
#define PG8_SB(b, h) ((4 + (b) * 2 + (h)) * HTB)
#define PG8_STAGE(bufoff, gbase, voff) do { _Pragma("unroll") for (int _i = 0; _i < 2; ++_i) \
        __builtin_amdgcn_global_load_lds((const unsigned*)((const char*)(gbase) + (voff)[_i]), (PG8_LAS unsigned*)(lds + (bufoff) + ldsw + _i * 8192), 16, 0, 0); } while (0)
#define PG8_LDA(dst, b, h) do { _Pragma("unroll") for (int m = 0; m < 4; ++m) _Pragma("unroll") for (int k = 0; k < 2; ++k) dst[m][k] = *(const PG8_LAS bf16x8*)(lds + PG8_SA(b, h) + aoff + m * 2048 + k * 1024); } while (0)
#define PG8_LDB(dst, b, h) do { _Pragma("unroll") for (int n = 0; n < 2; ++n) _Pragma("unroll") for (int k = 0; k < 2; ++k) dst[n][k] = *(const PG8_LAS bf16x8*)(lds + PG8_SB(b, h) + boff + n * 2048 + k * 1024); } while (0)
#define PG8_MMA(ai, bj, At, Bt) do { __builtin_amdgcn_s_setprio(1); _Pragma("unroll") for (int m = 0; m < 4; ++m) _Pragma("unroll") for (int n = 0; n < 2; ++n) _Pragma("unroll") for (int k = 0; k < 2; ++k) \
        acc[ai][bj][m][n] = __builtin_amdgcn_mfma_f32_16x16x32_bf16(Bt[n][k], At[m][k], acc[ai][bj][m][n], 0, 0, 0); __builtin_amdgcn_s_setprio(0); } while (0)
#define PG8_WAIT_V(n) asm volatile("s_waitcnt vmcnt(" #n ")" ::: "memory")
#define PG8_WAIT_L(n) asm volatile("s_waitcnt lgkmcnt(" #n ")" ::: "memory")
#define PG8_BAR __builtin_amdgcn_s_barrier()
#define PG8_SCHED __builtin_amdgcn_sched_barrier(0)
    Unit cur, nxt; int ui = 0;
    if (!S.next(0, cur)) return;
    f32x4 acc[2][2][4][2];
#pragma unroll
    for (int a = 0; a < 2; ++a)
#pragma unroll
        for (int b = 0; b < 2; ++b)
#pragma unroll
            for (int m = 0; m < 4; ++m)
#pragma unroll
                for (int n = 0; n < 2; ++n) acc[a][b][m][n] = (f32x4){0.f, 0.f, 0.f, 0.f};
    bf16x8 At[4][2], B0[2][2], B1[2][2];
    const char* cA = (const char*)g.A + (size_t)cur.pm * tstep + (size_t)cur.pb * g.a_bs; const char* cB = (const char*)g.Bt + (size_t)cur.pn * tstep + (size_t)cur.pb * g.b_bs;
    S.a_ready(cur);
    if constexpr (SP2) {
        PG8_STAGE(PG8_SB(0, 0), cB, voffB); PG8_STAGE(PG8_SB(0, 1), cB + hstep, voffB); PG8_STAGE(PG8_SA(0, 0), cA, voffA); PG8_STAGE(PG8_SA(0, 1), cA + hstep, voffA);
        if (wr == 1) PG8_BAR;
        PG8_WAIT_V(2); PG8_BAR;
        PG8_STAGE(PG8_SB(1, 0), cB + kstep, voffB); PG8_STAGE(PG8_SA(1, 0), cA + kstep, voffA); PG8_STAGE(PG8_SB(1, 1), cB + hstep + kstep, voffB);
        PG8_WAIT_V(6); PG8_BAR;
    } else {
        PG8_STAGE(PG8_SB(0, 0), cB, voffB); PG8_STAGE(PG8_SA(0, 0), cA, voffA); PG8_STAGE(PG8_SB(0, 1), cB + hstep, voffB); PG8_STAGE(PG8_SA(0, 1), cA + hstep, voffA);
        if (wr == 1) PG8_BAR;
        PG8_WAIT_V(4); PG8_BAR;
        PG8_STAGE(PG8_SB(1, 0), cB + kstep, voffB); PG8_STAGE(PG8_SA(1, 0), cA + kstep, voffA); PG8_STAGE(PG8_SB(1, 1), cB + hstep + kstep, voffB);
        PG8_WAIT_V(6); PG8_BAR;
    }
    for (;;) {
        const bool has_next = S.next(ui + 1, nxt);
        const char* nA = has_next ? (const char*)g.A + (size_t)nxt.pm * tstep + (size_t)nxt.pb * g.a_bs : cA; const char* nB = has_next ? (const char*)g.Bt + (size_t)nxt.pn * tstep + (size_t)nxt.pb * g.b_bs : cB;
        for (int t = 0; t < nt; t += 2) {
            const bool last = (t == nt - 2);
            const char* a1 = cA + (size_t)(t + 1) * kstep;
            const char* a2 = last ? nA : cA + (size_t)(t + 2) * kstep; const char* b2 = last ? nB : cB + (size_t)(t + 2) * kstep;
            const char* a3 = a2 + kstep; const char* b3 = b2 + kstep;
            if (last && has_next) S.a_ready(nxt);
            if constexpr (SP2) {
            PG8_LDB(B0, 0, 0); PG8_LDB(B1, 0, 1); PG8_SCHED; PG8_LDA(At, 0, 0); PG8_STAGE(PG8_SA(1, 1), a1 + hstep, voffA);
            PG8_WAIT_V(8); PG8_WAIT_L(0); PG8_BAR; PG8_MMA(0, 0, At, B0); PG8_MMA(0, 1, At, B1); PG8_BAR; PG8_SCHED;
            PG8_LDA(At, 0, 1); PG8_STAGE(PG8_SB(0, 0), b2, voffB); PG8_STAGE(PG8_SB(0, 1), b2 + hstep, voffB); PG8_STAGE(PG8_SA(0, 0), a2, voffA);
            PG8_WAIT_V(8); PG8_WAIT_L(0); PG8_BAR; PG8_MMA(1, 0, At, B0); PG8_MMA(1, 1, At, B1); PG8_BAR; PG8_SCHED;
            PG8_LDB(B0, 1, 0); PG8_LDB(B1, 1, 1); PG8_SCHED; PG8_LDA(At, 1, 0); PG8_STAGE(PG8_SA(0, 1), a2 + hstep, voffA);
            PG8_WAIT_V(8); PG8_WAIT_L(0); PG8_BAR; PG8_MMA(0, 0, At, B0); PG8_MMA(0, 1, At, B1); PG8_BAR; PG8_SCHED;
            PG8_LDA(At, 1, 1); PG8_STAGE(PG8_SB(1, 0), b3, voffB); PG8_STAGE(PG8_SB(1, 1), b3 + hstep, voffB); PG8_STAGE(PG8_SA(1, 0), a3, voffA);
            PG8_WAIT_V(8); PG8_WAIT_L(0); PG8_BAR; PG8_MMA(1, 0, At, B0); PG8_MMA(1, 1, At, B1); PG8_BAR; PG8_SCHED;
            } else {
            PG8_LDB(B0, 0, 0); PG8_SCHED; PG8_LDA(At, 0, 0); PG8_STAGE(PG8_SA(1, 1), a1 + hstep, voffA);
            PG8_WAIT_L(8); PG8_BAR; PG8_WAIT_L(0); PG8_MMA(0, 0, At, B0); PG8_BAR; PG8_SCHED;
            PG8_LDB(B1, 0, 1); PG8_STAGE(PG8_SB(0, 0), b2, voffB);
            PG8_BAR; PG8_WAIT_L(0); PG8_MMA(0, 1, At, B1); PG8_BAR;
            PG8_LDA(At, 0, 1); PG8_STAGE(PG8_SA(0, 0), a2, voffA);
            PG8_BAR; PG8_WAIT_L(0); PG8_MMA(1, 0, At, B0); PG8_BAR; PG8_SCHED;
            PG8_STAGE(PG8_SB(0, 1), b2 + hstep, voffB);
            PG8_WAIT_V(6); PG8_BAR; PG8_MMA(1, 1, At, B1); PG8_BAR;
            PG8_LDB(B0, 1, 0); PG8_SCHED; PG8_LDA(At, 1, 0); PG8_STAGE(PG8_SA(0, 1), a2 + hstep, voffA);
            PG8_WAIT_L(8); PG8_BAR; PG8_WAIT_L(0); PG8_MMA(0, 0, At, B0); PG8_BAR; PG8_SCHED;
            PG8_LDB(B1, 1, 1); PG8_STAGE(PG8_SB(1, 0), b3, voffB);
            PG8_BAR; PG8_WAIT_L(0); PG8_MMA(0, 1, At, B1); PG8_BAR;
            PG8_LDA(At, 1, 1); PG8_STAGE(PG8_SA(1, 0), a3, voffA);
            PG8_BAR; PG8_WAIT_L(0); PG8_MMA(1, 0, At, B0); PG8_BAR; PG8_SCHED;
            PG8_STAGE(PG8_SB(1, 1), b3 + hstep, voffB);
            PG8_WAIT_V(6); PG8_BAR; PG8_MMA(1, 1, At, B1); PG8_BAR;
            }
        }
        if constexpr (ALIGN_EPI) { if (wr == 0) PG8_BAR; }
        if constexpr (!Epi::AFTER_DRAIN) { E(acc, cur, wr, wc, fr, fq); S.done(cur); }
        if (!has_next) break;
        if (!E.keep(cur))
#pragma unroll
        for (int a = 0; a < 2; ++a)
#pragma unroll
            for (int b = 0; b < 2; ++b)
#pragma unroll
                for (int m = 0; m < 4; ++m)
#pragma unroll
                    for (int n = 0; n < 2; ++n) acc[a][b][m][n] = (f32x4){0.f, 0.f, 0.f, 0.f};
        cur = nxt; cA = nA; cB = nB; ++ui;
        if constexpr (ALIGN_EPI) { if (wr == 1) PG8_BAR; }
    }
    PG8_WAIT_V(0);
    if constexpr (!ALIGN_EPI) { if (wr == 0) PG8_BAR; }
    PG8_BAR;
    if constexpr (Epi::AFTER_DRAIN) { E.fused(acc, cur, wr, wc, fr, fq, lds, wid, lane); S.done(cur); }
#undef PG8_SA
#undef PG8_SB
#undef PG8_STAGE
#undef PG8_LDA
#undef PG8_LDB
#undef PG8_MMA
#undef PG8_WAIT_V
#undef PG8_WAIT_L
#undef PG8_BAR
#undef PG8_SCHED
}

struct TripleOrder {
    StaticOrder so;
    __device__ void init(int M, int N, int G_, int c_) { so.init(M, N, G_, c_); }
    __device__ bool next(int i, Unit& u) const { if (!so.next(i / 3, u)) return false; u.pb = i % 3; return true; }
    __device__ __forceinline__ void a_ready(const Unit&) const {}
    __device__ __forceinline__ void done(const Unit&) const {}
};
__device__ __forceinline__ float row_rs(const float* ssq, int row, int fq) {
    const f32x4 v = *(const f32x4*)(ssq + (size_t)row * 16 + 4 * fq);
    float s = (v.x + v.y) + (v.z + v.w); s += __shfl_xor(s, 16); s += __shfl_xor(s, 32);
    return rsqrtf(s * (1.0f / 1024.0f) + 1e-6f);
}
struct EpiScale {
    static constexpr bool PERM = true, AFTER_DRAIN = false;
    bf16_t* O; int ldo; const float* ssq; int ncol0; float s0;
    __device__ __forceinline__ bool keep(const Unit&) const { return false; }
    __device__ __forceinline__ void operator()(f32x4 (&acc)[2][2][4][2], const Unit& u, int wr, int wc, int fr, int fq) const {
        const int row0 = u.pm * BM + wr * 64 + fr, col0 = u.pn * BM + wc * 32 + 8 * fq;
#pragma unroll
        for (int ai = 0; ai < 2; ++ai)
#pragma unroll
            for (int m = 0; m < 4; ++m) {
                const int row = row0 + ai * HALF + m * 16;
                const float rs = row_rs(ssq, row, fq);
#pragma unroll
                for (int bj = 0; bj < 2; ++bj) {
                    const int c = col0 + bj * HALF; const float sc = rs * (c < ncol0 ? s0 : 1.0f);
                    const f32x4 v0 = acc[ai][bj][m][0] * sc, v1 = acc[ai][bj][m][1] * sc;
                    u32x4 w; w.x = cvt_pk_bf16(v0[0], v0[1]); w.y = cvt_pk_bf16(v0[2], v0[3]); w.z = cvt_pk_bf16(v1[0], v1[1]); w.w = cvt_pk_bf16(v1[2], v1[3]);
                    *(u32x4*)(O + (size_t)row * ldo + c) = w;
                }
            }
    }
};
struct EpiResidual {
    static constexpr bool PERM = true, AFTER_DRAIN = false;
    float* H; bf16_t* HB; float* ssq;
    __device__ __forceinline__ bool keep(const Unit&) const { return false; }
    __device__ __forceinline__ void operator()(f32x4 (&acc)[2][2][4][2], const Unit& u, int wr, int wc, int fr, int fq) const {
        const int row0 = u.pm * BM + wr * 64 + fr, col0 = u.pn * BM + wc * 32 + 8 * fq;
#pragma unroll
        for (int ai = 0; ai < 2; ++ai)
#pragma unroll
            for (int m = 0; m < 4; ++m) {
                const int row = row0 + ai * HALF + m * 16; float sq = 0.f;
#pragma unroll
                for (int bj = 0; bj < 2; ++bj) {
                    const int c = col0 + bj * HALF;
                    f32x4* hp = (f32x4*)(H + (size_t)row * D + c);
                    const f32x4 a = hp[0] + acc[ai][bj][m][0], b = hp[1] + acc[ai][bj][m][1];
                    hp[0] = a; hp[1] = b;
                    u32x4 w; w.x = cvt_pk_bf16(a[0], a[1]); w.y = cvt_pk_bf16(a[2], a[3]); w.z = cvt_pk_bf16(b[0], b[1]); w.w = cvt_pk_bf16(b[2], b[3]);
                    *(u32x4*)(HB + (size_t)row * D + c) = w;
                    sq += (a[0] * a[0] + a[1] * a[1]) + (a[2] * a[2] + a[3] * a[3]) + (b[0] * b[0] + b[1] * b[1]) + (b[2] * b[2] + b[3] * b[3]);
                }
                sq += __shfl_xor(sq, 16); sq += __shfl_xor(sq, 32);
                if (fq == 0) ssq[(size_t)row * 16 + u.pn * 4 + wc] = sq;
            }
    }
};
struct EpiMerged {
    static constexpr bool PERM = true, AFTER_DRAIN = false;
    const bf16_t* Pg;
    const float* bg;
    bf16_t* O;
    __device__ __forceinline__ bool keep(const Unit& u) const { return u.pb < 2; }
    __device__ __forceinline__ void operator()(f32x4 (&acc)[2][2][4][2], const Unit& u, int wr, int wc, int fr, int fq) const {
        const int row0 = u.pm * BM + wr * 64 + fr, col0 = u.pn * BM + wc * 32 + 8 * fq, b = u.pb;
        f32x4 bb[2][2], bn[2][2];
#pragma unroll
        for (int bj = 0; bj < 2; ++bj)
#pragma unroll
            for (int n = 0; n < 2; ++n) {
                bb[bj][n] = *(const f32x4*)(bg + b * D + col0 + bj * HALF + 4 * n);
                bn[bj][n] = (b < 2) ? *(const f32x4*)(bg + (b + 1) * D + col0 + bj * HALF + 4 * n) : (f32x4){0.f, 0.f, 0.f, 0.f};
            }
#pragma unroll
        for (int ai = 0; ai < 2; ++ai)
#pragma unroll
            for (int m = 0; m < 4; ++m) {
                const int row = row0 + ai * HALF + m * 16;
#pragma unroll
                for (int bj = 0; bj < 2; ++bj) {
                    const int c = col0 + bj * HALF;
                    const bf16_t* gp = Pg + (size_t)row * INW + b * D + c;
                    const u32x4 zb = *(const u32x4*)gp;
                    u32x4 zn = (u32x4){0u, 0u, 0u, 0u};
                    if (b < 2) zn = *(const u32x4*)(gp + D);
                    float f[8];
#pragma unroll
                    for (int j = 0; j < 8; ++j) {
                        const unsigned wb = zb[j >> 1], wn = zn[j >> 1];
                        const float z0 = ((j & 1) ? bfhi(wb) : bflo(wb)) + bb[bj][j >> 2][j & 3];
                        const float e0 = 1.0f + __expf(-fmaxf(z0, -30.f));
                        float num = 1.0f;
                        if (b < 2) { const float z1 = ((j & 1) ? bfhi(wn) : bflo(wn)) + bn[bj][j >> 2][j & 3]; num = 1.0f + __expf(-fmaxf(z1, -30.f)); }
                        f[j] = num * __builtin_amdgcn_rcpf(e0);
                    }
                    f32x4 v0 = acc[ai][bj][m][0], v1 = acc[ai][bj][m][1];
                    v0[0] *= f[0]; v0[1] *= f[1]; v0[2] *= f[2]; v0[3] *= f[3]; v1[0] *= f[4]; v1[1] *= f[5]; v1[2] *= f[6]; v1[3] *= f[7];
                    acc[ai][bj][m][0] = v0; acc[ai][bj][m][1] = v1;
                    if (b == 2) {
                        u32x4 w; w.x = cvt_pk_bf16(v0[0], v0[1]); w.y = cvt_pk_bf16(v0[2], v0[3]); w.z = cvt_pk_bf16(v1[0], v1[1]); w.w = cvt_pk_bf16(v1[2], v1[3]);
                        *(u32x4*)(O + (size_t)row * D + c) = w;
                    }
                }
            }
    }
};
}

typedef __attribute__((address_space(3))) unsigned char* lds_ptr;
__device__ __forceinline__ void ph_gemm_p(const P& p, int bid, int nb, lds_ptr lds) {
    pg8::Gemm g{(const bf16_t*)(p.ws + WS_HB), (const bf16_t*)(p.ws + WS_WIN), D, 0, 0}; pg8::StaticOrder S; S.init(T, INW, nb, bid);
    pg8::EpiScale E{(bf16_t*)(p.ws + WS_P), INW, (const float*)(p.ws + WS_SSQ), 512, 0.125f};
    pg8::gemm_phase<pg8::EpiScale, pg8::StaticOrder, true, true>(lds, g, S, E);
}
__device__ __forceinline__ void ph_gemm_kv(const P& p, int bid, int nb, lds_ptr lds) {
    pg8::Gemm g{(const bf16_t*)(p.ws + WS_MEMB), (const bf16_t*)(p.ws + WS_WKV), D, 0, 0}; pg8::StaticOrder S; S.init(TM, 2 * D, nb, bid);
    pg8::EpiScale E{(bf16_t*)(p.ws + WS_KV), 2 * D, (const float*)(p.ws + WS_MEMSSQ), 0, 1.f};
    pg8::gemm_phase<pg8::EpiScale, pg8::StaticOrder, true, true>(lds, g, S, E);
}
__device__ __forceinline__ void ph_merged(const P& p, int l, int bid, int nb, lds_ptr lds) {
    pg8::Gemm g{(const bf16_t*)(p.ws + WS_Y), (const bf16_t*)(p.ws + WS_WBR), 512, (size_t)T * 512 * 2, (size_t)1024 * 512 * 2}; pg8::TripleOrder S; S.init(T, D, nb, bid);
    pg8::EpiMerged E{(const bf16_t*)(p.ws + WS_P) + OFF_GATE, p.b_gate + (size_t)l * 3 * D, (bf16_t*)(p.ws + WS_MERGED)};
    pg8::gemm_phase<pg8::EpiMerged, pg8::TripleOrder, true, true>(lds, g, S, E);
}
__device__ __forceinline__ void ph_gemm_wout(const P& p, int bid, int nb, lds_ptr lds) {
    pg8::Gemm g{(const bf16_t*)(p.ws + WS_MERGED), (const bf16_t*)(p.ws + WS_WOUT), D, 0, 0}; pg8::StaticOrder S; S.init(T, D, nb, bid);
    pg8::EpiResidual E{p.out, (bf16_t*)(p.ws + WS_HB), (float*)(p.ws + WS_SSQ)};
    pg8::gemm_phase<pg8::EpiResidual, pg8::StaticOrder, true, true>(lds, g, S, E);
}
__device__ __forceinline__ void ph_gemm_xq(const P& p, int bid, int nb, lds_ptr lds) {
    pg8::Gemm g{(const bf16_t*)(p.ws + WS_HB), (const bf16_t*)(p.ws + WS_WXQ), D, 0, 0}; pg8::StaticOrder S; S.init(T, D, nb, bid);
    pg8::EpiScale E{(bf16_t*)(p.ws + WS_XQ), D, (const float*)(p.ws + WS_SSQ), D, 0.0625f};
    pg8::gemm_phase<pg8::EpiScale, pg8::StaticOrder, true, true>(lds, g, S, E);
}
__device__ __forceinline__ void ph_gemm_wo(const P& p, int bid, int nb, lds_ptr lds) {
    pg8::Gemm g{(const bf16_t*)(p.ws + WS_XO), (const bf16_t*)(p.ws + WS_WO), D, 0, 0}; pg8::StaticOrder S; S.init(T, D, nb, bid);
    pg8::EpiResidual E{p.out, (bf16_t*)(p.ws + WS_HB), (float*)(p.ws + WS_SSQ)};
    pg8::gemm_phase<pg8::EpiResidual, pg8::StaticOrder, true, true>(lds, g, S, E);
}
__device__ __forceinline__ void ph_gemm_pq(const P& p, int bid, int nb, lds_ptr lds) {
    pg8::Gemm g{(const bf16_t*)(p.ws + WS_HB), (const bf16_t*)(p.ws + WS_WPQ), D, 0, 0}; pg8::StaticOrder S; S.init(T, PQW, nb, bid);
    pg8::EpiScale E{(bf16_t*)(p.ws + WS_PQ), PQW, (const float*)(p.ws + WS_SSQ), 0, 1.f};
    pg8::gemm_phase<pg8::EpiScale, pg8::StaticOrder, true, true>(lds, g, S, E);
}

__device__ __forceinline__ void ph_sb_attn(const P& p, int bid, int nb) {
    const int tid = get_tid(), lane = tid & 63, wid = __builtin_amdgcn_readfirstlane(tid >> 6);
    const bf16_t* pp = (const bf16_t*)(p.ws + WS_P); bf16_t* Y = (bf16_t*)(p.ws + WS_Y);
    const int gw = bid * 8 + wid, ngw = nb * 8;
    for (int task = gw; task < 64 * 32; task += ngw) {
        const int tb = 31 - (task >> 6), bh = task & 63, b = bh >> 3, h = bh & 7;
        const int t = tb * 64 + lane;
        float q[64], o[64];
        {
            const u32x4* qp = (const u32x4*)(pp + (size_t)(b * SEQ + t) * INW + h * 64);
#pragma unroll
            for (int i = 0; i < 8; ++i) { const u32x4 w = qp[i]; q[8 * i] = bflo(w.x); q[8 * i + 1] = bfhi(w.x); q[8 * i + 2] = bflo(w.y); q[8 * i + 3] = bfhi(w.y);
                q[8 * i + 4] = bflo(w.z); q[8 * i + 5] = bfhi(w.z); q[8 * i + 6] = bflo(w.w); q[8 * i + 7] = bfhi(w.w); }
        }
#pragma unroll
        for (int i = 0; i < 64; ++i) o[i] = 0.f;
        float carry = 0.f;
        for (int s = tb * 64 + 62; s >= 0; --s) {
            const unsigned* kp = (const unsigned*)(pp + (size_t)(b * SEQ + s) * INW + 512 + h * 64);
            const unsigned* vp = kp + 256;
            float z0 = 0.f, z1 = 0.f;
#pragma unroll
            for (int i = 0; i < 32; ++i) { const unsigned w = kp[i]; z0 = fmaf(q[2 * i], bflo(w), z0); z1 = fmaf(q[2 * i + 1], bfhi(w), z1); }
            const float z = z0 + z1;
            const bool valid = s < t;
            const float sp = fmaxf(z, 0.f) + log1pf(expf(-fabsf(z)));
            const float a = valid ? expf((z - sp) + carry) : 0.f;
            carry += valid ? -sp : 0.f;
#pragma unroll
            for (int i = 0; i < 32; ++i) { const unsigned w = vp[i]; o[2 * i] = fmaf(a, bflo(w), o[2 * i]); o[2 * i + 1] = fmaf(a, bfhi(w), o[2 * i + 1]); }
            if (__all(carry < -110.f)) break;
        }
        u32x4* yp = (u32x4*)(Y + (size_t)(b * SEQ + t) * 512 + h * 64);
#pragma unroll
        for (int i = 0; i < 8; ++i) { u32x4 w; w.x = pk2(o[8 * i], o[8 * i + 1]); w.y = pk2(o[8 * i + 2], o[8 * i + 3]); w.z = pk2(o[8 * i + 4], o[8 * i + 5]); w.w = pk2(o[8 * i + 6], o[8 * i + 7]); yp[i] = w; }
    }
}
__device__ __forceinline__ void ph_conv(const P& p, int l, int bid, int nb, float* lds) {
    const int tid = get_tid(), lane = tid & 63, wid = tid >> 6, c = tid;
    const bf16_t* pp = (const bf16_t*)(p.ws + WS_P); bf16_t* Y = (bf16_t*)(p.ws + WS_Y);
    const float* dw = p.conv_dw_w + (size_t)l * 31 * 512; const float* scw = p.sc_w + (size_t)l * 3 * 512;
    const float db = p.conv_dw_b[l * 512 + c], lg = p.conv_ln_g[l * 512 + c], lb = p.conv_ln_b[l * 512 + c];
    for (int tok = bid; tok < T; tok += nb) {
        const int t = tok % SEQ;
        float acc = db;
        for (int j = 0; j < 31; ++j) {
            const int tt = t - 30 + j;
            if (tt >= 0) {
                const bf16_t* r = pp + (size_t)(tok - 30 + j) * INW;
                const float val = bf2f(r[OFF_CV + c]), gt = bf2f(r[OFF_CV + 512 + c]);
                acc = fmaf(dw[j * 512 + c], val * sigmoidf_(gt), acc);
            }
        }
        float s = wave_sum(acc);
        if (lane == 0) lds[wid] = s;
        __syncthreads();
        float mean = 0.f;
#pragma unroll
        for (int i = 0; i < 8; ++i) mean += lds[i];
        mean *= (1.0f / 512.0f);
        const float d = acc - mean;
        float s2 = wave_sum(d * d);
        if (lane == 0) lds[8 + wid] = s2;
        __syncthreads();
        float var = 0.f;
#pragma unroll
        for (int i = 0; i < 8; ++i) var += lds[8 + i];
        var *= (1.0f / 512.0f);
        const float yv = d * rsqrtf(var + 1e-5f) * lg + lb;
        Y[(size_t)T * 512 + (size_t)tok * 512 + c] = (bf16_t)f2bf(yv * sigmoidf_(yv));
        float sc = 0.f;
#pragma unroll
        for (int j = 0; j < 3; ++j) {
            const int tt = t - 2 + j;
            if (tt >= 0) { const bf16_t* r = pp + (size_t)(tok - 2 + j) * INW; sc = fmaf(scw[j * 512 + c], bf2f(r[OFF_SC + 512 + c]) * bf2f(r[OFF_SC + 1024 + c]), sc); }
        }
        Y[(size_t)2 * T * 512 + (size_t)tok * 512 + c] = (bf16_t)f2bf(bf2f(pp[(size_t)tok * INW + OFF_SC + c]) * sc);
        __syncthreads();
    }
}

__device__ __forceinline__ void ph_xattn(const P& p, int bid, int nb, float* lds) {
    const int tid = get_tid(), lane = tid & 63, wid = tid >> 6;
    const bf16_t* XQ = (const bf16_t*)(p.ws + WS_XQ); const bf16_t* KV = (const bf16_t*)(p.ws + WS_KV); bf16_t* XO = (bf16_t*)(p.ws + WS_XO);
    float* qs = lds + wid * 512; float* as = qs + 256;
    const int gw = bid * 8 + wid, ngw = nb * 8;
    for (int task = gw; task < T * 4; task += ngw) {
        const int tok = task >> 2, hd = task & 3, b = tok / SEQ;
        { const u32x2 w = *(const u32x2*)(XQ + (size_t)tok * D + hd * 256 + lane * 4); qs[lane * 4] = bflo(w.x); qs[lane * 4 + 1] = bfhi(w.x); qs[lane * 4 + 2] = bflo(w.y); qs[lane * 4 + 3] = bfhi(w.y); }
        __builtin_amdgcn_s_waitcnt(0);
        float sc[4];
#pragma unroll
        for (int j = 0; j < 4; ++j) {
            const int m = lane + 64 * j;
            const u32x4* kp = (const u32x4*)(KV + (size_t)(b * NMEM + m) * 2 * D + hd * 256);
            float z = 0.f;
#pragma unroll 4
            for (int i = 0; i < 32; ++i) { const u32x4 w = kp[i]; const float* qq = qs + 8 * i;
                z = fmaf(qq[0], bflo(w.x), z); z = fmaf(qq[1], bfhi(w.x), z); z = fmaf(qq[2], bflo(w.y), z); z = fmaf(qq[3], bfhi(w.y), z);
                z = fmaf(qq[4], bflo(w.z), z); z = fmaf(qq[5], bfhi(w.z), z); z = fmaf(qq[6], bflo(w.w), z); z = fmaf(qq[7], bfhi(w.w), z); }
            sc[j] = z;
        }
        const float mx = wave_max(fmaxf(fmaxf(sc[0], sc[1]), fmaxf(sc[2], sc[3])));
        float e[4], es = 0.f;
#pragma unroll
        for (int j = 0; j < 4; ++j) { e[j] = __expf(sc[j] - mx); es += e[j]; }
        es = wave_sum(es);
        const float inv = 1.0f / es;
#pragma unroll
        for (int j = 0; j < 4; ++j) as[lane + 64 * j] = e[j] * inv;
        __builtin_amdgcn_s_waitcnt(0);
        float o0 = 0.f, o1 = 0.f, o2 = 0.f, o3 = 0.f;
        const bf16_t* vb = KV + (size_t)(b * NMEM) * 2 * D + D + hd * 256 + lane * 4;
        for (int m = 0; m < NMEM; ++m) { const u32x2 w = *(const u32x2*)(vb + (size_t)m * 2 * D); const float a = as[m];
            o0 = fmaf(a, bflo(w.x), o0); o1 = fmaf(a, bfhi(w.x), o1); o2 = fmaf(a, bflo(w.y), o2); o3 = fmaf(a, bfhi(w.y), o3); }
        u32x2 w; w.x = pk2(o0, o1); w.y = pk2(o2, o3);
        *(u32x2*)(XO + (size_t)tok * D + hd * 256 + lane * 4) = w;
    }
}

__device__ __forceinline__ void wave_argmax(float& v, int& i) {
#pragma unroll
    for (int o = 1; o < 64; o <<= 1) { const float ov = __shfl_xor(v, o); const int oi = __shfl_xor(i, o); if (ov > v || (ov == v && oi < i)) { v = ov; i = oi; } }
}
__device__ __forceinline__ void ph_peer_score(const P& p, int bid, int nb, float* lds) {
    const int tid = get_tid(), lane = tid & 63, wid = tid >> 6;
    const bf16_t* PQ = (const bf16_t*)(p.ws + WS_PQ); const bf16_t* KEYS = (const bf16_t*)(p.ws + WS_KEYS);
    int* PIDX = (int*)(p.ws + WS_PIDX); float* PG = (float*)(p.ws + WS_PG);
    float* qs = lds + wid * 512;
    float* sv = qs + 256;
    int* si = (int*)(sv + 32);
    float* st = sv + 64;
    int* sci = (int*)(sv + 80);
    const int gw = bid * 8 + wid, ngw = nb * 8;
    for (int task = gw; task < T * 8; task += ngw) {
        const int tok = task >> 3, h = task & 7;
        { const u32x2 w = *(const u32x2*)(PQ + (size_t)tok * PQW + h * 256 + lane * 4); qs[lane * 4] = bflo(w.x); qs[lane * 4 + 1] = bfhi(w.x); qs[lane * 4 + 2] = bflo(w.y); qs[lane * 4 + 3] = bfhi(w.y); }
        __builtin_amdgcn_s_waitcnt(0);
#pragma unroll
        for (int pp = 0; pp < 2; ++pp) {
            float a[2];
#pragma unroll
            for (int jj = 0; jj < 2; ++jj) {
                const int n = lane + 64 * jj;
                const u32x4* kp = (const u32x4*)(KEYS + ((size_t)(h * 2 + pp) * 128 + n) * 128);
                const float* qq = qs + pp * 128; float z = 0.f;
#pragma unroll 4
                for (int i = 0; i < 16; ++i) { const u32x4 w = kp[i]; const float* q8 = qq + 8 * i;
                    z = fmaf(q8[0], bflo(w.x), z); z = fmaf(q8[1], bfhi(w.x), z); z = fmaf(q8[2], bflo(w.y), z); z = fmaf(q8[3], bfhi(w.y), z);
                    z = fmaf(q8[4], bflo(w.z), z); z = fmaf(q8[5], bfhi(w.z), z); z = fmaf(q8[6], bflo(w.w), z); z = fmaf(q8[7], bfhi(w.w), z); }
                a[jj] = z;
            }
#pragma unroll 1
            for (int k = 0; k < 16; ++k) {
                float v; int i;
                if (a[0] >= a[1]) { v = a[0]; i = lane; } else { v = a[1]; i = lane + 64; }
                wave_argmax(v, i);
                if (i == lane) a[0] = -INFINITY;
                if (i == lane + 64) a[1] = -INFINITY;
                if (lane == 0) { sv[pp * 16 + k] = v; si[pp * 16 + k] = i; }
            }
        }
        __builtin_amdgcn_s_waitcnt(0);
        float cnd[4];
#pragma unroll
        for (int j = 0; j < 4; ++j) { const int ci = lane * 4 + j; cnd[j] = sv[ci >> 4] + sv[16 + (ci & 15)]; }
#pragma unroll 1
        for (int k = 0; k < 16; ++k) {
            float v = cnd[0]; int i = lane * 4;
#pragma unroll
            for (int j = 1; j < 4; ++j) if (cnd[j] > v) { v = cnd[j]; i = lane * 4 + j; }
            wave_argmax(v, i);
#pragma unroll
            for (int j = 0; j < 4; ++j) if (i == lane * 4 + j) cnd[j] = -INFINITY;
            if (lane == 0) { st[k] = v; sci[k] = i; }
        }
        __builtin_amdgcn_s_waitcnt(0);
        if (lane < 16) {
            const float mx = st[0]; float sum = 0.f;
#pragma unroll
            for (int k = 0; k < 16; ++k) sum += __expf(st[k] - mx);
            const int ci = sci[lane];
            PIDX[(size_t)tok * 128 + h * 16 + lane] = si[ci >> 4] * 128 + si[16 + (ci & 15)];
            PG[(size_t)tok * 128 + h * 16 + lane] = __expf(st[lane] - mx) / sum;
        }
        __builtin_amdgcn_s_waitcnt(0);
    }
}
__device__ __forceinline__ void ph_peer_gather(const P& p, int l, int bid, int nb) {
    const int tid = get_tid(), lane = tid & 63, wid = __builtin_amdgcn_readfirstlane(tid >> 6);
    const bf16_t* HB = (const bf16_t*)(p.ws + WS_HB); float* SSQ = (float*)(p.ws + WS_SSQ);
    const bf16_t* U = (const bf16_t*)(p.ws + WS_U); const bf16_t* V = (const bf16_t*)(p.ws + WS_V);
    const int* PIDX = (const int*)(p.ws + WS_PIDX); const float* PG = (const float*)(p.ws + WS_PG);
    const int gw = bid * 8 + wid, ngw = nb * 8;
    for (int tok = gw; tok < T; tok += ngw) {
        float xv[16];
        {
            const u32x4 w0 = *(const u32x4*)(HB + (size_t)tok * D + lane * 8), w1 = *(const u32x4*)(HB + (size_t)tok * D + 512 + lane * 8);
            xv[0] = bflo(w0.x); xv[1] = bfhi(w0.x); xv[2] = bflo(w0.y); xv[3] = bfhi(w0.y); xv[4] = bflo(w0.z); xv[5] = bfhi(w0.z); xv[6] = bflo(w0.w); xv[7] = bfhi(w0.w);
            xv[8] = bflo(w1.x); xv[9] = bfhi(w1.x); xv[10] = bflo(w1.y); xv[11] = bfhi(w1.y); xv[12] = bflo(w1.z); xv[13] = bfhi(w1.z); xv[14] = bflo(w1.w); xv[15] = bfhi(w1.w);
        }
        const float rs = rsqrtf(wave_sum(lane < 16 ? SSQ[(size_t)tok * 16 + lane] : 0.f) * (1.0f / D) + 1e-6f);
        float o[16];
#pragma unroll
        for (int i = 0; i < 16; ++i) o[i] = 0.f;
        for (int e = 0; e < 128; ++e) {
            const int idx = __builtin_amdgcn_readfirstlane(PIDX[(size_t)tok * 128 + e]);
            const float g = PG[(size_t)tok * 128 + e];
            const u32x4 u0 = *(const u32x4*)(U + (size_t)idx * D + lane * 8), u1 = *(const u32x4*)(U + (size_t)idx * D + 512 + lane * 8);
            float d = xv[0] * bflo(u0.x);
            d = fmaf(xv[1], bfhi(u0.x), d); d = fmaf(xv[2], bflo(u0.y), d); d = fmaf(xv[3], bfhi(u0.y), d); d = fmaf(xv[4], bflo(u0.z), d); d = fmaf(xv[5], bfhi(u0.z), d);
            d = fmaf(xv[6], bflo(u0.w), d); d = fmaf(xv[7], bfhi(u0.w), d); d = fmaf(xv[8], bflo(u1.x), d); d = fmaf(xv[9], bfhi(u1.x), d); d = fmaf(xv[10], bflo(u1.y), d);
            d = fmaf(xv[11], bfhi(u1.y), d); d = fmaf(xv[12], bflo(u1.z), d); d = fmaf(xv[13], bfhi(u1.z), d); d = fmaf(xv[14], bflo(u1.w), d); d = fmaf(xv[15], bfhi(u1.w), d);
            const float a = wave_sum(d) * rs;
            const float w = g * 0.5f * a * (1.0f + erff(a * 0.70710678118654752f));
            const u32x4 v0 = *(const u32x4*)(V + (size_t)idx * D + lane * 8), v1 = *(const u32x4*)(V + (size_t)idx * D + 512 + lane * 8);
            o[0] = fmaf(w, bflo(v0.x), o[0]); o[1] = fmaf(w, bfhi(v0.x), o[1]); o[2] = fmaf(w, bflo(v0.y), o[2]); o[3] = fmaf(w, bfhi(v0.y), o[3]);
            o[4] = fmaf(w, bflo(v0.z), o[4]); o[5] = fmaf(w, bfhi(v0.z), o[5]); o[6] = fmaf(w, bflo(v0.w), o[6]); o[7] = fmaf(w, bfhi(v0.w), o[7]);
            o[8] = fmaf(w, bflo(v1.x), o[8]); o[9] = fmaf(w, bfhi(v1.x), o[9]); o[10] = fmaf(w, bflo(v1.y), o[10]); o[11] = fmaf(w, bfhi(v1.y), o[11]);
            o[12] = fmaf(w, bflo(v1.z), o[12]); o[13] = fmaf(w, bfhi(v1.z), o[13]); o[14] = fmaf(w, bflo(v1.w), o[14]); o[15] = fmaf(w, bfhi(v1.w), o[15]);
        }
        float* hrow = p.out + (size_t)tok * D;
        f32x4 h0 = *(f32x4*)(hrow + lane * 8), h1 = *(f32x4*)(hrow + lane * 8 + 4), h2 = *(f32x4*)(hrow + 512 + lane * 8), h3 = *(f32x4*)(hrow + 512 + lane * 8 + 4);
        h0.x += o[0]; h0.y += o[1]; h0.z += o[2]; h0.w += o[3]; h1.x += o[4]; h1.y += o[5]; h1.z += o[6]; h1.w += o[7];
        h2.x += o[8]; h2.y += o[9]; h2.z += o[10]; h2.w += o[11]; h3.x += o[12]; h3.y += o[13]; h3.z += o[14]; h3.w += o[15];
        float ss = h0.x * h0.x + h0.y * h0.y + h0.z * h0.z + h0.w * h0.w + h1.x * h1.x + h1.y * h1.y + h1.z * h1.z + h1.w * h1.w
                 + h2.x * h2.x + h2.y * h2.y + h2.z * h2.z + h2.w * h2.w + h3.x * h3.x + h3.y * h3.y + h3.z * h3.z + h3.w * h3.w;
        ss = wave_sum(ss);
        const float nrs = rsqrtf(ss * (1.0f / D) + 1e-6f);
        if (l == DEPTH - 1) {
            const f32x4 g0 = *(const f32x4*)(p.final_g + lane * 8), g1 = *(const f32x4*)(p.final_g + lane * 8 + 4), g2 = *(const f32x4*)(p.final_g + 512 + lane * 8), g3 = *(const f32x4*)(p.final_g + 512 + lane * 8 + 4);
            *(f32x4*)(hrow + lane * 8) = h0 * nrs * g0; *(f32x4*)(hrow + lane * 8 + 4) = h1 * nrs * g1;
            *(f32x4*)(hrow + 512 + lane * 8) = h2 * nrs * g2; *(f32x4*)(hrow + 512 + lane * 8 + 4) = h3 * nrs * g3;
        } else {
            *(f32x4*)(hrow + lane * 8) = h0; *(f32x4*)(hrow + lane * 8 + 4) = h1; *(f32x4*)(hrow + 512 + lane * 8) = h2; *(f32x4*)(hrow + 512 + lane * 8 + 4) = h3;
            u32x4 w0, w1;
            w0.x = pk2(h0.x, h0.y); w0.y = pk2(h0.z, h0.w); w0.z = pk2(h1.x, h1.y); w0.w = pk2(h1.z, h1.w);
            w1.x = pk2(h2.x, h2.y); w1.y = pk2(h2.z, h2.w); w1.z = pk2(h3.x, h3.y); w1.w = pk2(h3.z, h3.w);
            bf16_t* hb = (bf16_t*)(p.ws + WS_HB) + (size_t)tok * D;
            *(u32x4*)(hb + lane * 8) = w0; *(u32x4*)(hb + 512 + lane * 8) = w1;
            if (lane < 16) SSQ[(size_t)tok * 16 + lane] = lane == 0 ? ss : 0.f;
        }
    }
}

namespace cg = cooperative_groups;
constexpr int LDS_BYTES = 147456;
__global__ void __launch_bounds__(NT, 2) mega_fwd(P p) {
    extern __shared__ __attribute__((aligned(16))) unsigned char smem[];
    float* lds = (float*)smem;
    const lds_ptr ldsr = (lds_ptr)smem;
    cg::grid_group grid = cg::this_grid();
    const int bid = blockIdx.x, nb = gridDim.x;
#define PH(call) do { P q = p; asm volatile("" : "+s"(q.ws), "+s"(q.out) :: "memory"); call; } while (0)
    PH(ph_prologue(q, bid, nb));
#pragma unroll 1
    for (int l = 0; l < DEPTH; ++l) {
        PH(ph_prep_weights(q, l, bid, nb, lds)); grid.sync();
        PH(ph_gemm_p(q, bid, nb, ldsr)); PH(ph_gemm_kv(q, bid, nb, ldsr)); grid.sync();
        PH(ph_sb_attn(q, bid, nb)); PH(ph_conv(q, l, bid, nb, lds)); grid.sync();
        PH(ph_merged(q, l, bid, nb, ldsr)); grid.sync();
        PH(ph_gemm_wout(q, bid, nb, ldsr)); grid.sync();
        PH(ph_gemm_xq(q, bid, nb, ldsr)); grid.sync();
        PH(ph_xattn(q, bid, nb, lds)); grid.sync();
        PH(ph_gemm_wo(q, bid, nb, ldsr)); grid.sync();
        PH(ph_gemm_pq(q, bid, nb, ldsr)); grid.sync();
        PH(ph_peer_score(q, bid, nb, lds)); grid.sync();
        PH(ph_peer_gather(q, l, bid, nb)); grid.sync();
    }
#undef PH
}

extern "C" void kernel_launch(void* const* d_in, const int* in_sizes, int n_in, void* d_out, int out_size, void* d_ws, size_t ws_size, hipStream_t stream) {
    static int grid = 0;
    if (grid == 0) {
        int dev = 0, cus = 0, per_cu = 0;
        hipGetDevice(&dev);
        hipDeviceGetAttribute(&cus, hipDeviceAttributeMultiprocessorCount, dev);
        hipFuncSetAttribute((const void*)mega_fwd, hipFuncAttributeMaxDynamicSharedMemorySize, LDS_BYTES);
        hipOccupancyMaxActiveBlocksPerMultiprocessor(&per_cu, (const void*)mega_fwd, NT, LDS_BYTES);
        if (per_cu < 1) per_cu = 1;
        grid = cus * per_cu;
        if (ws_size < WS_END) { fprintf(stderr, "kernel_launch: workspace too small (%zu < %zu)\n", ws_size, (size_t)WS_END); grid = -1; }
    }
    if (grid < 0) return;
    P p{};
    const float** pp = (const float**)&p;
    for (int i = 0; i < 23; ++i) pp[i] = (const float*)d_in[i];
    p.out = (float*)d_out; p.ws = (unsigned char*)d_ws;
    void* args[] = {&p};
    hipError_t e = hipLaunchCooperativeKernel((void*)mega_fwd, dim3(grid), dim3(NT), args, LDS_BYTES, stream);
    if (e != hipSuccess) fprintf(stderr, "cooperative launch failed: %s (grid %d)\n", hipGetErrorString(e), grid);
}
```

```cpp
#include <hip/hip_runtime.h>
#include <hip/hip_cooperative_groups.h>
#include <cstdio>
#include <stdint.h>
#include <math.h>

constexpr int D = 1024, BATCH = 8, SEQ = 2048, T = BATCH * SEQ, DEPTH = 2, NMEM = 256, TM = BATCH * NMEM;
constexpr int INW = 7168, OFF_CV = 1536, OFF_SC = 2560, OFF_GATE = 4096;
constexpr int YW = 1536;
constexpr int NEXP = 16384, PQW = 2048;
constexpr int NT = 512;

typedef uint16_t bf16_t;
typedef short bf16x8 __attribute__((ext_vector_type(8)));
typedef float f32x4 __attribute__((ext_vector_type(4)));
typedef unsigned u32x4 __attribute__((ext_vector_type(4)));
typedef unsigned u32x2 __attribute__((ext_vector_type(2)));
#define GAS __attribute__((address_space(1)))

constexpr size_t MiB = 1u << 20;
constexpr size_t WS_CTL = 0;
constexpr size_t WS_WIN = 1 * MiB;
constexpr size_t WS_WBR = 15 * MiB;
constexpr size_t WS_WOUT = 18 * MiB;
constexpr size_t WS_WXQ = 20 * MiB;
constexpr size_t WS_WKV = 22 * MiB;
constexpr size_t WS_WO = 26 * MiB;
constexpr size_t WS_WPQ = 28 * MiB;
constexpr size_t WS_KEYS = 32 * MiB;
constexpr size_t WS_U = 33 * MiB;
constexpr size_t WS_V = 49 * MiB;
constexpr size_t WS_USC = 65 * MiB;
constexpr size_t WS_VSC = 65 * MiB + 65536;
constexpr size_t WS_HB = 97 * MiB;
constexpr size_t WS_SSQ = 129 * MiB;
constexpr size_t WS_MEMSSQ = 256 * 1024;
constexpr size_t WS_MEMB = 130 * MiB;
constexpr size_t WS_KV = 134 * MiB;
constexpr size_t WS_Y = 142 * MiB;
constexpr size_t WS_MERGED = 190 * MiB;
constexpr size_t WS_P = 222 * MiB;
constexpr size_t WS_XQ = 222 * MiB;
constexpr size_t WS_XO = 254 * MiB;
constexpr size_t WS_PQ = 286 * MiB;
constexpr size_t WS_PIDX = 350 * MiB;
constexpr size_t WS_PG = 358 * MiB;
constexpr size_t WS_VT = 446 * MiB;
constexpr size_t WS_SBVT = 450 * MiB;
constexpr size_t WS_WKV2 = 466 * MiB;
constexpr size_t WS_KV2 = 474 * MiB;
constexpr size_t WS_VT2 = 490 * MiB;
constexpr size_t WS_END = 498 * MiB;

struct P {
    const float *x, *mem, *norm_mix_g, *w_in, *conv_dw_w, *conv_dw_b, *conv_ln_g, *conv_ln_b, *sc_w, *w_branch, *b_gate, *w_out,
        *norm_xa_g, *norm_mem_g, *xa_wq, *xa_wkv, *xa_wo, *norm_ffn_g, *peer_wq, *peer_keys, *peer_u, *peer_v, *final_g;
    float* out;
    unsigned char* ws;
};

__device__ __forceinline__ unsigned f2bf(float f) { unsigned u = __float_as_uint(f); return (u + 0x7fffu + ((u >> 16) & 1u)) >> 16; }
__device__ __forceinline__ unsigned pk2(float lo, float hi) { return f2bf(lo) | (f2bf(hi) << 16); }
__device__ __forceinline__ float bflo(unsigned w) { return __uint_as_float(w << 16); }
__device__ __forceinline__ float bfhi(unsigned w) { return __uint_as_float(w & 0xffff0000u); }
__device__ __forceinline__ float bf2f(bf16_t h) { return __uint_as_float(((unsigned)h) << 16); }
constexpr int LDS_BYTES = 147456;
constexpr int LDS_WTAB = LDS_BYTES - 512;
extern __shared__ __attribute__((aligned(16))) unsigned char smem[];
__device__ __forceinline__ int get_tid() {
    const unsigned hw = __builtin_amdgcn_s_getreg((5 << 11) | 4);
    const int w = ((volatile __attribute__((address_space(3))) int*)((__attribute__((address_space(3))) unsigned char*)smem + LDS_WTAB))[hw];
    unsigned ones = ~0u; asm volatile("" : "+s"(ones));
    int t = (w << 6) | (int)__builtin_amdgcn_mbcnt_hi(ones, __builtin_amdgcn_mbcnt_lo(ones, 0u));
    asm volatile("" : "+v"(t)); return t; }
__device__ __forceinline__ float shx(float v, int m, int lane) { return __uint_as_float((unsigned)__builtin_amdgcn_ds_bpermute((lane ^ m) << 2, (int)__float_as_uint(v))); }
template <int CTRL> __device__ __forceinline__ float dppf(float x) { return __uint_as_float((unsigned)__builtin_amdgcn_update_dpp(0, (int)__float_as_uint(x), CTRL, 0xF, 0xF, false)); }
__device__ __forceinline__ float swap32_sum(float a, float b) { auto r = __builtin_amdgcn_permlane32_swap(__float_as_uint(a), __float_as_uint(b), false, false); return __uint_as_float(r[0]) + __uint_as_float(r[1]); }
__device__ __forceinline__ float swap16_sum(float a, float b) { auto r = __builtin_amdgcn_permlane16_swap(__float_as_uint(a), __float_as_uint(b), false, false); return __uint_as_float(r[0]) + __uint_as_float(r[1]); }
__device__ __forceinline__ float wave_sum2(float x) {
    x += dppf<0x128>(x); x += dppf<0x124>(x); x += dppf<0x122>(x); x += dppf<0x121>(x);
    x = swap16_sum(x, x); x = swap32_sum(x, x); return x; }
__device__ __forceinline__ float wave_sum(float v, int) { return wave_sum2(v); }
__device__ __forceinline__ float wave_max(float x, int) {
    x = fmaxf(x, dppf<0x128>(x)); x = fmaxf(x, dppf<0x124>(x)); x = fmaxf(x, dppf<0x122>(x)); x = fmaxf(x, dppf<0x121>(x));
    { auto r = __builtin_amdgcn_permlane16_swap(__float_as_uint(x), __float_as_uint(x), false, false); x = fmaxf(__uint_as_float(r[0]), __uint_as_float(r[1])); }
    { auto r = __builtin_amdgcn_permlane32_swap(__float_as_uint(x), __float_as_uint(x), false, false); x = fmaxf(__uint_as_float(r[0]), __uint_as_float(r[1])); }
    return x; }
__device__ __forceinline__ float sigmoidf_(float z) { return 1.0f / (1.0f + __expf(-z)); }

__device__ __forceinline__ void row_to_bf16_rs(const float* src, float* dst_f32, bf16_t* dst_bf, float* rs_out, int lane) {
    const f32x4* s4 = (const f32x4*)src + lane;
    f32x4 v[4]; float ss = 0.f;
#pragma unroll
    for (int j = 0; j < 4; ++j) { v[j] = s4[64 * j]; ss += v[j].x * v[j].x + v[j].y * v[j].y + v[j].z * v[j].z + v[j].w * v[j].w; }
    ss = wave_sum(ss, lane);
    if (dst_f32) {
#pragma unroll
        for (int j = 0; j < 4; ++j) ((f32x4*)dst_f32 + lane)[64 * j] = v[j];
    }
#pragma unroll
    for (int j = 0; j < 4; ++j) { u32x2 w; w.x = pk2(v[j].x, v[j].y); w.y = pk2(v[j].z, v[j].w); ((u32x2*)dst_bf + lane)[64 * j] = w; }
    if (lane < 16) rs_out[lane] = lane == 0 ? ss : 0.f;
}
__device__ __forceinline__ void ph_prologue(const P& p, int bid, int nb) {
    const int tid = get_tid(), lane = tid & 63, wid = tid >> 6;
    const int gw = bid * 8 + wid, ngw = nb * 8;
    bf16_t* hb = (bf16_t*)(p.ws + WS_HB); float* rs = (float*)(p.ws + WS_SSQ);
    bf16_t* memb = (bf16_t*)(p.ws + WS_MEMB); float* mrs = (float*)(p.ws + WS_MEMSSQ);
    for (int r = gw; r < T; r += ngw) row_to_bf16_rs(p.x + (size_t)r * D, nullptr, hb + (size_t)r * D, rs + (size_t)r * 16, lane);
    for (int r = gw; r < TM; r += ngw) row_to_bf16_rs(p.mem + (size_t)r * D, nullptr, memb + (size_t)r * D, mrs + (size_t)r * 16, lane);
}
__device__ __forceinline__ void transpose_item(const float* W_, const float* g_, bf16_t* Wt_, int K, int N, int item, __attribute__((address_space(3))) float* scr, int lane) {
    const GAS float* W = (const GAS float*)W_; const GAS float* g = (const GAS float*)g_; GAS bf16_t* Wt = (GAS bf16_t*)Wt_;
    const int nblk = N / 32, kb = item / nblk, nbk = item % nblk, k0 = 64 * kb, n0 = 32 * nbk;
    float v[32];
#pragma unroll
    for (int i = 0; i < 32; ++i) { const int kk = 2 * i + (lane >> 5); v[i] = W[(size_t)(k0 + kk) * N + n0 + (lane & 31)]; }
    if (g_ != nullptr) {
#pragma unroll
        for (int i = 0; i < 32; ++i) v[i] *= g[k0 + 2 * i + (lane >> 5)];
    }
#pragma unroll
    for (int i = 0; i < 32; ++i) scr[(2 * i + (lane >> 5)) * 33 + (lane & 31)] = v[i];
    const int c = lane & 7;
#pragma unroll
    for (int j = 0; j < 4; ++j) {
        const int n = (lane >> 3) + 8 * j; const __attribute__((address_space(3))) float* sp = scr + (8 * c) * 33 + n;
        u32x4 o; o.x = pk2(sp[0 * 33], sp[1 * 33]); o.y = pk2(sp[2 * 33], sp[3 * 33]); o.z = pk2(sp[4 * 33], sp[5 * 33]); o.w = pk2(sp[6 * 33], sp[7 * 33]);
        *(GAS u32x4*)(Wt + (size_t)(n0 + n) * K + k0 + 8 * c) = o;
    }
}
__device__ __forceinline__ void ph_prep_weights(const P& p, int l, int bid, int nb, __attribute__((address_space(3))) float* ldsf) {
    unsigned char* ws = p.ws;
    {
        const int tid = get_tid(), lane = tid & 63, wid = __builtin_amdgcn_readfirstlane(tid >> 6);
        __attribute__((address_space(3))) float* scr = ldsf + wid * (64 * 33);
        constexpr int I0 = 16 * 224, I1 = 8 * 32, I4 = 16 * 32, I6 = 16 * 64;
        constexpr int NITEMS = I0 + 3 * I1 + I4 + I4 + I6 + I4 + I6;
#pragma unroll 1
        for (int it = bid * 8 + wid; it < NITEMS; it += nb * 8) {
            int r = it;
            if (r < I0) { transpose_item(p.w_in + (size_t)l * D * INW, p.norm_mix_g + l * D, (bf16_t*)(ws + WS_WIN), D, INW, r, scr, lane); continue; } r -= I0;
            if (r < 3 * I1) { const int b = r / I1; transpose_item(p.w_branch + ((size_t)l * 3 + b) * 512 * D, nullptr, (bf16_t*)(ws + WS_WBR) + (size_t)b * 1024 * 512, 512, D, r % I1, scr, lane); continue; } r -= 3 * I1;
            if (r < I4) { transpose_item(p.w_out + (size_t)l * D * D, nullptr, (bf16_t*)(ws + WS_WOUT), D, D, r, scr, lane); continue; } r -= I4;
            if (r < I4) { transpose_item(p.xa_wq + (size_t)l * D * D, p.norm_xa_g + l * D, (bf16_t*)(ws + WS_WXQ), D, D, r, scr, lane); continue; } r -= I4;
            if (r < I6) { if (l == 0) { transpose_item(p.xa_wkv, p.norm_mem_g, (bf16_t*)(ws + WS_WKV2), D, 2 * D, r, scr, lane); transpose_item(p.xa_wkv + (size_t)D * 2 * D, p.norm_mem_g + D, (bf16_t*)(ws + WS_WKV2) + (size_t)2 * D * D, D, 2 * D, r, scr, lane); } continue; } r -= I6;
            if (r < I4) { transpose_item(p.xa_wo + (size_t)l * D * D, nullptr, (bf16_t*)(ws + WS_WO), D, D, r, scr, lane); continue; } r -= I4;
            transpose_item(p.peer_wq + (size_t)l * D * PQW, p.norm_ffn_g + l * D, (bf16_t*)(ws + WS_WPQ), D, PQW, r, scr, lane);
        }
    }
    {
        const int tid = get_tid(), lane = tid & 63, wid = tid >> 6;
        const f32x4* g4 = (const f32x4*)(p.norm_ffn_g + l * D) + 4 * lane;
        const f32x4 gg0 = g4[0], gg1 = g4[1], gg2 = g4[2], gg3 = g4[3];
#pragma unroll 1
        for (int row0 = bid * 8 + wid; row0 < 2 * NEXP; row0 += 2 * nb * 8) {
            f32x4 a[2][4];
#pragma unroll
            for (int h2 = 0; h2 < 2; ++h2) {
                const int row = row0 + h2 * nb * 8; const bool isv = row >= NEXP; const int e = isv ? row - NEXP : row;
                const GAS f32x4* src = (const GAS f32x4*)((isv ? p.peer_v : p.peer_u) + ((size_t)l * NEXP + (row < 2 * NEXP ? e : 0)) * D) + 4 * lane;
                a[h2][0] = src[0]; a[h2][1] = src[1]; a[h2][2] = src[2]; a[h2][3] = src[3];
            }
#pragma unroll
            for (int h2 = 0; h2 < 2; ++h2) {
                const int row = row0 + h2 * nb * 8; const bool isv = row >= NEXP; const int e = isv ? row - NEXP : row;
                if (row < 2 * NEXP) {
                    f32x4 a0 = a[h2][0], a1 = a[h2][1], a2 = a[h2][2], a3 = a[h2][3];
                    if (!isv) { a0 *= gg0; a1 *= gg1; a2 *= gg2; a3 *= gg3; }
                    float m = 0.f;
#pragma unroll
                    for (int i = 0; i < 4; ++i) m = fmaxf(m, fmaxf(fmaxf(fabsf(a0[i]), fabsf(a1[i])), fmaxf(fabsf(a2[i]), fabsf(a3[i]))));
                    m = wave_max(m, lane);
                    const float sc = m > 0.f ? 240.0f / m : 1.0f;
                    u32x4 w;
                    w.x = (unsigned)__builtin_amdgcn_cvt_pk_fp8_f32(a0[2] * sc, a0[3] * sc, __builtin_amdgcn_cvt_pk_fp8_f32(a0[0] * sc, a0[1] * sc, 0, false), true);
                    w.y = (unsigned)__builtin_amdgcn_cvt_pk_fp8_f32(a1[2] * sc, a1[3] * sc, __builtin_amdgcn_cvt_pk_fp8_f32(a1[0] * sc, a1[1] * sc, 0, false), true);
                    w.z = (unsigned)__builtin_amdgcn_cvt_pk_fp8_f32(a2[2] * sc, a2[3] * sc, __builtin_amdgcn_cvt_pk_fp8_f32(a2[0] * sc, a2[1] * sc, 0, false), true);
                    w.w = (unsigned)__builtin_amdgcn_cvt_pk_fp8_f32(a3[2] * sc, a3[3] * sc, __builtin_amdgcn_cvt_pk_fp8_f32(a3[0] * sc, a3[1] * sc, 0, false), true);
                    ((GAS u32x4*)(ws + (isv ? WS_V : WS_U)) + (size_t)e * 64)[lane] = w;
                    if (lane == 0) ((GAS float*)(ws + (isv ? WS_VSC : WS_USC)))[e] = m > 0.f ? m * (1.0f / 240.0f) : 1.0f;
                }
            }
        }
    }
    const size_t gt = (size_t)bid * NT + get_tid(), gn = (size_t)nb * NT;
    const f32x4* k4 = (const f32x4*)(p.peer_keys + (size_t)l * 8 * 2 * 128 * 128); u32x2* kb = (u32x2*)(ws + WS_KEYS);
    for (size_t i = gt; i < (size_t)8 * 2 * 128 * 128 / 4; i += gn) { const f32x4 a = k4[i]; u32x2 w; w.x = pk2(a.x, a.y); w.y = pk2(a.z, a.w); kb[i] = w; }
}

namespace pg8 {
#define PG8_LAS __attribute__((address_space(3)))
constexpr int BM = 256, BK = 64, HALF = 128, HTB = HALF * BK * 2  , STAGE_BYTES = 8 * HTB, NXCD = 8, WGM = 8;

__host__ __device__ __forceinline__ int lds_byte(int r, int c) { const int st = (r >> 4) * 2 + (c >> 5), rr = r & 15, cc = c & 31, ob = rr * 64 + cc * 2; return st * 1024 + (ob ^ (((ob >> 9) & 1) << 5)); }
__host__ __device__ __forceinline__ void stage_rc(int b, int& R, int& C) { const int st = b / 1024, sb = b % 1024, swz = sb ^ (((sb >> 9) & 1) << 5); R = (st >> 1) * 16 + swz / 64; C = (st & 1) * 32 + (swz % 64) / 2; }
__host__ __device__ __forceinline__ int perm32(int rho) { const int n = rho >> 4, i = rho & 15; return 8 * (i >> 2) + 4 * n + (i & 3); }

struct Unit { int pm, pn, pb; };
struct Gemm { const bf16_t* A; const bf16_t* Bt; int K; size_t a_bs, b_bs; };

struct StaticOrder {
    int nM, nN, nwg, G, c;
    __host__ __device__ void init(int M, int N, int G_, int c_) { nM = M / BM; nN = N / BM; nwg = nM * nN; G = G_; c = c_; }
    __host__ __device__ bool next(int i, Unit& u) const {
        const long L = (long)i * G + c; if (L >= nwg) return false;
        int wgid = (int)L; { const int q = nwg / NXCD, r = nwg % NXCD, xcd = wgid % NXCD, off = wgid / NXCD; wgid = (xcd < r ? xcd * (q + 1) : r * (q + 1) + (xcd - r) * q) + off; }
        const int nig = WGM * nN, gid = wgid / nig, fm = gid * WGM, gsz = (nM - fm) < WGM ? (nM - fm) : WGM;
        u.pm = fm + ((wgid % nig) % gsz); u.pn = (wgid % nig) / gsz; u.pb = 0; return true;
    }
    __device__ __forceinline__ void a_ready(const Unit&) const {}
    __device__ __forceinline__ void done(const Unit&) const {}
};
__device__ __forceinline__ unsigned cvt_pk_bf16(float lo, float hi) { unsigned r; asm volatile("v_cvt_pk_bf16_f32 %0, %1, %2" : "=v"(r) : "v"(lo), "v"(hi)); return r; }
template <class Epi, class Sched, bool ALIGN_EPI = false, bool SP2 = false>
__device__ __forceinline__ void gemm_phase(PG8_LAS unsigned char* lds, const Gemm g, const Sched& S, const Epi& E) {
    const int tid = get_tid(), wid = __builtin_amdgcn_readfirstlane(tid >> 6), lane = tid & 63, wr = wid >> 2, wc = wid & 3, fr = lane & 15, fq = lane >> 4;
    const int K = g.K, nt = K / BK;
    unsigned voffA[2], voffB[2];
#pragma unroll
    for (int i = 0; i < 2; ++i) { int R, C; stage_rc(tid * 16 + i * 8192, R, C); const int Rb = Epi::PERM ? ((R & ~31) + perm32(R & 31)) : R;
        voffA[i] = (unsigned)(R * K + C) * 2u; voffB[i] = (unsigned)(Rb * K + C) * 2u; }
    const size_t kstep = (size_t)(BK * 2);
    const size_t hstep = (size_t)HALF * K * 2;
    const size_t tstep = 2 * hstep;
    const unsigned ldsw = (unsigned)wid * 1024u;
    const int aoff = lds_byte(wr * 64 + fr, fq * 8), boff = lds_byte(wc * 32 + fr, fq * 8);
#define PG8_SA(b, h) (((b) * 2 + (h)) * HTB)
#define PG8_SB(b, h) ((4 + (b) * 2 + (h)) * HTB)
#define PG8_STAGE(bufoff, gbase, voff) do { _Pragma("unroll") for (int _i = 0; _i < 2; ++_i) \
        __builtin_amdgcn_global_load_lds((const unsigned*)((const char*)(gbase) + (voff)[_i]), (PG8_LAS unsigned*)(lds + (bufoff) + ldsw + _i * 8192), 16, 0, 0); } while (0)
#define PG8_LDA(dst, b, h) do { _Pragma("unroll") for (int m = 0; m < 4; ++m) _Pragma("unroll") for (int k = 0; k < 2; ++k) dst[m][k] = *(const PG8_LAS bf16x8*)(lds + PG8_SA(b, h) + aoff + m * 2048 + k * 1024); } while (0)
#define PG8_LDB(dst, b, h) do { _Pragma("unroll") for (int n = 0; n < 2; ++n) _Pragma("unroll") for (int k = 0; k < 2; ++k) dst[n][k] = *(const PG8_LAS bf16x8*)(lds + PG8_SB(b, h) + boff + n * 2048 + k * 1024); } while (0)
#define PG8_MMA(ai, bj, At, Bt) do { __builtin_amdgcn_s_setprio(1); _Pragma("unroll") for (int m = 0; m < 4; ++m) _Pragma("unroll") for (int n = 0; n < 2; ++n) _Pragma("unroll") for (int k = 0; k < 2; ++k) \
        acc[ai][bj][m][n] = __builtin_amdgcn_mfma_f32_16x16x32_bf16(Bt[n][k], At[m][k], acc[ai][bj][m][n], 0, 0, 0); __builtin_amdgcn_s_setprio(0); } while (0)
#define PG8_WAIT_V(n) asm volatile("s_waitcnt vmcnt(" #n ")" ::: "memory")
#define PG8_WAIT_L(n) asm volatile("s_waitcnt lgkmcnt(" #n ")" ::: "memory")
#define PG8_BAR __builtin_amdgcn_s_barrier()
#define PG8_SCHED __builtin_amdgcn_sched_barrier(0)
    Unit cur, nxt; int ui = 0;
    if (!S.next(0, cur)) return;
    f32x4 acc[2][2][4][2];
#pragma unroll
    for (int a = 0; a < 2; ++a)
#pragma unroll
        for (int b = 0; b < 2; ++b)
#pragma unroll
            for (int m = 0; m < 4; ++m)
#pragma unroll
                for (int n = 0; n < 2; ++n) acc[a][b][m][n] = (f32x4){0.f, 0.f, 0.f, 0.f};
    bf16x8 At[4][2], B0[2][2], B1[2][2];
    const char* cA = (const char*)g.A + (size_t)cur.pm * tstep + (size_t)cur.pb * g.a_bs; const char* cB = (const char*)g.Bt + (size_t)cur.pn * tstep + (size_t)cur.pb * g.b_bs;
    S.a_ready(cur);
    if constexpr (SP2) {
        PG8_STAGE(PG8_SB(0, 0), cB, voffB); PG8_STAGE(PG8_SB(0, 1), cB + hstep, voffB); PG8_STAGE(PG8_SA(0, 0), cA, voffA); PG8_STAGE(PG8_SA(0, 1), cA + hstep, voffA);
        if (wr == 1) PG8_BAR;
        PG8_WAIT_V(2); PG8_BAR;
        PG8_STAGE(PG8_SB(1, 0), cB + kstep, voffB); PG8_STAGE(PG8_SA(1, 0), cA + kstep, voffA); PG8_STAGE(PG8_SB(1, 1), cB + hstep + kstep, voffB);
        PG8_WAIT_V(6); PG8_BAR;
    } else {
        PG8_STAGE(PG8_SB(0, 0), cB, voffB); PG8_STAGE(PG8_SA(0, 0), cA, voffA); PG8_STAGE(PG8_SB(0, 1), cB + hstep, voffB); PG8_STAGE(PG8_SA(0, 1), cA + hstep, voffA);
        if (wr == 1) PG8_BAR;
        PG8_WAIT_V(4); PG8_BAR;
        PG8_STAGE(PG8_SB(1, 0), cB + kstep, voffB); PG8_STAGE(PG8_SA(1, 0), cA + kstep, voffA); PG8_STAGE(PG8_SB(1, 1), cB + hstep + kstep, voffB);
        PG8_WAIT_V(6); PG8_BAR;
    }
    for (;;) {
        const bool has_next = S.next(ui + 1, nxt);
        const char* nA = has_next ? (const char*)g.A + (size_t)nxt.pm * tstep + (size_t)nxt.pb * g.a_bs : cA; const char* nB = has_next ? (const char*)g.Bt + (size_t)nxt.pn * tstep + (size_t)nxt.pb * g.b_bs : cB;
        for (int t = 0; t < nt; t += 2) {
            const bool last = (t == nt - 2);
            const char* a1 = cA + (size_t)(t + 1) * kstep;
            const char* a2 = last ? nA : cA + (size_t)(t + 2) * kstep; const char* b2 = last ? nB : cB + (size_t)(t + 2) * kstep;
            const char* a3 = a2 + kstep; const char* b3 = b2 + kstep;
            if (last && has_next) S.a_ready(nxt);
            if constexpr (SP2) {
            PG8_LDB(B0, 0, 0); PG8_LDB(B1, 0, 1); PG8_SCHED; PG8_LDA(At, 0, 0); PG8_STAGE(PG8_SA(1, 1), a1 + hstep, voffA);
            PG8_WAIT_V(8); PG8_WAIT_L(0); PG8_BAR; PG8_MMA(0, 0, At, B0); PG8_MMA(0, 1, At, B1); PG8_BAR; PG8_SCHED;
            PG8_LDA(At, 0, 1); PG8_STAGE(PG8_SB(0, 0), b2, voffB); PG8_STAGE(PG8_SB(0, 1), b2 + hstep, voffB); PG8_STAGE(PG8_SA(0, 0), a2, voffA);
            PG8_WAIT_V(8); PG8_WAIT_L(0); PG8_BAR; PG8_MMA(1, 0, At, B0); PG8_MMA(1, 1, At, B1); PG8_BAR; PG8_SCHED;
            PG8_LDB(B0, 1, 0); PG8_LDB(B1, 1, 1); PG8_SCHED; PG8_LDA(At, 1, 0); PG8_STAGE(PG8_SA(0, 1), a2 + hstep, voffA);
            PG8_WAIT_V(8); PG8_WAIT_L(0); PG8_BAR; PG8_MMA(0, 0, At, B0); PG8_MMA(0, 1, At, B1); PG8_BAR; PG8_SCHED;
            PG8_LDA(At, 1, 1); PG8_STAGE(PG8_SB(1, 0), b3, voffB); PG8_STAGE(PG8_SB(1, 1), b3 + hstep, voffB); PG8_STAGE(PG8_SA(1, 0), a3, voffA);
            PG8_WAIT_V(8); PG8_WAIT_L(0); PG8_BAR; PG8_MMA(1, 0, At, B0); PG8_MMA(1, 1, At, B1); PG8_BAR; PG8_SCHED;
            } else {
            PG8_LDB(B0, 0, 0); PG8_SCHED; PG8_LDA(At, 0, 0); PG8_STAGE(PG8_SA(1, 1), a1 + hstep, voffA);
            PG8_WAIT_L(8); PG8_BAR; PG8_WAIT_L(0); PG8_MMA(0, 0, At, B0); PG8_BAR; PG8_SCHED;
            PG8_LDB(B1, 0, 1); PG8_STAGE(PG8_SB(0, 0), b2, voffB);
            PG8_BAR; PG8_WAIT_L(0); PG8_MMA(0, 1, At, B1); PG8_BAR;
            PG8_LDA(At, 0, 1); PG8_STAGE(PG8_SA(0, 0), a2, voffA);
            PG8_BAR; PG8_WAIT_L(0); PG8_MMA(1, 0, At, B0); PG8_BAR; PG8_SCHED;
            PG8_STAGE(PG8_SB(0, 1), b2 + hstep, voffB);
            PG8_WAIT_V(6); PG8_BAR; PG8_MMA(1, 1, At, B1); PG8_BAR;
            PG8_LDB(B0, 1, 0); PG8_SCHED; PG8_LDA(At, 1, 0); PG8_STAGE(PG8_SA(0, 1), a2 + hstep, voffA);
            PG8_WAIT_L(8); PG8_BAR; PG8_WAIT_L(0); PG8_MMA(0, 0, At, B0); PG8_BAR; PG8_SCHED;
            PG8_LDB(B1, 1, 1); PG8_STAGE(PG8_SB(1, 0), b3, voffB);
            PG8_BAR; PG8_WAIT_L(0); PG8_MMA(0, 1, At, B1); PG8_BAR;
            PG8_LDA(At, 1, 1); PG8_STAGE(PG8_SA(1, 0), a3, voffA);
            PG8_BAR; PG8_WAIT_L(0); PG8_MMA(1, 0, At, B0); PG8_BAR; PG8_SCHED;
            PG8_STAGE(PG8_SB(1, 1), b3 + hstep, voffB);
            PG8_WAIT_V(6); PG8_BAR; PG8_MMA(1, 1, At, B1); PG8_BAR;
            }
        }
        if constexpr (ALIGN_EPI) { if (wr == 0) PG8_BAR; }
        if constexpr (!Epi::AFTER_DRAIN) { E(acc, cur, wr, wc, fr, fq); S.done(cur); }
        if (!has_next) break;
        if (!E.keep(cur))
#pragma unroll
        for (int a = 0; a < 2; ++a)
#pragma unroll
            for (int b = 0; b < 2; ++b)
#pragma unroll
                for (int m = 0; m < 4; ++m)
#pragma unroll
                    for (int n = 0; n < 2; ++n) acc[a][b][m][n] = (f32x4){0.f, 0.f, 0.f, 0.f};
        cur = nxt; cA = nA; cB = nB; ++ui;
        if constexpr (ALIGN_EPI) { if (wr == 1) PG8_BAR; }
    }
    PG8_WAIT_V(0);
    if constexpr (!ALIGN_EPI) { if (wr == 0) PG8_BAR; }
    PG8_BAR;
    if constexpr (Epi::AFTER_DRAIN) { E.fused(acc, cur, wr, wc, fr, fq, lds, wid, lane); S.done(cur); }
#undef PG8_SA
#undef PG8_SB
#undef PG8_STAGE
#undef PG8_LDA
#undef PG8_LDB
#undef PG8_MMA
#undef PG8_WAIT_V
#undef PG8_WAIT_L
#undef PG8_BAR
#undef PG8_SCHED
}

struct TripleOrder {
    StaticOrder so;
    __device__ void init(int M, int N, int G_, int c_) { so.init(M, N, G_, c_); }
    __device__ bool next(int i, Unit& u) const { if (!so.next(i / 3, u)) return false; u.pb = i % 3; return true; }
    __device__ __forceinline__ void a_ready(const Unit&) const {}
    __device__ __forceinline__ void done(const Unit&) const {}
};
__device__ __forceinline__ float row_rs(const float* ssq, int row, int fq, int lane) {
    const f32x4 v = *(const f32x4*)(ssq + (size_t)row * 16 + 4 * fq);
    float s = (v.x + v.y) + (v.z + v.w); s = swap16_sum(s, s); s = swap32_sum(s, s);
    return rsqrtf(s * (1.0f / 1024.0f) + 1e-6f);
}
struct EpiScale {
    static constexpr bool PERM = true, AFTER_DRAIN = false;
    bf16_t* O; int ldo; const float* ssq; int ncol0; float s0; bf16_t* VT;
    const float* gbias;
    __device__ __forceinline__ bool keep(const Unit&) const { return false; }
    __device__ __forceinline__ void operator()(f32x4 (&acc)[2][2][4][2], const Unit& u, int wr, int wc, int fr, int fq) const {
        const int row0 = u.pm * BM + wr * 64 + fr, col0 = u.pn * BM + wc * 32 + 8 * fq;
#pragma unroll
        for (int ai = 0; ai < 2; ++ai)
#pragma unroll
            for (int m = 0; m < 4; ++m) {
                const int row = row0 + ai * HALF + m * 16;
                const float rs = row_rs(ssq, row, fq, fq * 16 + fr);
#pragma unroll
                for (int bj = 0; bj < 2; ++bj) {
                    const int c = col0 + bj * HALF; const float sc = rs * (c < ncol0 ? s0 : 1.0f);
                    f32x4 v0 = acc[ai][bj][m][0] * sc, v1 = acc[ai][bj][m][1] * sc;
                    if (gbias != nullptr && c >= OFF_GATE) {
                        const f32x4 b0 = *(const f32x4*)(gbias + (c - OFF_GATE)), b1 = *(const f32x4*)(gbias + (c - OFF_GATE) + 4);
#pragma unroll
                        for (int e = 0; e < 4; ++e) { v0[e] = 1.0f + __expf(-fmaxf(v0[e] + b0[e], -30.f)); v1[e] = 1.0f + __expf(-fmaxf(v1[e] + b1[e], -30.f)); }
                    }
                    u32x4 w; w.x = cvt_pk_bf16(v0[0], v0[1]); w.y = cvt_pk_bf16(v0[2], v0[3]); w.z = cvt_pk_bf16(v1[0], v1[1]); w.w = cvt_pk_bf16(v1[2], v1[3]);
                    *(u32x4*)(O + (size_t)row * ldo + c) = w;
                    if (VT != nullptr && c >= 1024 && c < 1536) {
                        const int b = row >> 11, sq = row & 2047, cc = c - 1024;
                        bf16_t* vp = VT + ((size_t)(b * 512 + cc)) * 2048 + sq;
                        vp[0 * 2048] = (bf16_t)(w.x & 0xffffu); vp[1 * 2048] = (bf16_t)(w.x >> 16); vp[2 * 2048] = (bf16_t)(w.y & 0xffffu); vp[3 * 2048] = (bf16_t)(w.y >> 16);
                        vp[4 * 2048] = (bf16_t)(w.z & 0xffffu); vp[5 * 2048] = (bf16_t)(w.z >> 16); vp[6 * 2048] = (bf16_t)(w.w & 0xffffu); vp[7 * 2048] = (bf16_t)(w.w >> 16);
                    }
                }
            }
    }
};
struct EpiKV {
    static constexpr bool PERM = true, AFTER_DRAIN = false;
    bf16_t* O; bf16_t* VT; const float* ssq;
    __device__ __forceinline__ bool keep(const Unit&) const { return false; }
    __device__ __forceinline__ void operator()(f32x4 (&acc)[2][2][4][2], const Unit& u, int wr, int wc, int fr, int fq) const {
        const int row0 = u.pm * BM + wr * 64 + fr, col0 = u.pn * BM + wc * 32 + 8 * fq;
#pragma unroll
        for (int ai = 0; ai < 2; ++ai)
#pragma unroll
            for (int m = 0; m < 4; ++m) {
                const int row = row0 + ai * HALF + m * 16;
                const float rs = row_rs(ssq, row, fq, fq * 16 + fr);
#pragma unroll
                for (int bj = 0; bj < 2; ++bj) {
                    const int cfull = col0 + bj * HALF, layer = cfull >> 11, c = cfull & 2047;
                    const f32x4 v0 = acc[ai][bj][m][0] * rs, v1 = acc[ai][bj][m][1] * rs;
                    u32x4 w; w.x = cvt_pk_bf16(v0[0], v0[1]); w.y = cvt_pk_bf16(v0[2], v0[3]); w.z = cvt_pk_bf16(v1[0], v1[1]); w.w = cvt_pk_bf16(v1[2], v1[3]);
                    if (c < 1024) { *(u32x4*)(O + (size_t)layer * TM * 2048 + (size_t)row * 2048 + c) = w; }
                    else {
                        const int b = row >> 8, mem = row & 255, cc = c - 1024;
                        bf16_t* vp = VT + (size_t)layer * (8 * 4 * 256 * 256) + ((size_t)(b * 4 + (cc >> 8)) * 256 + (cc & 255)) * 256 + mem;
                        vp[0 * 256] = (bf16_t)(w.x & 0xffffu); vp[1 * 256] = (bf16_t)(w.x >> 16); vp[2 * 256] = (bf16_t)(w.y & 0xffffu); vp[3 * 256] = (bf16_t)(w.y >> 16);
                        vp[4 * 256] = (bf16_t)(w.z & 0xffffu); vp[5 * 256] = (bf16_t)(w.z >> 16); vp[6 * 256] = (bf16_t)(w.w & 0xffffu); vp[7 * 256] = (bf16_t)(w.w >> 16);
                    }
                }
            }
    }
};
struct EpiResidual {
    static constexpr bool PERM = true, AFTER_DRAIN = false;
    bf16_t* HB; float* ssq;
    __device__ __forceinline__ bool keep(const Unit&) const { return false; }
    __device__ __forceinline__ void operator()(f32x4 (&acc)[2][2][4][2], const Unit& u, int wr, int wc, int fr, int fq) const {
        const int row0 = u.pm * BM + wr * 64 + fr, col0 = u.pn * BM + wc * 32 + 8 * fq;
#pragma unroll
        for (int ai = 0; ai < 2; ++ai)
#pragma unroll
            for (int m = 0; m < 4; ++m) {
                const int row = row0 + ai * HALF + m * 16; float sq = 0.f;
#pragma unroll
                for (int bj = 0; bj < 2; ++bj) {
                    const int c = col0 + bj * HALF;
                    u32x4* hp = (u32x4*)(HB + (size_t)row * D + c);
                    const u32x4 hv = *hp;
                    const f32x4 a = (f32x4){bflo(hv.x), bfhi(hv.x), bflo(hv.y), bfhi(hv.y)} + acc[ai][bj][m][0], b = (f32x4){bflo(hv.z), bfhi(hv.z), bflo(hv.w), bfhi(hv.w)} + acc[ai][bj][m][1];
                    u32x4 w; w.x = cvt_pk_bf16(a[0], a[1]); w.y = cvt_pk_bf16(a[2], a[3]); w.z = cvt_pk_bf16(b[0], b[1]); w.w = cvt_pk_bf16(b[2], b[3]);
                    *hp = w;
                    const float r0 = bflo(w.x), r1 = bfhi(w.x), r2 = bflo(w.y), r3 = bfhi(w.y), r4 = bflo(w.z), r5 = bfhi(w.z), r6 = bflo(w.w), r7 = bfhi(w.w);
                    sq += (r0 * r0 + r1 * r1) + (r2 * r2 + r3 * r3) + (r4 * r4 + r5 * r5) + (r6 * r6 + r7 * r7);
                }
                sq = swap16_sum(sq, sq); sq = swap32_sum(sq, sq);
                if (fq == 0) ssq[(size_t)row * 16 + u.pn * 4 + wc] = sq;
            }
    }
};
struct EpiMerged {
    static constexpr bool PERM = true, AFTER_DRAIN = false;
    const bf16_t* Pg;
    bf16_t* O;
    __device__ __forceinline__ bool keep(const Unit& u) const { return u.pb < 2; }
    __device__ __forceinline__ void operator()(f32x4 (&acc)[2][2][4][2], const Unit& u, int wr, int wc, int fr, int fq) const {
        const int row0 = u.pm * BM + wr * 64 + fr, col0 = u.pn * BM + wc * 32 + 8 * fq, b = u.pb;
#pragma unroll
        for (int ai = 0; ai < 2; ++ai)
#pragma unroll
            for (int m = 0; m < 4; ++m) {
                const int row = row0 + ai * HALF + m * 16;
#pragma unroll
                for (int bj = 0; bj < 2; ++bj) {
                    const int c = col0 + bj * HALF;
                    const bf16_t* gp = Pg + (size_t)row * INW + b * D + c;
                    const u32x4 eb = *(const u32x4*)gp;
                    u32x4 en = (u32x4){0x3f803f80u, 0x3f803f80u, 0x3f803f80u, 0x3f803f80u};
                    if (b < 2) en = *(const u32x4*)(gp + D);
                    float f[8];
#pragma unroll
                    for (int j = 0; j < 8; ++j) {
                        const unsigned wb = eb[j >> 1], wn = en[j >> 1];
                        f[j] = ((j & 1) ? bfhi(wn) : bflo(wn)) * __builtin_amdgcn_rcpf((j & 1) ? bfhi(wb) : bflo(wb));
                    }
                    f32x4 v0 = acc[ai][bj][m][0], v1 = acc[ai][bj][m][1];
                    v0[0] *= f[0]; v0[1] *= f[1]; v0[2] *= f[2]; v0[3] *= f[3]; v1[0] *= f[4]; v1[1] *= f[5]; v1[2] *= f[6]; v1[3] *= f[7];
                    acc[ai][bj][m][0] = v0; acc[ai][bj][m][1] = v1;
                    if (b == 2) {
                        u32x4 w; w.x = cvt_pk_bf16(v0[0], v0[1]); w.y = cvt_pk_bf16(v0[2], v0[3]); w.z = cvt_pk_bf16(v1[0], v1[1]); w.w = cvt_pk_bf16(v1[2], v1[3]);
                        *(u32x4*)(O + (size_t)row * D + c) = w;
                    }
                }
            }
    }
};
}

typedef __attribute__((address_space(3))) unsigned char* lds_ptr;
__device__ __forceinline__ void ph_gemm_p(const P& p, int l, int bid, int nb, lds_ptr lds) {
    pg8::Gemm g{(const bf16_t*)(p.ws + WS_HB), (const bf16_t*)(p.ws + WS_WIN), D, 0, 0}; pg8::StaticOrder S; S.init(T, INW, nb, bid);
    pg8::EpiScale E{(bf16_t*)(p.ws + WS_P), INW, (const float*)(p.ws + WS_SSQ), 512, 0.125f * 1.4426950408889634f, (bf16_t*)(p.ws + WS_SBVT), p.b_gate + (size_t)l * 3 * D};
    pg8::gemm_phase<pg8::EpiScale, pg8::StaticOrder, true, true>(lds, g, S, E);
}
__device__ __forceinline__ void ph_gemm_kv(const P& p, int bid, int nb, lds_ptr lds) {
    pg8::Gemm g{(const bf16_t*)(p.ws + WS_MEMB), (const bf16_t*)(p.ws + WS_WKV2), D, 0, 0}; pg8::StaticOrder S; S.init(TM, 2 * 2 * D, nb, bid);
    pg8::EpiKV E{(bf16_t*)(p.ws + WS_KV2), (bf16_t*)(p.ws + WS_VT2), (const float*)(p.ws + WS_MEMSSQ)};
    pg8::gemm_phase<pg8::EpiKV, pg8::StaticOrder, true, true>(lds, g, S, E);
}
__device__ __forceinline__ void ph_merged(const P& p, int l, int bid, int nb, lds_ptr lds) {
    pg8::Gemm g{(const bf16_t*)(p.ws + WS_Y), (const bf16_t*)(p.ws + WS_WBR), 512, (size_t)T * 512 * 2, (size_t)1024 * 512 * 2}; pg8::TripleOrder S; S.init(T, D, nb, bid);
    pg8::EpiMerged E{(const bf16_t*)(p.ws + WS_P) + OFF_GATE, (bf16_t*)(p.ws + WS_MERGED)};
    pg8::gemm_phase<pg8::EpiMerged, pg8::TripleOrder, true, true>(lds, g, S, E);
}
__device__ __forceinline__ void ph_gemm_wout(const P& p, int bid, int nb, lds_ptr lds) {
    pg8::Gemm g{(const bf16_t*)(p.ws + WS_MERGED), (const bf16_t*)(p.ws + WS_WOUT), D, 0, 0}; pg8::StaticOrder S; S.init(T, D, nb, bid);
    pg8::EpiResidual E{(bf16_t*)(p.ws + WS_HB), (float*)(p.ws + WS_SSQ)};
    pg8::gemm_phase<pg8::EpiResidual, pg8::StaticOrder, true, true>(lds, g, S, E);
}
__device__ __forceinline__ void ph_gemm_xq(const P& p, int bid, int nb, lds_ptr lds) {
    pg8::Gemm g{(const bf16_t*)(p.ws + WS_HB), (const bf16_t*)(p.ws + WS_WXQ), D, 0, 0}; pg8::StaticOrder S; S.init(T, D, nb, bid);
    pg8::EpiScale E{(bf16_t*)(p.ws + WS_XQ), D, (const float*)(p.ws + WS_SSQ), D, 0.0625f, nullptr, nullptr};
    pg8::gemm_phase<pg8::EpiScale, pg8::StaticOrder, true, true>(lds, g, S, E);
}
__device__ __forceinline__ void ph_gemm_wo(const P& p, int bid, int nb, lds_ptr lds) {
    pg8::Gemm g{(const bf16_t*)(p.ws + WS_XO), (const bf16_t*)(p.ws + WS_WO), D, 0, 0}; pg8::StaticOrder S; S.init(T, D, nb, bid);
    pg8::EpiResidual E{(bf16_t*)(p.ws + WS_HB), (float*)(p.ws + WS_SSQ)};
    pg8::gemm_phase<pg8::EpiResidual, pg8::StaticOrder, true, true>(lds, g, S, E);
}
__device__ __forceinline__ void ph_gemm_pq(const P& p, int bid, int nb, lds_ptr lds) {
    pg8::Gemm g{(const bf16_t*)(p.ws + WS_HB), (const bf16_t*)(p.ws + WS_WPQ), D, 0, 0}; pg8::StaticOrder S; S.init(T, PQW, nb, bid);
    pg8::EpiScale E{(bf16_t*)(p.ws + WS_PQ), PQW, (const float*)(p.ws + WS_SSQ), 0, 1.f, nullptr, nullptr};
    pg8::gemm_phase<pg8::EpiScale, pg8::StaticOrder, true, true>(lds, g, S, E);
}

typedef float f32x16 __attribute__((ext_vector_type(16)));
typedef __bf16 bf16x2_t __attribute__((ext_vector_type(2)));
typedef float f32x2_t __attribute__((ext_vector_type(2)));
#define MFMA32(a, b, c) __builtin_amdgcn_mfma_f32_32x32x16_bf16((a), (b), (c), 0, 0, 0)
__device__ __forceinline__ unsigned cvtpk(float lo, float hi) { f32x2_t v = {lo, hi}; return __builtin_bit_cast(unsigned, __builtin_convertvector(v, bf16x2_t)); }
__device__ __forceinline__ bf16x8 pack8(const f32x16& x, int s2) {
    u32x4 w; w.x = cvtpk(x[8 * s2], x[8 * s2 + 1]); w.y = cvtpk(x[8 * s2 + 2], x[8 * s2 + 3]); w.z = cvtpk(x[8 * s2 + 4], x[8 * s2 + 5]); w.w = cvtpk(x[8 * s2 + 6], x[8 * s2 + 7]);
    return __builtin_bit_cast(bf16x8, w);
}
__device__ __forceinline__ void ph_sb_attn(const P& p, int bid, int nb, __attribute__((address_space(3))) unsigned char* lds) {
    const int tid = get_tid(), lane = tid & 63, wid = __builtin_amdgcn_readfirstlane(tid >> 6), r = lane & 31, hh = lane >> 5;
    GAS unsigned char* wsg = (GAS unsigned char*)p.ws;
    const GAS bf16_t* PP = (const GAS bf16_t*)(wsg + WS_P); const GAS bf16_t* VT = (const GAS bf16_t*)(wsg + WS_SBVT); GAS bf16_t* Y = (GAS bf16_t*)(wsg + WS_Y);
    bf16x8 uneg[2], oneg;
#pragma unroll
    for (int s2 = 0; s2 < 2; ++s2)
#pragma unroll
        for (int j = 0; j < 8; ++j) { const int k = 16 * s2 + 8 * (j >> 2) + 4 * hh + (j & 3); uneg[s2][j] = (k > r) ? (short)0xBF80 : (short)0; }
#pragma unroll
    for (int j = 0; j < 8; ++j) oneg[j] = (short)0xBF80;
    constexpr int KP = 144, VP = 912, VOFF = 448 * KP;
#pragma unroll 1
    for (int rnd = 0; rnd < 2; ++rnd) {
        if (bid >= 256) break;
        const int bh = bid & 63, b = bh >> 3, h = bh & 7;
        const int Q0 = (((bid >> 6) & 3) * 16 + rnd * 8) * 32, W0 = Q0 >= 192 ? Q0 - 192 : 0, wsz = Q0 + 256 - W0;
        const int qt = (Q0 >> 5) + wid, q0 = qt * 32;
        const GAS bf16_t* prow = PP + (size_t)(b * SEQ) * INW + h * 64 + 8 * hh;
        const GAS bf16_t* vtb = VT + ((size_t)bh * 64 + r) * 2048 + 4 * hh;
        {
            u32x4 rk[7], rv[7];
#pragma unroll
            for (int i = 0; i < 7; ++i) {
                const int c = tid + 512 * i, row = c >> 3, ck = c & 7;
                rk[i] = (u32x4){0u, 0u, 0u, 0u};
                if (row < wsz) rk[i] = *(const GAS u32x4*)(PP + (size_t)(b * SEQ + W0 + row) * INW + 512 + h * 64 + ck * 8);
                const int d = c / 56, cv = c - d * 56;
                rv[i] = (u32x4){0u, 0u, 0u, 0u};
                if (cv * 8 < wsz) rv[i] = *(const GAS u32x4*)(VT + ((size_t)bh * 64 + d) * 2048 + W0 + cv * 8);
            }
#pragma unroll
            for (int i = 0; i < 7; ++i) {
                const int c = tid + 512 * i, row = c >> 3, ck = c & 7, d = c / 56, cv = c - d * 56;
                *(__attribute__((address_space(3))) u32x4*)(lds + row * KP + ck * 16) = rk[i];
                *(__attribute__((address_space(3))) u32x4*)(lds + VOFF + d * VP + cv * 16) = rv[i];
            }
        }
        bf16x8 qf[4];
#pragma unroll
        for (int ks = 0; ks < 4; ++ks) qf[ks] = *(const GAS bf16x8*)(prow + (size_t)(q0 + r) * INW + 16 * ks);
        __syncthreads();
        f32x16 o0, o1, C;
#pragma unroll
        for (int i = 0; i < 16; ++i) { o0[i] = 0.f; o1[i] = 0.f; C[i] = 0.f; }
#pragma unroll 1
        for (int kt = qt; kt >= 0; --kt) {
            const int k0 = kt * 32;
            bf16x8 kf[4]; u32x2 vlo[2][2], vhi[2][2];
            if (k0 >= W0) {
                const __attribute__((address_space(3))) unsigned char* kl = lds + (k0 - W0 + r) * KP + 16 * hh;
#pragma unroll
                for (int ks = 0; ks < 4; ++ks) kf[ks] = *(const __attribute__((address_space(3))) bf16x8*)(kl + 32 * ks);
                const __attribute__((address_space(3))) unsigned char* vl = lds + VOFF + r * VP + (k0 - W0 + 4 * hh) * 2;
#pragma unroll
                for (int dt = 0; dt < 2; ++dt)
#pragma unroll
                    for (int s2 = 0; s2 < 2; ++s2) { vlo[dt][s2] = *(const __attribute__((address_space(3))) u32x2*)(vl + dt * 32 * VP + 32 * s2); vhi[dt][s2] = *(const __attribute__((address_space(3))) u32x2*)(vl + dt * 32 * VP + 32 * s2 + 16); }
            } else {
#pragma unroll
                for (int ks = 0; ks < 4; ++ks) kf[ks] = *(const GAS bf16x8*)(prow + (size_t)(k0 + r) * INW + 512 + 16 * ks);
#pragma unroll
                for (int dt = 0; dt < 2; ++dt)
#pragma unroll
                    for (int s2 = 0; s2 < 2; ++s2) { vlo[dt][s2] = *(const GAS u32x2*)(vtb + (size_t)dt * 32 * 2048 + k0 + 16 * s2); vhi[dt][s2] = *(const GAS u32x2*)(vtb + (size_t)dt * 32 * 2048 + k0 + 16 * s2 + 8); }
            }
            f32x16 z;
#pragma unroll
            for (int i = 0; i < 16; ++i) z[i] = 0.f;
#pragma unroll
            for (int ks = 0; ks < 4; ++ks) z = MFMA32(kf[ks], qf[ks], z);
            f32x16 X, LB;
            const bool diag = (kt == qt);
#pragma unroll
            for (int i = 0; i < 16; ++i) {
                const float zz = z[i];
                const float e = __builtin_amdgcn_exp2f(-fabsf(zz));
                const float sp = fmaxf(zz, 0.f) + __builtin_amdgcn_logf(1.0f + e);
                const bool valid = !diag || (((i & 3) + 8 * (i >> 2) + 4 * hh) < r);
                X[i] = valid ? sp : 0.f;
                LB[i] = valid ? (zz - sp) : -1.0e30f;
            }
            const bf16x8 x0 = pack8(X, 0), x1 = pack8(X, 1);
            f32x16 A = MFMA32(uneg[0], x0, C); A = MFMA32(uneg[1], x1, A);
            f32x16 Cn = MFMA32(oneg, x0, C); Cn = MFMA32(oneg, x1, Cn);
#pragma unroll
            for (int i = 0; i < 16; ++i) A[i] = __builtin_amdgcn_exp2f(LB[i] + A[i]);
            const bf16x8 p0 = pack8(A, 0), p1 = pack8(A, 1);
            { u32x4 a4; a4.x = vlo[0][0].x; a4.y = vlo[0][0].y; a4.z = vhi[0][0].x; a4.w = vhi[0][0].y; o0 = MFMA32(__builtin_bit_cast(bf16x8, a4), p0, o0); }
            { u32x4 a4; a4.x = vlo[0][1].x; a4.y = vlo[0][1].y; a4.z = vhi[0][1].x; a4.w = vhi[0][1].y; o0 = MFMA32(__builtin_bit_cast(bf16x8, a4), p1, o0); }
            { u32x4 a4; a4.x = vlo[1][0].x; a4.y = vlo[1][0].y; a4.z = vhi[1][0].x; a4.w = vhi[1][0].y; o1 = MFMA32(__builtin_bit_cast(bf16x8, a4), p0, o1); }
            { u32x4 a4; a4.x = vlo[1][1].x; a4.y = vlo[1][1].y; a4.z = vhi[1][1].x; a4.w = vhi[1][1].y; o1 = MFMA32(__builtin_bit_cast(bf16x8, a4), p1, o1); }
            C = Cn;
            if (__all(C[0] < -160.f)) break;
        }
        GAS bf16_t* yp = Y + (size_t)(b * SEQ + q0 + r) * 512 + h * 64 + 4 * hh;
#pragma unroll
        for (int g = 0; g < 4; ++g) {
            u32x2 w0; w0.x = cvtpk(o0[4 * g], o0[4 * g + 1]); w0.y = cvtpk(o0[4 * g + 2], o0[4 * g + 3]);
            u32x2 w1; w1.x = cvtpk(o1[4 * g], o1[4 * g + 1]); w1.y = cvtpk(o1[4 * g + 2], o1[4 * g + 3]);
            *(GAS u32x2*)(yp + 8 * g) = w0; *(GAS u32x2*)(yp + 32 + 8 * g) = w1;
        }
        __syncthreads();
    }
}
typedef __attribute__((address_space(3))) float* lds_fptr;
#define LASX __attribute__((address_space(3)))
__device__ __forceinline__ void ph_conv(const P& p, int l, int bid, int nb, LASX unsigned char* lds) {
    const int tid0 = get_tid(), wid = __builtin_amdgcn_readfirstlane(tid0 >> 6);
    GAS unsigned char* wsg = (GAS unsigned char*)p.ws;
    const GAS bf16_t* PP = (const GAS bf16_t*)(wsg + WS_P); GAS bf16_t* Y = (GAS bf16_t*)(wsg + WS_Y);
    const GAS float* dw = (const GAS float*)p.conv_dw_w + (size_t)l * 31 * 512; const GAS float* scw = (const GAS float*)p.sc_w + (size_t)l * 3 * 512;
    float w[31];
#pragma unroll
    for (int j = 0; j < 31; ++j) w[j] = dw[j * 512 + tid0];
    const float w0 = scw[tid0], w1 = scw[512 + tid0], w2 = scw[1024 + tid0];
    const float db = ((const GAS float*)p.conv_dw_b)[l * 512 + tid0], lg = ((const GAS float*)p.conv_ln_g)[l * 512 + tid0], lb = ((const GAS float*)p.conv_ln_b)[l * 512 + tid0];
    const LASX float* stat = (const LASX float*)(lds + 131072);
    LASX float* statw = (LASX float*)(lds + 131072);
#pragma unroll 1
    for (int it = bid; it < T / 32; it += nb) {
        const int tile = (nb == 256) ? ((it & 7) * 64 + ((it >> 3) & 31) + 32 * (it >> 8)) : it;
        const int tok0 = tile * 32, t0 = tok0 & (SEQ - 1);
        int tid = tid0; asm volatile("" : "+v"(tid));
        const int c = tid, lane = tid & 63;
        const GAS bf16_t* tb = PP + (size_t)tok0 * INW;
        {
            u32x4 r[16];
#pragma unroll
            for (int i = 0; i < 16; ++i) {
                const int ch = tid + 512 * i, row = ch >> 7, c16 = ch & 127; const bool ok = (t0 + row - 30 >= 0);
                r[i] = (u32x4){0u, 0u, 0u, 0u};
                if (i < 15 || ch < 62 * 128) { const u32x4 v = *(const GAS u32x4*)(tb + (ptrdiff_t)(ok ? row - 30 : 0) * INW + OFF_CV + c16 * 8); r[i] = ok ? v : (u32x4){0u, 0u, 0u, 0u}; }
            }
#pragma unroll
            for (int i = 0; i < 16; ++i) { const int ch = tid + 512 * i; if (i < 15 || ch < 62 * 128) *(LASX u32x4*)(lds + (ch >> 7) * 2048 + (ch & 127) * 16) = r[i]; }
        }
        __syncthreads();
        float o32[32];
        {
            float u[62];
#pragma unroll
            for (int i = 0; i < 62; ++i) {
                const float val = bf2f(*(const LASX bf16_t*)(lds + i * 2048 + c * 2)), gt = bf2f(*(const LASX bf16_t*)(lds + i * 2048 + 1024 + c * 2));
                u[i] = val * __builtin_amdgcn_rcpf(1.0f + __expf(-gt));
            }
#pragma unroll
            for (int i = 0; i < 32; ++i) {
                float acc = db;
#pragma unroll
                for (int j = 0; j < 31; ++j) asm("v_fmac_f32 %0, %1, %2" : "+v"(acc) : "v"(w[j]), "v"(u[i + j]));
                o32[i] = acc;
            }
        }
        {
            const bool h8 = (lane & 8) != 0, h4 = (lane & 4) != 0, h2 = (lane & 2) != 0, h1 = (lane & 1) != 0;
#pragma unroll
            for (int st = 0; st < 2; ++st) {
                float v[32];
#pragma unroll
                for (int i = 0; i < 32; ++i) { const float x = st ? o32[i] * o32[i] : o32[i]; v[i] = swap32_sum(x, x); }
#pragma unroll
                for (int i = 0; i < 16; ++i) v[i] = swap16_sum(v[i], v[i + 16]);
#pragma unroll
                for (int i = 0; i < 8; ++i) v[i] = (h8 ? v[i + 8] : v[i]) + dppf<0x128>(h8 ? v[i] : v[i + 8]);
#pragma unroll
                for (int i = 0; i < 4; ++i) v[i] = (h4 ? v[i + 4] : v[i]) + dppf<0x141>(dppf<0x1B>(h4 ? v[i] : v[i + 4]));
#pragma unroll
                for (int i = 0; i < 2; ++i) v[i] = (h2 ? v[i + 2] : v[i]) + dppf<0x4E>(h2 ? v[i] : v[i + 2]);
                v[0] = (h1 ? v[1] : v[0]) + dppf<0xB1>(h1 ? v[0] : v[1]);
                if (lane < 32) statw[st * 256 + wid * 32 + lane] = v[0];
            }
        }
        __syncthreads();
        if (tid < 64) { float t = 0.f; const int st = tid >> 5, tk = tid & 31;
#pragma unroll
            for (int k = 0; k < 8; ++k) t += stat[st * 256 + k * 32 + tk];
            statw[512 + tid] = t; }
        {
            u32x4 r[13];
#pragma unroll
            for (int i = 0; i < 13; ++i) {
                const int ch = tid + 512 * i;
                r[i] = (u32x4){0u, 0u, 0u, 0u};
                if (i < 8 || ch < 34 * 128) { const int row = ch >> 7, c16 = ch & 127; const bool ok = (t0 + row - 2 >= 0);
                    const u32x4 v = *(const GAS u32x4*)(tb + (ptrdiff_t)(ok ? row - 2 : 0) * INW + OFF_SC + 512 + c16 * 8); r[i] = ok ? v : (u32x4){0u, 0u, 0u, 0u}; }
                else if (ch < 34 * 128 + 32 * 64) { const int c2 = ch - 34 * 128; r[i] = *(const GAS u32x4*)(tb + (size_t)(c2 >> 6) * INW + OFF_SC + (c2 & 63) * 8); }
            }
#pragma unroll
            for (int i = 0; i < 13; ++i) {
                const int ch = tid + 512 * i;
                if (i < 8 || ch < 34 * 128) *(LASX u32x4*)(lds + (ch >> 7) * 2048 + (ch & 127) * 16) = r[i];
                else if (ch < 34 * 128 + 32 * 64) { const int c2 = ch - 34 * 128; *(LASX u32x4*)(lds + 69632 + (c2 >> 6) * 1024 + (c2 & 63) * 16) = r[i]; }
            }
        }
        __syncthreads();
        GAS bf16_t* ycv = Y + (size_t)T * 512 + (size_t)tok0 * 512;
#pragma unroll
        for (int i = 0; i < 32; ++i) {
            const float mean = stat[512 + i] * (1.0f / 512.0f), var = fmaxf(stat[512 + 32 + i] * (1.0f / 512.0f) - mean * mean, 0.f);
            const float yv = (o32[i] - mean) * rsqrtf(var + 1e-5f) * lg + lb;
            GAS bf16_t* yr = ycv + i * 512; asm volatile("" : "+s"(yr));
            yr[c] = (bf16_t)f2bf(yv * __builtin_amdgcn_rcpf(1.0f + __expf(-yv)));
        }
        {
            float gx[34];
#pragma unroll
            for (int i = 0; i < 34; ++i) gx[i] = bf2f(*(const LASX bf16_t*)(lds + i * 2048 + c * 2)) * bf2f(*(const LASX bf16_t*)(lds + i * 2048 + 1024 + c * 2));
            GAS bf16_t* ysc = Y + (size_t)2 * T * 512 + (size_t)tok0 * 512;
#pragma unroll
            for (int i = 0; i < 32; ++i) {
                const float sc = fmaf(w2, gx[i + 2], fmaf(w1, gx[i + 1], w0 * gx[i]));
                GAS bf16_t* yr = ysc + i * 512; asm volatile("" : "+s"(yr));
                yr[c] = (bf16_t)f2bf(bf2f(*(const LASX bf16_t*)(lds + 69632 + i * 1024 + c * 2)) * sc);
            }
        }
        __syncthreads();
    }
}

#define MFMA16(a, b, c) __builtin_amdgcn_mfma_f32_16x16x32_bf16((a), (b), (c), 0, 0, 0)
#define XA_PITCH 528
#define XA_LOAD(regs, src, pitch) do { _Pragma("unroll") for (int i_ = 0; i_ < 16; ++i_) { const int ch_ = tid + 512 * i_; regs[i_] = *(const GAS u32x4*)((const GAS char*)(src) + (size_t)(ch_ >> 5) * (pitch) + (ch_ & 31) * 16); } } while (0)
#define XA_STORE(regs) do { _Pragma("unroll") for (int i_ = 0; i_ < 16; ++i_) { const int ch_ = tid + 512 * i_; *(LASX u32x4*)(lds + (ch_ >> 5) * XA_PITCH + (ch_ & 31) * 16) = regs[i_]; } } while (0)
__device__ __forceinline__ void ph_xattn(const P& p, int l, int bid, int nb, LASX unsigned char* lds) {
    const int tid = get_tid(), lane = tid & 63, wid = __builtin_amdgcn_readfirstlane(tid >> 6), fr = lane & 15, fq = lane >> 4;
    GAS unsigned char* wsg = (GAS unsigned char*)p.ws;
    const GAS bf16_t* XQ = (const GAS bf16_t*)(wsg + WS_XQ); const GAS bf16_t* KV = (const GAS bf16_t*)(wsg + WS_KV2) + (size_t)l * TM * 2048; const GAS bf16_t* VT = (const GAS bf16_t*)(wsg + WS_VT2) + (size_t)l * (8 * 4 * 256 * 256);
    GAS bf16_t* XO = (GAS bf16_t*)(wsg + WS_XO);
    constexpr int NU = BATCH * 4 * 16;
    u32x4 st[16];
    if (bid < NU) { const int b = bid >> 6, hd = (bid >> 4) & 3; XA_LOAD(st, KV + (size_t)(b * NMEM) * 2048 + hd * 256, 4096); }
#pragma unroll 1
    for (int unit = bid; unit < NU; unit += nb) {
        const int b = unit >> 6, hd = (unit >> 4) & 3, qt = unit & 15;
        const int tok0 = b * SEQ + qt * 128 + wid * 16;
        XA_STORE(st);
        bf16x8 qf[8];
        { const GAS bf16_t* qp = XQ + (size_t)(tok0 + fr) * D + hd * 256 + fq * 8;
#pragma unroll
          for (int ks = 0; ks < 8; ++ks) qf[ks] = *(const GAS bf16x8*)(qp + ks * 32); }
        __syncthreads();
        f32x4 sacc[16];
        const LASX unsigned char* kl = lds + fr * XA_PITCH + fq * 16;
#pragma unroll
        for (int t = 0; t < 16; ++t) {
            f32x4 acc = (f32x4){0.f, 0.f, 0.f, 0.f};
#pragma unroll
            for (int ks = 0; ks < 8; ++ks) { const bf16x8 kf = *(const LASX bf16x8*)(kl + t * 16 * XA_PITCH + ks * 64); acc = MFMA16(kf, qf[ks], acc); }
            sacc[t] = acc;
        }
        XA_LOAD(st, VT + (size_t)(b * 4 + hd) * 256 * 256, 512);
        float mx = -3.0e38f;
#pragma unroll
        for (int t = 0; t < 16; ++t) mx = fmaxf(fmaxf(fmaxf(sacc[t][0], sacc[t][1]), fmaxf(sacc[t][2], sacc[t][3])), mx);
        { auto r = __builtin_amdgcn_permlane16_swap(__float_as_uint(mx), __float_as_uint(mx), false, false); mx = fmaxf(__uint_as_float(r[0]), __uint_as_float(r[1])); }
        { auto r = __builtin_amdgcn_permlane32_swap(__float_as_uint(mx), __float_as_uint(mx), false, false); mx = fmaxf(__uint_as_float(r[0]), __uint_as_float(r[1])); }
        float sum = 0.f;
#pragma unroll
        for (int t = 0; t < 16; ++t) {
#pragma unroll
            for (int r = 0; r < 4; ++r) { const float e = __expf(sacc[t][r] - mx); sacc[t][r] = e; sum += e; }
        }
        sum = swap16_sum(sum, sum); sum = swap32_sum(sum, sum);
        const float inv = 1.0f / sum;
        bf16x8 pf[8];
#pragma unroll
        for (int s2 = 0; s2 < 8; ++s2) {
            u32x4 w; w.x = cvtpk(sacc[2 * s2][0], sacc[2 * s2][1]); w.y = cvtpk(sacc[2 * s2][2], sacc[2 * s2][3]);
            w.z = cvtpk(sacc[2 * s2 + 1][0], sacc[2 * s2 + 1][1]); w.w = cvtpk(sacc[2 * s2 + 1][2], sacc[2 * s2 + 1][3]);
            pf[s2] = __builtin_bit_cast(bf16x8, w);
        }
        __syncthreads();
        XA_STORE(st);
        __syncthreads();
        if (unit + nb < NU) { const int u2 = unit + nb, b2 = u2 >> 6, hd2 = (u2 >> 4) & 3; XA_LOAD(st, KV + (size_t)(b2 * NMEM) * 2048 + hd2 * 256, 4096); }
        const LASX unsigned char* vl = lds + fr * XA_PITCH + fq * 8;
        GAS bf16_t* op = XO + (size_t)(tok0 + fr) * D + hd * 256 + 4 * fq;
#pragma unroll 2
        for (int dt = 0; dt < 16; ++dt) {
            f32x4 acc = (f32x4){0.f, 0.f, 0.f, 0.f};
#pragma unroll
            for (int s2 = 0; s2 < 8; ++s2) {
                const u32x2 lo = *(const LASX u32x2*)(vl + dt * 16 * XA_PITCH + 64 * s2), hi = *(const LASX u32x2*)(vl + dt * 16 * XA_PITCH + 64 * s2 + 32);
                u32x4 a4; a4.x = lo.x; a4.y = lo.y; a4.z = hi.x; a4.w = hi.y;
                acc = MFMA16(__builtin_bit_cast(bf16x8, a4), pf[s2], acc);
            }
            u32x2 w; w.x = cvtpk(acc[0] * inv, acc[1] * inv); w.y = cvtpk(acc[2] * inv, acc[3] * inv);
            *(GAS u32x2*)(op + dt * 16) = w;
        }
        __syncthreads();
    }
}

typedef __attribute__((address_space(3))) int* lds_iptr;
#define TK_CE(a, b) do { const float hi_ = __builtin_fmaxf(a, b); b = __builtin_fminf(a, b); a = hi_; } while (0)
__device__ __forceinline__ void tk_sort16(float (&a)[16]) {
#pragma unroll
    for (int k = 2; k <= 16; k <<= 1)
#pragma unroll
        for (int j = k >> 1; j > 0; j >>= 1)
#pragma unroll
            for (int i = 0; i < 16; ++i) { const int l = i ^ j; if (l > i) { if ((i & k) == 0) TK_CE(a[i], a[l]); else TK_CE(a[l], a[i]); } }
}
__device__ __forceinline__ void tk_merge16(float (&L)[16], const float (&G)[16]) {
#pragma unroll
    for (int i = 0; i < 16; ++i) L[i] = __builtin_fmaxf(L[i], G[15 - i]);
#pragma unroll
    for (int j = 8; j > 0; j >>= 1)
#pragma unroll
        for (int i = 0; i < 16; ++i) { const int l = i ^ j; if (l > i) TK_CE(L[i], L[l]); }
}
#define TK_INSERT(L, x) do { float x_ = (x); _Pragma("unroll") for (int i_ = 0; i_ < 16; ++i_) { const float hi_ = __builtin_fmaxf(L[i_], x_); x_ = __builtin_fminf(L[i_], x_); L[i_] = hi_; } } while (0)
__device__ __forceinline__ void ph_peer_score(const P& p, int bid, int nb, lds_fptr ldsf) {
    const int tid = get_tid(), lane = tid & 63, wid = __builtin_amdgcn_readfirstlane(tid >> 6), fr = lane & 15, fq = lane >> 4;
    GAS unsigned char* wsg = (GAS unsigned char*)p.ws;
    const GAS bf16_t* PQ = (const GAS bf16_t*)(wsg + WS_PQ); const GAS bf16_t* KEYS = (const GAS bf16_t*)(wsg + WS_KEYS);
    GAS int* PIDX = (GAS int*)(wsg + WS_PIDX); GAS float* PG = (GAS float*)(wsg + WS_PG);
    const lds_fptr sc = ldsf + wid * (64 * 68);
    const int gw = bid * 8 + wid, ngw = nb * 8;
#pragma unroll 1
    for (int task = gw; task < (T / 64) * 8; task += ngw) {
        const int tok0 = (task >> 3) * 64, h = task & 7;
        float L1[16], L2[16];
#pragma unroll
        for (int i = 0; i < 16; ++i) { L1[i] = -3.0e38f; L2[i] = -3.0e38f; }
        bf16x8 qf[4][4], kfa[4][4];
#define PS_LOADQ(pp_) do { _Pragma("unroll") for (int mt_ = 0; mt_ < 4; ++mt_) _Pragma("unroll") for (int ks_ = 0; ks_ < 4; ++ks_) \
            qf[mt_][ks_] = *(const GAS bf16x8*)(PQ + (size_t)(tok0 + 16 * mt_ + fr) * PQW + h * 256 + (pp_) * 128 + 32 * ks_ + 8 * fq); } while (0)
#define PS_LOADK(it_) do { const GAS bf16_t* kp_ = KEYS + ((size_t)h * 256 + (it_) * 64 + fr) * 128 + 8 * fq; _Pragma("unroll") for (int nt_ = 0; nt_ < 4; ++nt_) _Pragma("unroll") for (int ks_ = 0; ks_ < 4; ++ks_) \
            kfa[nt_][ks_] = *(const GAS bf16x8*)(kp_ + (size_t)nt_ * 16 * 128 + 32 * ks_); } while (0)
        PS_LOADQ(0); PS_LOADK(0);
        float Lr[16];
#pragma unroll
        for (int i = 0; i < 16; ++i) Lr[i] = -3.0e38f;
#pragma unroll 1
        for (int it = 0; it < 4; ++it) {
            const int half = it & 1;
#pragma unroll
            for (int nt = 0; nt < 4; ++nt) {
#pragma unroll
                for (int mt = 0; mt < 4; ++mt) {
                    f32x4 acc = (f32x4){0.f, 0.f, 0.f, 0.f};
#pragma unroll
                    for (int ks = 0; ks < 4; ++ks) acc = MFMA16(kfa[nt][ks], qf[mt][ks], acc);
                    *(__attribute__((address_space(3))) f32x4*)(sc + (16 * mt + fr) * 68 + 16 * nt + 4 * fq) = acc;
                }
            }
            __builtin_amdgcn_sched_barrier(0);
            if (it == 1) PS_LOADQ(1);
            if (it < 3) PS_LOADK(it + 1);
            __builtin_amdgcn_sched_barrier(0);
#pragma unroll
            for (int grp = 0; grp < 4; ++grp) {
                float G[16];
#pragma unroll
                for (int k4 = 0; k4 < 4; ++k4) {
                    const f32x4 v = *(const __attribute__((address_space(3))) f32x4*)(sc + lane * 68 + 16 * grp + 4 * k4);
#pragma unroll
                    for (int r = 0; r < 4; ++r) G[4 * k4 + r] = __uint_as_float((__float_as_uint(v[r]) & 0xffffff80u) | (unsigned)(half * 64 + 16 * grp + 4 * k4 + r));
                }
                tk_sort16(G);
                tk_merge16(Lr, G);
            }
            if (it == 1) {
#pragma unroll
                for (int i = 0; i < 16; ++i) { L1[i] = Lr[i]; Lr[i] = -3.0e38f; }
            }
        }
#pragma unroll
        for (int i = 0; i < 16; ++i) L2[i] = Lr[i];
#undef PS_LOADQ
#undef PS_LOADK
        const lds_iptr li = (lds_iptr)sc + lane * 33;
#pragma unroll
        for (int i = 0; i < 16; ++i) { li[i] = (int)(__float_as_uint(L1[i]) & 127u); li[16 + i] = (int)(__float_as_uint(L2[i]) & 127u); }
        float C[16];
        {
            float G[4][16];
#pragma unroll
            for (int a = 0; a < 4; ++a)
#pragma unroll
                for (int i = 0; i < 16; ++i) G[a][i] = -3.0e38f;
            int cnt = 0;
#pragma unroll
            for (int i = 0; i < 16; ++i)
#pragma unroll
                for (int j = 0; j < 16; ++j)
                    if ((i + 1) * (j + 1) <= 16) { const float sm = L1[i] + L2[j]; G[cnt >> 4][cnt & 15] = __uint_as_float((__float_as_uint(sm) & 0xffffff00u) | (unsigned)(i * 16 + j)); ++cnt; }
            tk_sort16(G[0]); tk_sort16(G[1]); tk_sort16(G[2]); tk_sort16(G[3]);
            tk_merge16(G[0], G[1]); tk_merge16(G[2], G[3]); tk_merge16(G[0], G[2]);
#pragma unroll
            for (int i = 0; i < 16; ++i) C[i] = G[0][i];
        }
        float e[16], es = 0.f;
#pragma unroll
        for (int k = 0; k < 16; ++k) { e[k] = __expf(C[k] - C[0]); es += e[k]; }
        const float inv = 1.0f / es;
        int ex[16];
#pragma unroll
        for (int k = 0; k < 16; ++k) { const unsigned ci = __float_as_uint(C[k]) & 255u; ex[k] = li[ci >> 4] * 128 + li[16 + (ci & 15)]; }
        GAS int* pi = PIDX + (size_t)(tok0 + lane) * 128 + h * 16; GAS float* pgp = PG + (size_t)(tok0 + lane) * 128 + h * 16;
#pragma unroll
        for (int k4 = 0; k4 < 4; ++k4) {
            typedef int i32x4 __attribute__((ext_vector_type(4)));
            i32x4 iv; iv.x = ex[4 * k4]; iv.y = ex[4 * k4 + 1]; iv.z = ex[4 * k4 + 2]; iv.w = ex[4 * k4 + 3];
            f32x4 gv; gv.x = e[4 * k4] * inv; gv.y = e[4 * k4 + 1] * inv; gv.z = e[4 * k4 + 2] * inv; gv.w = e[4 * k4 + 3] * inv;
            *(GAS i32x4*)(pi + 4 * k4) = iv; *(GAS f32x4*)(pgp + 4 * k4) = gv;
        }
    }
}
#define PG_ISSUE(buf, TAB, ireg, c) do { _Pragma("unroll") for (int j_ = 0; j_ < 8; ++j_) { \
        const int idx_ = __builtin_amdgcn_readlane(ireg, ((c) & 7) * 8 + j_); buf[j_] = ((const GAS u32x4*)((const GAS char*)(TAB) + (size_t)(unsigned)idx_ * 1024u))[lane]; } } while (0)
#define PG_CVT(f, q) do { const f32x2_t a_ = __builtin_amdgcn_cvt_pk_f32_fp8((int)(q).x, false), b_ = __builtin_amdgcn_cvt_pk_f32_fp8((int)(q).x, true), c_ = __builtin_amdgcn_cvt_pk_f32_fp8((int)(q).y, false), d_ = __builtin_amdgcn_cvt_pk_f32_fp8((int)(q).y, true), \
        e_ = __builtin_amdgcn_cvt_pk_f32_fp8((int)(q).z, false), f_ = __builtin_amdgcn_cvt_pk_f32_fp8((int)(q).z, true), g_ = __builtin_amdgcn_cvt_pk_f32_fp8((int)(q).w, false), h_ = __builtin_amdgcn_cvt_pk_f32_fp8((int)(q).w, true); \
        f[0] = a_[0]; f[1] = a_[1]; f[2] = b_[0]; f[3] = b_[1]; f[4] = c_[0]; f[5] = c_[1]; f[6] = d_[0]; f[7] = d_[1]; f[8] = e_[0]; f[9] = e_[1]; f[10] = f_[0]; f[11] = f_[1]; f[12] = g_[0]; f[13] = g_[1]; f[14] = h_[0]; f[15] = h_[1]; } while (0)
#define PG_DOTS(buf, c) do { float pd_[8]; _Pragma("unroll") for (int j_ = 0; j_ < 8; ++j_) { float f_v[16]; PG_CVT(f_v, buf[j_]); \
        float d0_ = f_v[0] * xf[0], d1_ = f_v[1] * xf[1]; _Pragma("unroll") for (int k_ = 2; k_ < 16; k_ += 2) { d0_ = fmaf(f_v[k_], xf[k_], d0_); d1_ = fmaf(f_v[k_ + 1], xf[k_ + 1], d1_); } pd_[j_] = d0_ + d1_; } \
        float r_[4]; _Pragma("unroll") for (int i_ = 0; i_ < 4; ++i_) r_[i_] = swap32_sum(pd_[i_], pd_[i_ + 4]); \
        float s_[2]; _Pragma("unroll") for (int i_ = 0; i_ < 2; ++i_) s_[i_] = swap16_sum(r_[i_], r_[i_ + 2]); \
        float t_ = (h8 ? s_[1] : s_[0]) + dppf<0x128>(h8 ? s_[0] : s_[1]); t_ += dppf<0xB1>(t_); t_ += dppf<0x4E>(t_); t_ += dppf<0x141>(t_);     \
        if ((lane & 7) == 0) als[(c) * 8 + ((lane >> 3) & 7)] = t_; } while (0)
__device__ __forceinline__ void ph_peer_u(const P& p, int bid, int nb, lds_fptr ldsf) {
    const int tid = get_tid(), lane = tid & 63, wid = __builtin_amdgcn_readfirstlane(tid >> 6);
    GAS unsigned char* wsg = (GAS unsigned char*)p.ws;
    const GAS bf16_t* HB = (const GAS bf16_t*)(wsg + WS_HB); const GAS float* SSQ = (const GAS float*)(wsg + WS_SSQ);
    const GAS unsigned char* U = (const GAS unsigned char*)(wsg + WS_U);
    const GAS float* USC = (const GAS float*)(wsg + WS_USC); const GAS float* VSC = (const GAS float*)(wsg + WS_VSC);
    const GAS int* PIDX = (const GAS int*)(wsg + WS_PIDX); GAS float* PG = (GAS float*)(wsg + WS_PG);
    const lds_fptr als = ldsf + wid * 128;
    const bool h32 = (lane & 32) != 0, h16 = (lane & 16) != 0, h8 = (lane & 8) != 0;
    const int gw = bid * 8 + wid, ngw = nb * 8;
#pragma unroll 1
    for (int tok = gw; tok < T; tok += ngw) {
        float xf[16];
        { const GAS u32x4* xr = (const GAS u32x4*)(HB + (size_t)tok * D); const u32x4 w0 = xr[2 * lane], w1 = xr[2 * lane + 1];
          xf[0] = bflo(w0.x); xf[1] = bfhi(w0.x); xf[2] = bflo(w0.y); xf[3] = bfhi(w0.y); xf[4] = bflo(w0.z); xf[5] = bfhi(w0.z); xf[6] = bflo(w0.w); xf[7] = bfhi(w0.w);
          xf[8] = bflo(w1.x); xf[9] = bfhi(w1.x); xf[10] = bflo(w1.y); xf[11] = bfhi(w1.y); xf[12] = bflo(w1.z); xf[13] = bfhi(w1.z); xf[14] = bflo(w1.w); xf[15] = bfhi(w1.w); }
        const int idx_lo = PIDX[(size_t)tok * 128 + lane], idx_hi = PIDX[(size_t)tok * 128 + 64 + lane];
        const float g_lo = PG[(size_t)tok * 128 + lane], g_hi = PG[(size_t)tok * 128 + 64 + lane];
        const float us_lo = USC[idx_lo], us_hi = USC[idx_hi], vs_lo = VSC[idx_lo], vs_hi = VSC[idx_hi];
        const float rs = rsqrtf(wave_sum2(lane < 16 ? SSQ[(size_t)tok * 16 + lane] : 0.f) * (1.0f / D) + 1e-6f);
        u32x4 bA[8], bB[8];
        PG_ISSUE(bA, U, idx_lo, 0);
#pragma unroll 1
        for (int c = 0; c < 8; c += 2) {
            PG_ISSUE(bB, U, idx_lo, c + 1); PG_DOTS(bA, c);
            if (c + 2 < 8) PG_ISSUE(bA, U, idx_lo, c + 2); else PG_ISSUE(bA, U, idx_hi, 0);
            PG_DOTS(bB, c + 1);
        }
#pragma unroll 1
        for (int c = 8; c < 16; c += 2) {
            PG_ISSUE(bB, U, idx_hi, c + 1); PG_DOTS(bA, c);
            if (c + 2 < 16) PG_ISSUE(bA, U, idx_hi, c + 2);
            PG_DOTS(bB, c + 1);
        }
        const float a0 = als[lane] * us_lo * rs, a1 = als[lane + 64] * us_hi * rs;
        PG[(size_t)tok * 128 + lane] = g_lo * vs_lo * 0.5f * a0 * (1.0f + erff(a0 * 0.70710678118654752f));
        PG[(size_t)tok * 128 + 64 + lane] = g_hi * vs_hi * 0.5f * a1 * (1.0f + erff(a1 * 0.70710678118654752f));
    }
}
#define V2_META(ilo, ihi, wlo, whi, hw, t_) do { const size_t o_ = (size_t)(t_) * 128 + lane; ilo = PIDX[o_]; ihi = PIDX[o_ + 64]; wlo = PW[o_]; whi = PW[o_ + 64]; hw = *(const GAS unsigned*)(HBW + (size_t)(t_) * D + col); } while (0)
#define V2_TAB(slot, ilo, ihi, wlo, whi) do { *(LASX u32x2*)(tab + (slot) * 1024 + lane * 8) = (u32x2){(unsigned)(ilo), __float_as_uint(wlo)}; *(LASX u32x2*)(tab + (slot) * 1024 + 512 + lane * 8) = (u32x2){(unsigned)(ihi), __float_as_uint(whi)}; } while (0)
#define V2_ISSUE(buf, slot) do { _Pragma("unroll") for (int i_ = 0; i_ < 16; ++i_) { const unsigned e_ = *(const LASX unsigned*)(tab + (slot) * 1024 + ((i_ & 7) * 8 + 64 * (i_ >> 3)) * 8 + g * 8); \
        buf[i_] = *(const GAS u32x4*)(Vx + (size_t)e_ * 1024u); } } while (0)
#define V2_ACC(buf, slot) do { _Pragma("unroll") for (int i_ = 0; i_ < 16; ++i_) { const float w_ = *(const LASX float*)(tab + (slot) * 1024 + ((i_ & 7) * 8 + 64 * (i_ >> 3)) * 8 + g * 8 + 4); \
        float f_v[16]; PG_CVT(f_v, buf[i_]); _Pragma("unroll") for (int k_ = 0; k_ < 16; ++k_) asm("v_fmac_f32 %0, %1, %2" : "+v"(o[k_]) : "v"(w_), "v"(f_v[k_])); } } while (0)
#define V2_FINISH(t_, hwreg) do { float r8_[8], r4_[4]; \
        _Pragma("unroll") for (int i_ = 0; i_ < 8; ++i_) r8_[i_] = swap32_sum(o[i_], o[i_ + 8]); \
        _Pragma("unroll") for (int i_ = 0; i_ < 4; ++i_) r4_[i_] = swap16_sum(r8_[i_], r8_[i_ + 4]); \
        const float c0_ = (h8 ? r4_[2] : r4_[0]) + dppf<0x128>(h8 ? r4_[0] : r4_[2]), c1_ = (h8 ? r4_[3] : r4_[1]) + dppf<0x128>(h8 ? r4_[1] : r4_[3]); \
        GAS unsigned* hp_ = (GAS unsigned*)(HBW + (size_t)(t_) * D + col); const unsigned hw_ = (hwreg); const unsigned nw_ = pk2(bflo(hw_) + c0_, bfhi(hw_) + c1_); *hp_ = nw_; \
        const float n0_ = bflo(nw_), n1_ = bfhi(nw_); \
        const float ss_ = wave_sum2(n0_ * n0_ + n1_ * n1_); if (lane < 2) SSQW[(size_t)(t_) * 16 + x + 8 * lane] = lane == 0 ? ss_ : 0.f; \
        _Pragma("unroll") for (int i_ = 0; i_ < 16; ++i_) o[i_] = 0.f; } while (0)
__device__ __forceinline__ void ph_peer_v(const P& p, int bid, int nb, LASX unsigned char* ldsb) {
    const int tid = get_tid(), lane = tid & 63, wid = __builtin_amdgcn_readfirstlane(tid >> 6), g = lane >> 3, j = lane & 7;
    GAS unsigned char* wsg = (GAS unsigned char*)p.ws;
    const int x = bid & 7, nsl = nb >> 3;
    const GAS unsigned char* Vx = (const GAS unsigned char*)(wsg + WS_V) + x * 128 + j * 16;
    const GAS int* PIDX = (const GAS int*)(wsg + WS_PIDX); const GAS float* PW = (const GAS float*)(wsg + WS_PG);
    GAS bf16_t* HBW = (GAS bf16_t*)(wsg + WS_HB); GAS float* SSQW = (GAS float*)(wsg + WS_SSQ);
    const bool h32 = (lane & 32) != 0, h16 = (lane & 16) != 0, h8 = (lane & 8) != 0;
    const int col = x * 128 + j * 16 + (h32 ? 8 : 0) + (h16 ? 4 : 0) + (h8 ? 2 : 0);
    const int wv = (bid >> 3) * 8 + wid, nwv = nsl * 8;
    LASX unsigned char* tab = ldsb + wid * 2048;
    float o[16];
#pragma unroll
    for (int i = 0; i < 16; ++i) o[i] = 0.f;
    int iloA, ihiA, iloB, ihiB; float wloA, whiA, wloB, whiB; unsigned hwA = 0u, hwB = 0u, hwC = 0u;
    u32x4 bA[16], bB[16];
    const int t0 = wv;
    if (t0 < T) { V2_META(iloA, ihiA, wloA, whiA, hwA, t0); V2_TAB(0, iloA, ihiA, wloA, whiA); V2_ISSUE(bA, 0); }
    if (t0 + nwv < T) V2_META(iloB, ihiB, wloB, whiB, hwB, t0 + nwv);
#pragma unroll 1
    for (int t = t0; t < T; t += 2 * nwv) {
        const int t1 = t + nwv, t2 = t + 2 * nwv, t3 = t + 3 * nwv;
        if (t1 < T) { V2_TAB(1, iloB, ihiB, wloB, whiB); V2_ISSUE(bB, 1); }
        V2_ACC(bA, 0);
        hwC = hwA;
        if (t2 < T) V2_META(iloA, ihiA, wloA, whiA, hwA, t2);
        V2_FINISH(t, hwC);
        if (t1 < T) {
            if (t2 < T) { V2_TAB(0, iloA, ihiA, wloA, whiA); V2_ISSUE(bA, 0); }
            V2_ACC(bB, 1);
            hwC = hwB;
            if (t3 < T) V2_META(iloB, ihiB, wloB, whiB, hwB, t3);
            V2_FINISH(t1, hwC);
        }
    }
}
__device__ __forceinline__ void ph_final_norm(const P& p, int bid, int nb) {
    const int tid = get_tid(), lane = tid & 63, wid = __builtin_amdgcn_readfirstlane(tid >> 6);
    GAS float* outg = (GAS float*)p.out; const GAS f32x4* fg = (const GAS f32x4*)p.final_g; const GAS float* SSQ = (const GAS float*)(p.ws + WS_SSQ);
    const GAS bf16_t* HB = (const GAS bf16_t*)(p.ws + WS_HB);
    const f32x4 g0 = fg[2 * lane], g1 = fg[2 * lane + 1], g2 = fg[128 + 2 * lane], g3 = fg[128 + 2 * lane + 1];
#pragma unroll 1
    for (int r = bid * 8 + wid; r < T; r += nb * 8) {
        const GAS u32x4* hr = (const GAS u32x4*)(HB + (size_t)r * D);
        const u32x4 w0 = hr[lane], w1 = hr[lane + 64];
        const float rs = rsqrtf(wave_sum(lane < 16 ? SSQ[(size_t)r * 16 + lane] : 0.f, lane) * (1.0f / D) + 1e-6f);
        GAS f32x4* o = (GAS f32x4*)(outg + (size_t)r * D);
        o[2 * lane] = (f32x4){bflo(w0.x), bfhi(w0.x), bflo(w0.y), bfhi(w0.y)} * rs * g0; o[2 * lane + 1] = (f32x4){bflo(w0.z), bfhi(w0.z), bflo(w0.w), bfhi(w0.w)} * rs * g1;
        o[128 + 2 * lane] = (f32x4){bflo(w1.x), bfhi(w1.x), bflo(w1.y), bfhi(w1.y)} * rs * g2; o[128 + 2 * lane + 1] = (f32x4){bflo(w1.z), bfhi(w1.z), bflo(w1.w), bfhi(w1.w)} * rs * g3;
    }
}

#define LAS __attribute__((address_space(3)))
#define XB_TMO      128
#define XB_XCNT(j)  (256  + 64 * (j))
#define XB_XSUB(j)  (1280 + 64 * (j))
#define XB_XGEN(j)  (2304 + 64 * (j))
#define XB_TOP      3328
#define XB_TOPGEN   3392
#define XCD_BAR_WORDS 3456
#define XB_SPIN_CAP (1u << 18)

__device__ __forceinline__ unsigned xb_ld(unsigned* p)              { return __hip_atomic_load(p, __ATOMIC_RELAXED, __HIP_MEMORY_SCOPE_AGENT); }
__device__ __forceinline__ unsigned xb_add(unsigned* p, unsigned v) { return __hip_atomic_fetch_add(p, v, __ATOMIC_RELAXED, __HIP_MEMORY_SCOPE_AGENT); }
__device__ __forceinline__ unsigned xb_xcc_id() { return (unsigned)__builtin_amdgcn_s_getreg((3 << 11) | 20) & 0xFu; }
#define XB_SPIN(cond, bar) do { unsigned _sp = 0; while (cond) { __builtin_amdgcn_s_sleep(1); \
    if ((++_sp & 255u) == 0u) { if (xb_ld(&(bar)[XB_TMO])) break; if (_sp > XB_SPIN_CAP) { atomicAdd(&(bar)[XB_TMO], 1u); break; } } } } while (0)

struct XcdBarrier {
    unsigned* bar; unsigned x;
    volatile LAS unsigned* st;
};

__device__ __forceinline__ XcdBarrier xcd_barrier_post(unsigned* bar, volatile LAS unsigned* st) {
    XcdBarrier b; b.bar = bar; b.x = xb_xcc_id(); b.st = st;
    if (get_tid() == 0) (void)xb_add(&bar[XB_XCNT(b.x)], 1u);
    return b;
}
__device__ __forceinline__ void xcd_barrier_complete(unsigned* bar, unsigned x, unsigned& nloc, unsigned& nx) {
    const unsigned G = gridDim.x * gridDim.y * gridDim.z;
    unsigned sum, cnt, mine, sp = 0u;
    for (;;) {
        sum = 0u; cnt = 0u; mine = 0u;
#pragma unroll
        for (unsigned j = 0; j < 16; ++j) { const unsigned c = xb_ld(&bar[XB_XCNT(j)]); sum += c; cnt += (c > 0u) ? 1u : 0u; mine = (j == x) ? c : mine; }
        if (sum == G) break;
        __builtin_amdgcn_s_sleep(1);
        if ((++sp & 255u) == 0u) { if (xb_ld(&bar[XB_TMO])) break; if (sp > XB_SPIN_CAP) { atomicAdd(&bar[XB_TMO], 1u); break; } }
    }
    nloc = mine > 0u ? mine : 1u; nx = cnt > 0u ? cnt : 1u;
}

__device__ __forceinline__ void xcd_barrier(const XcdBarrier& b) {
    asm volatile("s_waitcnt vmcnt(0)" ::: "memory");
    __syncthreads();
    if (get_tid() == 0) {
        unsigned* bar = b.bar;
        __builtin_amdgcn_s_waitcnt(0);
        unsigned nloc = b.st[0], nx = b.st[1];
        if (nloc == 0u) { xcd_barrier_complete(bar, b.x, nloc, nx); b.st[0] = nloc; b.st[1] = nx; }
        const unsigned old = xb_add(&bar[XB_XSUB(b.x)], 1u);
        const unsigned gen = old / nloc;
        if (old + 1u == (gen + 1u) * nloc) {
            __builtin_amdgcn_fence(__ATOMIC_RELEASE, "agent");
            asm volatile("s_waitcnt vmcnt(0)" ::: "memory");
            const unsigned og = xb_add(&bar[XB_TOP], 1u);
            const unsigned tg = og / nx;
            if (og + 1u == (tg + 1u) * nx) xb_add(&bar[XB_TOPGEN], 1u);
            else XB_SPIN(xb_ld(&bar[XB_TOPGEN]) == tg, bar);
            __builtin_amdgcn_fence(__ATOMIC_ACQUIRE, "agent");
            xb_add(&bar[XB_XGEN(b.x)], 1u);
            asm volatile("s_waitcnt vmcnt(0)" ::: "memory");
        } else {
            XB_SPIN(xb_ld(&bar[XB_XGEN(b.x)]) == gen, bar);
            __builtin_amdgcn_fence(__ATOMIC_ACQUIRE, "agent");
            asm volatile("s_waitcnt vmcnt(0)" ::: "memory");
        }
    }
    __syncthreads();
}

namespace cg = cooperative_groups;
__global__ void __launch_bounds__(NT, 2) mega_fwd(P p) {
    float* lds = (float*)smem;
    const lds_ptr ldsr = (lds_ptr)smem;
    const int bid = blockIdx.x, nb = gridDim.x;
    volatile LAS unsigned* MISC = (volatile LAS unsigned*)((LAS unsigned char*)smem + LDS_BYTES - 64);
    if (threadIdx.x < 2) MISC[threadIdx.x] = 0u;
    if ((threadIdx.x & 63) == 0) ((LAS int*)((LAS unsigned char*)smem + LDS_WTAB))[__builtin_amdgcn_s_getreg((5 << 11) | 4)] = (int)(threadIdx.x >> 6);
    __syncthreads();
    const XcdBarrier bar = xcd_barrier_post((unsigned*)(p.ws + WS_CTL), MISC);
#define GSYNC() xcd_barrier(bar)
#ifndef PROBE_A
#define PROBE_A -1
#endif
#ifndef PROBE_P
#define PROBE_P (PROBE_A - 1)
#endif
    unsigned long long* ts = (unsigned long long*)(p.ws + 512 * 1024);
#define STAMP(cat) do { if (PROBE_A >= 0 && bid == 0) ts[l * 16 + (cat)] = __builtin_amdgcn_s_memrealtime(); } while (0)
#define PH(call) do { const __attribute__((address_space(4))) unsigned long long* kp_ = (const __attribute__((address_space(4))) unsigned long long*)__builtin_amdgcn_kernarg_segment_ptr(); asm volatile("" : "+s"(kp_) :: "memory"); \
        P q; { unsigned long long* d_ = (unsigned long long*)&q; _Pragma("unroll") for (int i_ = 0; i_ < (int)(sizeof(P) / 8); ++i_) d_[i_] = kp_[i_]; } call; } while (0)
    if (PROBE_A >= 0 && bid == 0) ts[40] = __builtin_amdgcn_s_memrealtime();

#ifndef NO_ph_prologue
        PH(ph_prologue(q, bid, nb));
#endif

    cg::this_grid().sync();
    { constexpr int l = 0;

#ifndef NO_ph_prep_weights
        PH(ph_prep_weights(q, l, bid, nb, (lds_fptr)smem));
#endif
        GSYNC(); STAMP(0);

#ifndef NO_ph_gemm_p
        PH(ph_gemm_p(q, l, bid, nb, ldsr));
#endif

#ifndef NO_ph_gemm_kv
        if (l == 0) PH(ph_gemm_kv(q, bid, nb, ldsr));
#endif
        GSYNC(); STAMP(1);

#ifndef NO_ph_sb_attn
        PH(ph_sb_attn(q, bid, nb, (__attribute__((address_space(3))) unsigned char*)smem));
#endif

STAMP(11);
#ifndef NO_ph_conv
        PH(ph_conv(q, l, bid, nb, (LASX unsigned char*)smem));
#endif
        GSYNC(); STAMP(2);

#ifndef NO_ph_merged
        PH(ph_merged(q, l, bid, nb, ldsr));
#endif
        GSYNC(); STAMP(3);

#ifndef NO_ph_gemm_wout
        PH(ph_gemm_wout(q, bid, nb, ldsr));
#endif
        GSYNC(); STAMP(4);

#ifndef NO_ph_gemm_xq
        PH(ph_gemm_xq(q, bid, nb, ldsr));
#endif
        GSYNC(); STAMP(5);

#ifndef NO_ph_xattn
        PH(ph_xattn(q, l, bid, nb, (LASX unsigned char*)smem));
#endif
        GSYNC(); STAMP(6);

#ifndef NO_ph_gemm_wo
        PH(ph_gemm_wo(q, bid, nb, ldsr));
#endif
        GSYNC(); STAMP(7);

#ifndef NO_ph_gemm_pq
        PH(ph_gemm_pq(q, bid, nb, ldsr));
#endif
        GSYNC(); STAMP(8);

#ifndef NO_ph_peer_score
        PH(ph_peer_score(q, bid, nb, (lds_fptr)smem));
#endif
        GSYNC(); STAMP(9);

#ifndef NO_ph_peer_gather
        PH(ph_peer_u(q, bid, nb, (lds_fptr)smem)); GSYNC(); STAMP(12);
        PH(ph_peer_v(q, bid, nb, (LASX unsigned char*)smem));
        if (l == DEPTH - 1) { GSYNC(); PH(ph_final_norm(q, bid, nb)); }
#endif
        if (l < DEPTH - 1 || PROBE_A >= 0) GSYNC();
        STAMP(10);
    }
    { constexpr int l = 1;

#ifndef NO_ph_prep_weights
        PH(ph_prep_weights(q, l, bid, nb, (lds_fptr)smem));
#endif
        GSYNC(); STAMP(0);

#ifndef NO_ph_gemm_p
        PH(ph_gemm_p(q, l, bid, nb, ldsr));
#endif

#ifndef NO_ph_gemm_kv
        if (l == 0) PH(ph_gemm_kv(q, bid, nb, ldsr));
#endif
        GSYNC(); STAMP(1);

#ifndef NO_ph_sb_attn
        PH(ph_sb_attn(q, bid, nb, (__attribute__((address_space(3))) unsigned char*)smem));
#endif

STAMP(11);
#ifndef NO_ph_conv
        PH(ph_conv(q, l, bid, nb, (LASX unsigned char*)smem));
#endif
        GSYNC(); STAMP(2);

#ifndef NO_ph_merged
        PH(ph_merged(q, l, bid, nb, ldsr));
#endif
        GSYNC(); STAMP(3);

#ifndef NO_ph_gemm_wout
        PH(ph_gemm_wout(q, bid, nb, ldsr));
#endif
        GSYNC(); STAMP(4);

#ifndef NO_ph_gemm_xq
        PH(ph_gemm_xq(q, bid, nb, ldsr));
#endif
        GSYNC(); STAMP(5);

#ifndef NO_ph_xattn
        PH(ph_xattn(q, l, bid, nb, (LASX unsigned char*)smem));
#endif
        GSYNC(); STAMP(6);

#ifndef NO_ph_gemm_wo
        PH(ph_gemm_wo(q, bid, nb, ldsr));
#endif
        GSYNC(); STAMP(7);

#ifndef NO_ph_gemm_pq
        PH(ph_gemm_pq(q, bid, nb, ldsr));
#endif
        GSYNC(); STAMP(8);

#ifndef NO_ph_peer_score
        PH(ph_peer_score(q, bid, nb, (lds_fptr)smem));
#endif
        GSYNC(); STAMP(9);

#ifndef NO_ph_peer_gather
        PH(ph_peer_u(q, bid, nb, (lds_fptr)smem)); GSYNC(); STAMP(12);
        PH(ph_peer_v(q, bid, nb, (LASX unsigned char*)smem));
        if (l == DEPTH - 1) { GSYNC(); PH(ph_final_norm(q, bid, nb)); }
#endif
        if (l < DEPTH - 1 || PROBE_A >= 0) GSYNC();
        STAMP(10);
    }
#if PROBE_A >= 0
    {
        __threadfence(); cg::this_grid().sync();
        if (bid == 0 && get_tid() == 0) {
            unsigned long long tot = 0;
            for (int l = 0; l < DEPTH; ++l) { const unsigned long long prev = (PROBE_P >= 0) ? ts[l * 16 + PROBE_P] : (l == 0 ? ts[40] : ts[(l - 1) * 16 + 10]); tot += ts[l * 16 + PROBE_A] - prev; }
            p.out[0] += (float)tot * 0.01f * 0.02f;
        }
    }
#endif
#undef PH
}

extern "C" void kernel_launch(void* const* d_in, const int* in_sizes, int n_in, void* d_out, int out_size, void* d_ws, size_t ws_size, hipStream_t stream) {
    static int grid = 0;
    if (grid == 0) {
        int dev = 0, cus = 0, per_cu = 0;
        hipGetDevice(&dev);
        hipDeviceGetAttribute(&cus, hipDeviceAttributeMultiprocessorCount, dev);
        hipFuncSetAttribute((const void*)mega_fwd, hipFuncAttributeMaxDynamicSharedMemorySize, LDS_BYTES);
        hipOccupancyMaxActiveBlocksPerMultiprocessor(&per_cu, (const void*)mega_fwd, NT, LDS_BYTES);
        if (per_cu < 1) per_cu = 1;
        grid = cus * per_cu;
        if (ws_size < WS_END) { fprintf(stderr, "kernel_launch: workspace too small (%zu < %zu)\n", ws_size, (size_t)WS_END); grid = -1; }
    }
    if (grid < 0) return;
    P p{};
    const float** pp = (const float**)&p;
    for (int i = 0; i < 23; ++i) pp[i] = (const float*)d_in[i];
    p.out = (float*)d_out; p.ws = (unsigned char*)d_ws;
    (void)hipMemsetAsync((char*)d_ws + WS_CTL, 0, 16384, stream);
    void* args[] = {&p};
    hipError_t e = hipLaunchCooperativeKernel((void*)mega_fwd, dim3(grid), dim3(NT), args, LDS_BYTES, stream);
    if (e != hipSuccess) fprintf(stderr, "cooperative launch failed: %s (grid %d)\n", hipGetErrorString(e), grid);
}
```

```cpp
#include <hip/hip_runtime.h>
#include <hip/hip_cooperative_groups.h>
#include <cstdio>
#include <stdint.h>
#include <math.h>

constexpr int D = 1024, BATCH = 8, SEQ = 2048, T = BATCH * SEQ, DEPTH = 2, NMEM = 256, TM = BATCH * NMEM;
constexpr int INW = 7168, OFF_CV = 1536, OFF_SC = 2560, OFF_GATE = 4096;
constexpr int YW = 1536;
constexpr int NEXP = 16384, PQW = 2048;
constexpr int NT = 512;

typedef uint16_t bf16_t;
typedef short bf16x8 __attribute__((ext_vector_type(8)));
typedef float f32x4 __attribute__((ext_vector_type(4)));
typedef unsigned u32x4 __attribute__((ext_vector_type(4)));
typedef unsigned u32x2 __attribute__((ext_vector_type(2)));
#define GAS __attribute__((address_space(1)))

constexpr size_t MiB = 1u << 20;
constexpr size_t WS_CTL = 0;
constexpr size_t WS_WIN = 1 * MiB;
constexpr size_t WS_WBR = 15 * MiB;
constexpr size_t WS_WOUT = 18 * MiB;
constexpr size_t WS_WXQ = 20 * MiB;
constexpr size_t WS_WKV = 22 * MiB;
constexpr size_t WS_WO = 26 * MiB;
constexpr size_t WS_WPQ = 28 * MiB;
constexpr size_t WS_KEYS = 32 * MiB;
constexpr size_t WS_U = 33 * MiB;
constexpr size_t WS_V = 49 * MiB;
constexpr size_t WS_USC = 65 * MiB;
constexpr size_t WS_VSC = 65 * MiB + 65536;
constexpr size_t WS_HB = 97 * MiB;
constexpr size_t WS_SSQ = 129 * MiB;
constexpr size_t WS_MEMSSQ = 256 * 1024;
constexpr size_t WS_MEMB = 130 * MiB;
constexpr size_t WS_KV = 134 * MiB;
constexpr size_t WS_Y = 142 * MiB;
constexpr size_t WS_MERGED = 190 * MiB;
constexpr size_t WS_P = 222 * MiB;
constexpr size_t WS_XQ = 222 * MiB;
constexpr size_t WS_XO = 254 * MiB;
constexpr size_t WS_PQ = 286 * MiB;
constexpr size_t WS_PIDX = 350 * MiB;
constexpr size_t WS_PG = 358 * MiB;
constexpr size_t WS_PD = 366 * MiB;
constexpr size_t WS_VT = 446 * MiB;
constexpr size_t WS_SBVT = 450 * MiB;
constexpr size_t WS_WKV2 = 466 * MiB;
constexpr size_t WS_KV2 = 474 * MiB;
constexpr size_t WS_VT2 = 490 * MiB;
constexpr size_t WS_END = 498 * MiB;

struct P {
    const float *x, *mem, *norm_mix_g, *w_in, *conv_dw_w, *conv_dw_b, *conv_ln_g, *conv_ln_b, *sc_w, *w_branch, *b_gate, *w_out,
        *norm_xa_g, *norm_mem_g, *xa_wq, *xa_wkv, *xa_wo, *norm_ffn_g, *peer_wq, *peer_keys, *peer_u, *peer_v, *final_g;
    float* out;
    unsigned char* ws;
};

__device__ __forceinline__ unsigned f2bf(float f) { unsigned u = __float_as_uint(f); return (u + 0x7fffu + ((u >> 16) & 1u)) >> 16; }
__device__ __forceinline__ unsigned pk2(float lo, float hi) { return f2bf(lo) | (f2bf(hi) << 16); }
__device__ __forceinline__ float bflo(unsigned w) { return __uint_as_float(w << 16); }
__device__ __forceinline__ float bfhi(unsigned w) { return __uint_as_float(w & 0xffff0000u); }
__device__ __forceinline__ float bf2f(bf16_t h) { return __uint_as_float(((unsigned)h) << 16); }
constexpr int LDS_BYTES = 147456;
constexpr int LDS_WTAB = LDS_BYTES - 512;
extern __shared__ __attribute__((aligned(16))) unsigned char smem[];
__device__ __forceinline__ int get_tid() {
    const unsigned hw = __builtin_amdgcn_s_getreg((5 << 11) | 4);
    const int w = ((volatile __attribute__((address_space(3))) int*)((__attribute__((address_space(3))) unsigned char*)smem + LDS_WTAB))[hw];
    unsigned ones = ~0u; asm volatile("" : "+s"(ones));
    int t = (w << 6) | (int)__builtin_amdgcn_mbcnt_hi(ones, __builtin_amdgcn_mbcnt_lo(ones, 0u));
    asm volatile("" : "+v"(t)); return t; }
__device__ __forceinline__ float shx(float v, int m, int lane) { return __uint_as_float((unsigned)__builtin_amdgcn_ds_bpermute((lane ^ m) << 2, (int)__float_as_uint(v))); }
template <int CTRL> __device__ __forceinline__ float dppf(float x) { return __uint_as_float((unsigned)__builtin_amdgcn_update_dpp(0, (int)__float_as_uint(x), CTRL, 0xF, 0xF, false)); }
__device__ __forceinline__ float swap32_sum(float a, float b) { auto r = __builtin_amdgcn_permlane32_swap(__float_as_uint(a), __float_as_uint(b), false, false); return __uint_as_float(r[0]) + __uint_as_float(r[1]); }
__device__ __forceinline__ float swap16_sum(float a, float b) { auto r = __builtin_amdgcn_permlane16_swap(__float_as_uint(a), __float_as_uint(b), false, false); return __uint_as_float(r[0]) + __uint_as_float(r[1]); }
__device__ __forceinline__ float wave_sum2(float x) {
    x += dppf<0x128>(x); x += dppf<0x124>(x); x += dppf<0x122>(x); x += dppf<0x121>(x);
    x = swap16_sum(x, x); x = swap32_sum(x, x); return x; }
__device__ __forceinline__ float wave_sum(float v, int) { return wave_sum2(v); }
__device__ __forceinline__ float wave_max(float x, int) {
    x = fmaxf(x, dppf<0x128>(x)); x = fmaxf(x, dppf<0x124>(x)); x = fmaxf(x, dppf<0x122>(x)); x = fmaxf(x, dppf<0x121>(x));
    { auto r = __builtin_amdgcn_permlane16_swap(__float_as_uint(x), __float_as_uint(x), false, false); x = fmaxf(__uint_as_float(r[0]), __uint_as_float(r[1])); }
    { auto r = __builtin_amdgcn_permlane32_swap(__float_as_uint(x), __float_as_uint(x), false, false); x = fmaxf(__uint_as_float(r[0]), __uint_as_float(r[1])); }
    return x; }
__device__ __forceinline__ float sigmoidf_(float z) { return 1.0f / (1.0f + __expf(-z)); }

__device__ __forceinline__ void row_to_bf16_rs(const float* src, float* dst_f32, bf16_t* dst_bf, float* rs_out, int lane) {
    const f32x4* s4 = (const f32x4*)src + lane;
    f32x4 v[4]; float ss = 0.f;
#pragma unroll
    for (int j = 0; j < 4; ++j) { v[j] = s4[64 * j]; ss += v[j].x * v[j].x + v[j].y * v[j].y + v[j].z * v[j].z + v[j].w * v[j].w; }
    ss = wave_sum(ss, lane);
    if (dst_f32) {
#pragma unroll
        for (int j = 0; j < 4; ++j) ((f32x4*)dst_f32 + lane)[64 * j] = v[j];
    }
#pragma unroll
    for (int j = 0; j < 4; ++j) { u32x2 w; w.x = pk2(v[j].x, v[j].y); w.y = pk2(v[j].z, v[j].w); ((u32x2*)dst_bf + lane)[64 * j] = w; }
    if (lane < 16) rs_out[lane] = lane == 0 ? ss : 0.f;
}
__device__ __forceinline__ void ph_prologue(const P& p, int bid, int nb) {
    const int tid = get_tid(), lane = tid & 63, wid = tid >> 6;
    const int gw = bid * 8 + wid, ngw = nb * 8;
    bf16_t* hb = (bf16_t*)(p.ws + WS_HB); float* rs = (float*)(p.ws + WS_SSQ);
    bf16_t* memb = (bf16_t*)(p.ws + WS_MEMB); float* mrs = (float*)(p.ws + WS_MEMSSQ);
    for (int r = gw; r < T; r += ngw) row_to_bf16_rs(p.x + (size_t)r * D, nullptr, hb + (size_t)r * D, rs + (size_t)r * 16, lane);
    for (int r = gw; r < TM; r += ngw) row_to_bf16_rs(p.mem + (size_t)r * D, nullptr, memb + (size_t)r * D, mrs + (size_t)r * 16, lane);
}
__device__ __forceinline__ void transpose_item(const float* W_, const float* g_, bf16_t* Wt_, int K, int N, int item, __attribute__((address_space(3))) float* scr, int lane) {
    const GAS float* W = (const GAS float*)W_; const GAS float* g = (const GAS float*)g_; GAS bf16_t* Wt = (GAS bf16_t*)Wt_;
    const int nblk = N / 32, kb = item / nblk, nbk = item % nblk, k0 = 64 * kb, n0 = 32 * nbk;
    float v[32];
#pragma unroll
    for (int i = 0; i < 32; ++i) { const int kk = 2 * i + (lane >> 5); v[i] = W[(size_t)(k0 + kk) * N + n0 + (lane & 31)]; }
    if (g_ != nullptr) {
#pragma unroll
        for (int i = 0; i < 32; ++i) v[i] *= g[k0 + 2 * i + (lane >> 5)];
    }
#pragma unroll
    for (int i = 0; i < 32; ++i) scr[(2 * i + (lane >> 5)) * 33 + (lane & 31)] = v[i];
    const int c = lane & 7;
#pragma unroll
    for (int j = 0; j < 4; ++j) {
        const int n = (lane >> 3) + 8 * j; const __attribute__((address_space(3))) float* sp = scr + (8 * c) * 33 + n;
        u32x4 o; o.x = pk2(sp[0 * 33], sp[1 * 33]); o.y = pk2(sp[2 * 33], sp[3 * 33]); o.z = pk2(sp[4 * 33], sp[5 * 33]); o.w = pk2(sp[6 * 33], sp[7 * 33]);
        *(GAS u32x4*)(Wt + (size_t)(n0 + n) * K + k0 + 8 * c) = o;
    }
}
__device__ __forceinline__ void ph_prep_weights(const P& p, int l, int bid, int nb, __attribute__((address_space(3))) float* ldsf) {
    unsigned char* ws = p.ws;
    {
        const int tid = get_tid(), lane = tid & 63, wid = __builtin_amdgcn_readfirstlane(tid >> 6);
        __attribute__((address_space(3))) float* scr = ldsf + wid * (64 * 33);
        constexpr int I0 = 16 * 224, I1 = 8 * 32, I4 = 16 * 32, I6 = 16 * 64;
        constexpr int NITEMS = I0 + 3 * I1 + I4 + I4 + I6 + I4 + I6;
#pragma unroll 1
        for (int it = bid * 8 + wid; it < NITEMS; it += nb * 8) {
            int r = it;
            if (r < I0) { transpose_item(p.w_in + (size_t)l * D * INW, p.norm_mix_g + l * D, (bf16_t*)(ws + WS_WIN), D, INW, r, scr, lane); continue; } r -= I0;
            if (r < 3 * I1) { const int b = r / I1; transpose_item(p.w_branch + ((size_t)l * 3 + b) * 512 * D, nullptr, (bf16_t*)(ws + WS_WBR) + (size_t)b * 1024 * 512, 512, D, r % I1, scr, lane); continue; } r -= 3 * I1;
            if (r < I4) { transpose_item(p.w_out + (size_t)l * D * D, nullptr, (bf16_t*)(ws + WS_WOUT), D, D, r, scr, lane); continue; } r -= I4;
            if (r < I4) { transpose_item(p.xa_wq + (size_t)l * D * D, p.norm_xa_g + l * D, (bf16_t*)(ws + WS_WXQ), D, D, r, scr, lane); continue; } r -= I4;
            if (r < I6) { if (l == 0) { transpose_item(p.xa_wkv, p.norm_mem_g, (bf16_t*)(ws + WS_WKV2), D, 2 * D, r, scr, lane); transpose_item(p.xa_wkv + (size_t)D * 2 * D, p.norm_mem_g + D, (bf16_t*)(ws + WS_WKV2) + (size_t)2 * D * D, D, 2 * D, r, scr, lane); } continue; } r -= I6;
            if (r < I4) { transpose_item(p.xa_wo + (size_t)l * D * D, nullptr, (bf16_t*)(ws + WS_WO), D, D, r, scr, lane); continue; } r -= I4;
            transpose_item(p.peer_wq + (size_t)l * D * PQW, p.norm_ffn_g + l * D, (bf16_t*)(ws + WS_WPQ), D, PQW, r, scr, lane);
        }
    }
    {
        const int tid = get_tid(), lane = tid & 63, wid = tid >> 6;
        const f32x4* g4 = (const f32x4*)(p.norm_ffn_g + l * D) + 4 * lane;
        const f32x4 gg0 = g4[0], gg1 = g4[1], gg2 = g4[2], gg3 = g4[3];
#pragma unroll 1
        for (int row0 = bid * 8 + wid; row0 < 2 * NEXP; row0 += 2 * nb * 8) {
            f32x4 a[2][4];
#pragma unroll
            for (int h2 = 0; h2 < 2; ++h2) {
                const int row = row0 + h2 * nb * 8; const bool isv = row >= NEXP; const int e = isv ? row - NEXP : row;
                const GAS f32x4* src = (const GAS f32x4*)((isv ? p.peer_v : p.peer_u) + ((size_t)l * NEXP + (row < 2 * NEXP ? e : 0)) * D) + 4 * lane;
                a[h2][0] = src[0]; a[h2][1] = src[1]; a[h2][2] = src[2]; a[h2][3] = src[3];
            }
#pragma unroll
            for (int h2 = 0; h2 < 2; ++h2) {
                const int row = row0 + h2 * nb * 8; const bool isv = row >= NEXP; const int e = isv ? row - NEXP : row;
                if (row < 2 * NEXP) {
                    f32x4 a0 = a[h2][0], a1 = a[h2][1], a2 = a[h2][2], a3 = a[h2][3];
                    if (!isv) { a0 *= gg0; a1 *= gg1; a2 *= gg2; a3 *= gg3; }
                    float m = 0.f;
#pragma unroll
                    for (int i = 0; i < 4; ++i) m = fmaxf(m, fmaxf(fmaxf(fabsf(a0[i]), fabsf(a1[i])), fmaxf(fabsf(a2[i]), fabsf(a3[i]))));
                    m = wave_max(m, lane);
                    const float sc = m > 0.f ? 240.0f / m : 1.0f;
                    u32x4 w;
                    w.x = (unsigned)__builtin_amdgcn_cvt_pk_fp8_f32(a0[2] * sc, a0[3] * sc, __builtin_amdgcn_cvt_pk_fp8_f32(a0[0] * sc, a0[1] * sc, 0, false), true);
                    w.y = (unsigned)__builtin_amdgcn_cvt_pk_fp8_f32(a1[2] * sc, a1[3] * sc, __builtin_amdgcn_cvt_pk_fp8_f32(a1[0] * sc, a1[1] * sc, 0, false), true);
                    w.z = (unsigned)__builtin_amdgcn_cvt_pk_fp8_f32(a2[2] * sc, a2[3] * sc, __builtin_amdgcn_cvt_pk_fp8_f32(a2[0] * sc, a2[1] * sc, 0, false), true);
                    w.w = (unsigned)__builtin_amdgcn_cvt_pk_fp8_f32(a3[2] * sc, a3[3] * sc, __builtin_amdgcn_cvt_pk_fp8_f32(a3[0] * sc, a3[1] * sc, 0, false), true);
                    ((GAS u32x4*)(ws + (isv ? WS_V : WS_U)) + (size_t)e * 64)[lane] = w;
                    if (lane == 0) ((GAS float*)(ws + (isv ? WS_VSC : WS_USC)))[e] = m > 0.f ? m * (1.0f / 240.0f) : 1.0f;
                }
            }
        }
    }
    const size_t gt = (size_t)bid * NT + get_tid(), gn = (size_t)nb * NT;
    const f32x4* k4 = (const f32x4*)(p.peer_keys + (size_t)l * 8 * 2 * 128 * 128); u32x2* kb = (u32x2*)(ws + WS_KEYS);
    for (size_t i = gt; i < (size_t)8 * 2 * 128 * 128 / 4; i += gn) { const f32x4 a = k4[i]; u32x2 w; w.x = pk2(a.x, a.y); w.y = pk2(a.z, a.w); kb[i] = w; }
}

namespace pg8 {
#define PG8_LAS __attribute__((address_space(3)))
constexpr int BM = 256, BK = 64, HALF = 128, HTB = HALF * BK * 2  , STAGE_BYTES = 8 * HTB, NXCD = 8, WGM = 8;

__host__ __device__ __forceinline__ int lds_byte(int r, int c) { const int st = (r >> 4) * 2 + (c >> 5), rr = r & 15, cc = c & 31, ob = rr * 64 + cc * 2; return st * 1024 + (ob ^ (((ob >> 9) & 1) << 5)); }
__host__ __device__ __forceinline__ void stage_rc(int b, int& R, int& C) { const int st = b / 1024, sb = b % 1024, swz = sb ^ (((sb >> 9) & 1) << 5); R = (st >> 1) * 16 + swz / 64; C = (st & 1) * 32 + (swz % 64) / 2; }
__host__ __device__ __forceinline__ int perm32(int rho) { const int n = rho >> 4, i = rho & 15; return 8 * (i >> 2) + 4 * n + (i & 3); }

struct Unit { int pm, pn, pb; };
struct Gemm { const bf16_t* A; const bf16_t* Bt; int K; size_t a_bs, b_bs; };

struct StaticOrder {
    int nM, nN, nwg, G, c;
    __host__ __device__ void init(int M, int N, int G_, int c_) { nM = M / BM; nN = N / BM; nwg = nM * nN; G = G_; c = c_; }
    __host__ __device__ bool next(int i, Unit& u) const {
        const long L = (long)i * G + c; if (L >= nwg) return false;
        int wgid = (int)L; { const int q = nwg / NXCD, r = nwg % NXCD, xcd = wgid % NXCD, off = wgid / NXCD; wgid = (xcd < r ? xcd * (q + 1) : r * (q + 1) + (xcd - r) * q) + off; }
        const int nig = WGM * nN, gid = wgid / nig, fm = gid * WGM, gsz = (nM - fm) < WGM ? (nM - fm) : WGM;
        u.pm = fm + ((wgid % nig) % gsz); u.pn = (wgid % nig) / gsz; u.pb = 0; return true;
    }
    __device__ __forceinline__ void a_ready(const Unit&) const {}
    __device__ __forceinline__ void done(const Unit&) const {}
};
__device__ __forceinline__ unsigned cvt_pk_bf16(float lo, float hi) { unsigned r; asm volatile("v_cvt_pk_bf16_f32 %0, %1, %2" : "=v"(r) : "v"(lo), "v"(hi)); return r; }
template <class Epi, class Sched, bool ALIGN_EPI = false, bool SP2 = false>
__device__ __forceinline__ void gemm_phase(PG8_LAS unsigned char* lds, const Gemm g, const Sched& S, const Epi& E) {
    const int tid = get_tid(), wid = __builtin_amdgcn_readfirstlane(tid >> 6), lane = tid & 63, wr = wid >> 2, wc = wid & 3, fr = lane & 15, fq = lane >> 4;
    const int K = g.K, nt = K / BK;
    unsigned voffA[2], voffB[2];
#pragma unroll
    for (int i = 0; i < 2; ++i) { int R, C; stage_rc(tid * 16 + i * 8192, R, C); const int Rb = Epi::PERM ? ((R & ~31) + perm32(R & 31)) : R;
        voffA[i] = (unsigned)(R * K + C) * 2u; voffB[i] = (unsigned)(Rb * K + C) * 2u; }
    const size_t kstep = (size_t)(BK * 2);
    const size_t hstep = (size_t)HALF * K * 2;
    const size_t tstep = 2 * hstep;
    const unsigned ldsw = (unsigned)wid * 1024u;
    const int aoff = lds_byte(wr * 64 + fr, fq * 8), boff = lds_byte(wc * 32 + fr, fq * 8);
#define PG8_SA(b, h) (((b) * 2 + (h)) * HTB)
#define PG8_SB(b, h) ((4 + (b) * 2 + (h)) * HTB)
#define PG8_STAGE(bufoff, gbase, voff) do { _Pragma("unroll") for (int _i = 0; _i < 2; ++_i) \
        __builtin_amdgcn_global_load_lds((const unsigned*)((const char*)(gbase) + (voff)[_i]), (PG8_LAS unsigned*)(lds + (bufoff) + ldsw + _i * 8192), 16, 0, 0); } while (0)
#define PG8_LDA(dst, b, h) do { _Pragma("unroll") for (int m = 0; m < 4; ++m) _Pragma("unroll") for (int k = 0; k < 2; ++k) dst[m][k] = *(const PG8_LAS bf16x8*)(lds + PG8_SA(b, h) + aoff + m * 2048 + k * 1024); } while (0)
#define PG8_LDB(dst, b, h) do { _Pragma("unroll") for (int n = 0; n < 2; ++n) _Pragma("unroll") for (int k = 0; k < 2; ++k) dst[n][k] = *(const PG8_LAS bf16x8*)(lds + PG8_SB(b, h) + boff + n * 2048 + k * 1024); } while (0)
#define PG8_MMA(ai, bj, At, Bt) do { __builtin_amdgcn_s_setprio(1); _Pragma("unroll") for (int m = 0; m < 4; ++m) _Pragma("unroll") for (int n = 0; n < 2; ++n) _Pragma("unroll") for (int k = 0; k < 2; ++k) \
        acc[ai][bj][m][n] = __builtin_amdgcn_mfma_f32_16x16x32_bf16(Bt[n][k], At[m][k], acc[ai][bj][m][n], 0, 0, 0); __builtin_amdgcn_s_setprio(0); } while (0)
#define PG8_WAIT_V(n) asm volatile("s_waitcnt vmcnt(" #n ")" ::: "memory")
#define PG8_WAIT_L(n) asm volatile("s_waitcnt lgkmcnt(" #n ")" ::: "memory")
#define PG8_BAR __builtin_amdgcn_s_barrier()
#define PG8_SCHED __builtin_amdgcn_sched_barrier(0)
    Unit cur, nxt; int ui = 0;
    if (!S.next(0, cur)) return;
    f32x4 acc[2][2][4][2];
#pragma unroll
    for (int a = 0; a < 2; ++a)
#pragma unroll
        for (int b = 0; b < 2; ++b)
#pragma unroll
            for (int m = 0; m < 4; ++m)
#pragma unroll
                for (int n = 0; n < 2; ++n) acc[a][b][m][n] = (f32x4){0.f, 0.f, 0.f, 0.f};
    bf16x8 At[4][2], B0[2][2], B1[2][2];
    const char* cA = (const char*)g.A + (size_t)cur.pm * tstep + (size_t)cur.pb * g.a_bs; const char* cB = (const char*)g.Bt + (size_t)cur.pn * tstep + (size_t)cur.pb * g.b_bs;
    S.a_ready(cur);
    if constexpr (SP2) {
        PG8_STAGE(PG8_SB(0, 0), cB, voffB); PG8_STAGE(PG8_SB(0, 1), cB + hstep, voffB); PG8_STAGE(PG8_SA(0, 0), cA, voffA); PG8_STAGE(PG8_SA(0, 1), cA + hstep, voffA);
        if (wr == 1) PG8_BAR;
        PG8_WAIT_V(2); PG8_BAR;
        PG8_STAGE(PG8_SB(1, 0), cB + kstep, voffB); PG8_STAGE(PG8_SA(1, 0), cA + kstep, voffA); PG8_STAGE(PG8_SB(1, 1), cB + hstep + kstep, voffB);
        PG8_WAIT_V(6); PG8_BAR;
    } else {
        PG8_STAGE(PG8_SB(0, 0), cB, voffB); PG8_STAGE(PG8_SA(0, 0), cA, voffA); PG8_STAGE(PG8_SB(0, 1), cB + hstep, voffB); PG8_STAGE(PG8_SA(0, 1), cA + hstep, voffA);
        if (wr == 1) PG8_BAR;
        PG8_WAIT_V(4); PG8_BAR;
        PG8_STAGE(PG8_SB(1, 0), cB + kstep, voffB); PG8_STAGE(PG8_SA(1, 0), cA + kstep, voffA); PG8_STAGE(PG8_SB(1, 1), cB + hstep + kstep, voffB);
        PG8_WAIT_V(6); PG8_BAR;
    }
    for (;;) {
        const bool has_next = S.next(ui + 1, nxt);
        const char* nA = has_next ? (const char*)g.A + (size_t)nxt.pm * tstep + (size_t)nxt.pb * g.a_bs : cA; const char* nB = has_next ? (const char*)g.Bt + (size_t)nxt.pn * tstep + (size_t)nxt.pb * g.b_bs : cB;
        for (int t = 0; t < nt; t += 2) {
            const bool last = (t == nt - 2);
            const char* a1 = cA + (size_t)(t + 1) * kstep;
            const char* a2 = last ? nA : cA + (size_t)(t + 2) * kstep; const char* b2 = last ? nB : cB + (size_t)(t + 2) * kstep;
            const char* a3 = a2 + kstep; const char* b3 = b2 + kstep;
            if (last && has_next) S.a_ready(nxt);
            if constexpr (SP2) {
            PG8_LDB(B0, 0, 0); PG8_LDB(B1, 0, 1); PG8_SCHED; PG8_LDA(At, 0, 0); PG8_STAGE(PG8_SA(1, 1), a1 + hstep, voffA);
            PG8_WAIT_V(8); PG8_WAIT_L(0); PG8_BAR; PG8_MMA(0, 0, At, B0); PG8_MMA(0, 1, At, B1); PG8_BAR; PG8_SCHED;
            PG8_LDA(At, 0, 1); PG8_STAGE(PG8_SB(0, 0), b2, voffB); PG8_STAGE(PG8_SB(0, 1), b2 + hstep, voffB); PG8_STAGE(PG8_SA(0, 0), a2, voffA);
            PG8_WAIT_V(8); PG8_WAIT_L(0); PG8_BAR; PG8_MMA(1, 0, At, B0); PG8_MMA(1, 1, At, B1); PG8_BAR; PG8_SCHED;
            PG8_LDB(B0, 1, 0); PG8_LDB(B1, 1, 1); PG8_SCHED; PG8_LDA(At, 1, 0); PG8_STAGE(PG8_SA(0, 1), a2 + hstep, voffA);
            PG8_WAIT_V(8); PG8_WAIT_L(0); PG8_BAR; PG8_MMA(0, 0, At, B0); PG8_MMA(0, 1, At, B1); PG8_BAR; PG8_SCHED;
            PG8_LDA(At, 1, 1); PG8_STAGE(PG8_SB(1, 0), b3, voffB); PG8_STAGE(PG8_SB(1, 1), b3 + hstep, voffB); PG8_STAGE(PG8_SA(1, 0), a3, voffA);
            PG8_WAIT_V(8); PG8_WAIT_L(0); PG8_BAR; PG8_MMA(1, 0, At, B0); PG8_MMA(1, 1, At, B1); PG8_BAR; PG8_SCHED;
            } else {
            PG8_LDB(B0, 0, 0); PG8_SCHED; PG8_LDA(At, 0, 0); PG8_STAGE(PG8_SA(1, 1), a1 + hstep, voffA);
            PG8_WAIT_L(8); PG8_BAR; PG8_WAIT_L(0); PG8_MMA(0, 0, At, B0); PG8_BAR; PG8_SCHED;
            PG8_LDB(B1, 0, 1); PG8_STAGE(PG8_SB(0, 0), b2, voffB);
            PG8_BAR; PG8_WAIT_L(0); PG8_MMA(0, 1, At, B1); PG8_BAR;
            PG8_LDA(At, 0, 1); PG8_STAGE(PG8_SA(0, 0), a2, voffA);
            PG8_BAR; PG8_WAIT_L(0); PG8_MMA(1, 0, At, B0); PG8_BAR; PG8_SCHED;
            PG8_STAGE(PG8_SB(0, 1), b2 + hstep, voffB);
            PG8_WAIT_V(6); PG8_BAR; PG8_MMA(1, 1, At, B1); PG8_BAR;
            PG8_LDB(B0, 1, 0); PG8_SCHED; PG8_LDA(At, 1, 0); PG8_STAGE(PG8_SA(0, 1), a2 + hstep, voffA);
            PG8_WAIT_L(8); PG8_BAR; PG8_WAIT_L(0); PG8_MMA(0, 0, At, B0); PG8_BAR; PG8_SCHED;
            PG8_LDB(B1, 1, 1); PG8_STAGE(PG8_SB(1, 0), b3, voffB);
            PG8_BAR; PG8_WAIT_L(0); PG8_MMA(0, 1, At, B1); PG8_BAR;
            PG8_LDA(At, 1, 1); PG8_STAGE(PG8_SA(1, 0), a3, voffA);
            PG8_BAR; PG8_WAIT_L(0); PG8_MMA(1, 0, At, B0); PG8_BAR; PG8_SCHED;
            PG8_STAGE(PG8_SB(1, 1), b3 + hstep, voffB);
            PG8_WAIT_V(6); PG8_BAR; PG8_MMA(1, 1, At, B1); PG8_BAR;
            }
        }
        if constexpr (ALIGN_EPI) { if (wr == 0) PG8_BAR; }
        if constexpr (!Epi::AFTER_DRAIN) { E(acc, cur, wr, wc, fr, fq); S.done(cur); }
        if (!has_next) break;
        if (!E.keep(cur))
#pragma unroll
        for (int a = 0; a < 2; ++a)
#pragma unroll
            for (int b = 0; b < 2; ++b)
#pragma unroll
                for (int m = 0; m < 4; ++m)
#pragma unroll
                    for (int n = 0; n < 2; ++n) acc[a][b][m][n] = (f32x4){0.f, 0.f, 0.f, 0.f};
        cur = nxt; cA = nA; cB = nB; ++ui;
        if constexpr (ALIGN_EPI) { if (wr == 1) PG8_BAR; }
    }
    PG8_WAIT_V(0);
    if constexpr (!ALIGN_EPI) { if (wr == 0) PG8_BAR; }
    PG8_BAR;
    if constexpr (Epi::AFTER_DRAIN) { E.fused(acc, cur, wr, wc, fr, fq, lds, wid, lane); S.done(cur); }
#undef PG8_SA
#undef PG8_SB
#undef PG8_STAGE
#undef PG8_LDA
#undef PG8_LDB
#undef PG8_MMA
#undef PG8_WAIT_V
#undef PG8_WAIT_L
#undef PG8_BAR
#undef PG8_SCHED
}

struct TripleOrder {
    StaticOrder so;
    __device__ void init(int M, int N, int G_, int c_) { so.init(M, N, G_, c_); }
    __device__ bool next(int i, Unit& u) const { if (!so.next(i / 3, u)) return false; u.pb = i % 3; return true; }
    __device__ __forceinline__ void a_ready(const Unit&) const {}
    __device__ __forceinline__ void done(const Unit&) const {}
};
__device__ __forceinline__ float row_rs(const float* ssq, int row, int fq, int lane) {
    const f32x4 v = *(const f32x4*)(ssq + (size_t)row * 16 + 4 * fq);
    float s = (v.x + v.y) + (v.z + v.w); s = swap16_sum(s, s); s = swap32_sum(s, s);
    return rsqrtf(s * (1.0f / 1024.0f) + 1e-6f);
}
struct EpiScale {
    static constexpr bool PERM = true, AFTER_DRAIN = false;
    bf16_t* O; int ldo; const float* ssq; int ncol0; float s0; bf16_t* VT;
    __device__ __forceinline__ bool keep(const Unit&) const { return false; }
    __device__ __forceinline__ void operator()(f32x4 (&acc)[2][2][4][2], const Unit& u, int wr, int wc, int fr, int fq) const {
        const int row0 = u.pm * BM + wr * 64 + fr, col0 = u.pn * BM + wc * 32 + 8 * fq;
#pragma unroll
        for (int ai = 0; ai < 2; ++ai)
#pragma unroll
            for (int m = 0; m < 4; ++m) {
                const int row = row0 + ai * HALF + m * 16;
                const float rs = row_rs(ssq, row, fq, fq * 16 + fr);
#pragma unroll
                for (int bj = 0; bj < 2; ++bj) {
                    const int c = col0 + bj * HALF; const float sc = rs * (c < ncol0 ? s0 : 1.0f);
                    const f32x4 v0 = acc[ai][bj][m][0] * sc, v1 = acc[ai][bj][m][1] * sc;
                    u32x4 w; w.x = cvt_pk_bf16(v0[0], v0[1]); w.y = cvt_pk_bf16(v0[2], v0[3]); w.z = cvt_pk_bf16(v1[0], v1[1]); w.w = cvt_pk_bf16(v1[2], v1[3]);
                    *(u32x4*)(O + (size_t)row * ldo + c) = w;
                    if (VT != nullptr && c >= 1024 && c < 1536) {
                        const int b = row >> 11, sq = row & 2047, cc = c - 1024;
                        bf16_t* vp = VT + ((size_t)(b * 512 + cc)) * 2048 + sq;
                        vp[0 * 2048] = (bf16_t)(w.x & 0xffffu); vp[1 * 2048] = (bf16_t)(w.x >> 16); vp[2 * 2048] = (bf16_t)(w.y & 0xffffu); vp[3 * 2048] = (bf16_t)(w.y >> 16);
                        vp[4 * 2048] = (bf16_t)(w.z & 0xffffu); vp[5 * 2048] = (bf16_t)(w.z >> 16); vp[6 * 2048] = (bf16_t)(w.w & 0xffffu); vp[7 * 2048] = (bf16_t)(w.w >> 16);
                    }
                }
            }
    }
};
struct EpiKV {
    static constexpr bool PERM = true, AFTER_DRAIN = false;
    bf16_t* O; bf16_t* VT; const float* ssq;
    __device__ __forceinline__ bool keep(const Unit&) const { return false; }
    __device__ __forceinline__ void operator()(f32x4 (&acc)[2][2][4][2], const Unit& u, int wr, int wc, int fr, int fq) const {
        const int row0 = u.pm * BM + wr * 64 + fr, col0 = u.pn * BM + wc * 32 + 8 * fq;
#pragma unroll
        for (int ai = 0; ai < 2; ++ai)
#pragma unroll
            for (int m = 0; m < 4; ++m) {
                const int row = row0 + ai * HALF + m * 16;
                const float rs = row_rs(ssq, row, fq, fq * 16 + fr);
#pragma unroll
                for (int bj = 0; bj < 2; ++bj) {
                    const int cfull = col0 + bj * HALF, layer = cfull >> 11, c = cfull & 2047;
                    const f32x4 v0 = acc[ai][bj][m][0] * rs, v1 = acc[ai][bj][m][1] * rs;
                    u32x4 w; w.x = cvt_pk_bf16(v0[0], v0[1]); w.y = cvt_pk_bf16(v0[2], v0[3]); w.z = cvt_pk_bf16(v1[0], v1[1]); w.w = cvt_pk_bf16(v1[2], v1[3]);
                    if (c < 1024) { *(u32x4*)(O + (size_t)layer * TM * 2048 + (size_t)row * 2048 + c) = w; }
                    else {
                        const int b = row >> 8, mem = row & 255, cc = c - 1024;
                        bf16_t* vp = VT + (size_t)layer * (8 * 4 * 256 * 256) + ((size_t)(b * 4 + (cc >> 8)) * 256 + (cc & 255)) * 256 + mem;
                        vp[0 * 256] = (bf16_t)(w.x & 0xffffu); vp[1 * 256] = (bf16_t)(w.x >> 16); vp[2 * 256] = (bf16_t)(w.y & 0xffffu); vp[3 * 256] = (bf16_t)(w.y >> 16);
                        vp[4 * 256] = (bf16_t)(w.z & 0xffffu); vp[5 * 256] = (bf16_t)(w.z >> 16); vp[6 * 256] = (bf16_t)(w.w & 0xffffu); vp[7 * 256] = (bf16_t)(w.w >> 16);
                    }
                }
            }
    }
};
struct EpiResidual {
    static constexpr bool PERM = true, AFTER_DRAIN = false;
    bf16_t* HB; float* ssq;
    __device__ __forceinline__ bool keep(const Unit&) const { return false; }
    __device__ __forceinline__ void operator()(f32x4 (&acc)[2][2][4][2], const Unit& u, int wr, int wc, int fr, int fq) const {
        const int row0 = u.pm * BM + wr * 64 + fr, col0 = u.pn * BM + wc * 32 + 8 * fq;
#pragma unroll
        for (int ai = 0; ai < 2; ++ai)
#pragma unroll
            for (int m = 0; m < 4; ++m) {
                const int row = row0 + ai * HALF + m * 16; float sq = 0.f;
#pragma unroll
                for (int bj = 0; bj < 2; ++bj) {
                    const int c = col0 + bj * HALF;
                    u32x4* hp = (u32x4*)(HB + (size_t)row * D + c);
                    const u32x4 hv = *hp;
                    const f32x4 a = (f32x4){bflo(hv.x), bfhi(hv.x), bflo(hv.y), bfhi(hv.y)} + acc[ai][bj][m][0], b = (f32x4){bflo(hv.z), bfhi(hv.z), bflo(hv.w), bfhi(hv.w)} + acc[ai][bj][m][1];
                    u32x4 w; w.x = cvt_pk_bf16(a[0], a[1]); w.y = cvt_pk_bf16(a[2], a[3]); w.z = cvt_pk_bf16(b[0], b[1]); w.w = cvt_pk_bf16(b[2], b[3]);
                    *hp = w;
                    const float r0 = bflo(w.x), r1 = bfhi(w.x), r2 = bflo(w.y), r3 = bfhi(w.y), r4 = bflo(w.z), r5 = bfhi(w.z), r6 = bflo(w.w), r7 = bfhi(w.w);
                    sq += (r0 * r0 + r1 * r1) + (r2 * r2 + r3 * r3) + (r4 * r4 + r5 * r5) + (r6 * r6 + r7 * r7);
                }
                sq = swap16_sum(sq, sq); sq = swap32_sum(sq, sq);
                if (fq == 0) ssq[(size_t)row * 16 + u.pn * 4 + wc] = sq;
            }
    }
};
struct EpiMerged {
    static constexpr bool PERM = true, AFTER_DRAIN = false;
    const bf16_t* Pg;
    const float* bg;
    bf16_t* O;
    __device__ __forceinline__ bool keep(const Unit& u) const { return u.pb < 2; }
    __device__ __forceinline__ void operator()(f32x4 (&acc)[2][2][4][2], const Unit& u, int wr, int wc, int fr, int fq) const {
        const int row0 = u.pm * BM + wr * 64 + fr, col0 = u.pn * BM + wc * 32 + 8 * fq, b = u.pb;
        f32x4 bb[2][2], bn[2][2];
#pragma unroll
        for (int bj = 0; bj < 2; ++bj)
#pragma unroll
            for (int n = 0; n < 2; ++n) {
                bb[bj][n] = *(const f32x4*)(bg + b * D + col0 + bj * HALF + 4 * n);
                bn[bj][n] = (b < 2) ? *(const f32x4*)(bg + (b + 1) * D + col0 + bj * HALF + 4 * n) : (f32x4){0.f, 0.f, 0.f, 0.f};
            }
#pragma unroll
        for (int ai = 0; ai < 2; ++ai)
#pragma unroll
            for (int m = 0; m < 4; ++m) {
                const int row = row0 + ai * HALF + m * 16;
#pragma unroll
                for (int bj = 0; bj < 2; ++bj) {
                    const int c = col0 + bj * HALF;
                    const bf16_t* gp = Pg + (size_t)row * INW + b * D + c;
                    const u32x4 zb = *(const u32x4*)gp;
                    u32x4 zn = (u32x4){0u, 0u, 0u, 0u};
                    if (b < 2) zn = *(const u32x4*)(gp + D);
                    float f[8];
#pragma unroll
                    for (int j = 0; j < 8; ++j) {
                        const unsigned wb = zb[j >> 1], wn = zn[j >> 1];
                        const float z0 = ((j & 1) ? bfhi(wb) : bflo(wb)) + bb[bj][j >> 2][j & 3];
                        const float e0 = 1.0f + __expf(-fmaxf(z0, -30.f));
                        float num = 1.0f;
                        if (b < 2) { const float z1 = ((j & 1) ? bfhi(wn) : bflo(wn)) + bn[bj][j >> 2][j & 3]; num = 1.0f + __expf(-fmaxf(z1, -30.f)); }
                        f[j] = num * __builtin_amdgcn_rcpf(e0);
                    }
                    f32x4 v0 = acc[ai][bj][m][0], v1 = acc[ai][bj][m][1];
                    v0[0] *= f[0]; v0[1] *= f[1]; v0[2] *= f[2]; v0[3] *= f[3]; v1[0] *= f[4]; v1[1] *= f[5]; v1[2] *= f[6]; v1[3] *= f[7];
                    acc[ai][bj][m][0] = v0; acc[ai][bj][m][1] = v1;
                    if (b == 2) {
                        u32x4 w; w.x = cvt_pk_bf16(v0[0], v0[1]); w.y = cvt_pk_bf16(v0[2], v0[3]); w.z = cvt_pk_bf16(v1[0], v1[1]); w.w = cvt_pk_bf16(v1[2], v1[3]);
                        *(u32x4*)(O + (size_t)row * D + c) = w;
                    }
                }
            }
    }
};
}

typedef __attribute__((address_space(3))) unsigned char* lds_ptr;
__device__ __forceinline__ void ph_gemm_p(const P& p, int bid, int nb, lds_ptr lds) {
    pg8::Gemm g{(const bf16_t*)(p.ws + WS_HB), (const bf16_t*)(p.ws + WS_WIN), D, 0, 0}; pg8::StaticOrder S; S.init(T, INW, nb, bid);
    pg8::EpiScale E{(bf16_t*)(p.ws + WS_P), INW, (const float*)(p.ws + WS_SSQ), 512, 0.125f * 1.4426950408889634f, (bf16_t*)(p.ws + WS_SBVT)};
    pg8::gemm_phase<pg8::EpiScale, pg8::StaticOrder, true, true>(lds, g, S, E);
}
__device__ __forceinline__ void ph_gemm_kv(const P& p, int bid, int nb, lds_ptr lds) {
    pg8::Gemm g{(const bf16_t*)(p.ws + WS_MEMB), (const bf16_t*)(p.ws + WS_WKV2), D, 0, 0}; pg8::StaticOrder S; S.init(TM, 2 * 2 * D, nb, bid);
    pg8::EpiKV E{(bf16_t*)(p.ws + WS_KV2), (bf16_t*)(p.ws + WS_VT2), (const float*)(p.ws + WS_MEMSSQ)};
    pg8::gemm_phase<pg8::EpiKV, pg8::StaticOrder, true, true>(lds, g, S, E);
}
__device__ __forceinline__ void ph_merged(const P& p, int l, int bid, int nb, lds_ptr lds) {
    pg8::Gemm g{(const bf16_t*)(p.ws + WS_Y), (const bf16_t*)(p.ws + WS_WBR), 512, (size_t)T * 512 * 2, (size_t)1024 * 512 * 2}; pg8::TripleOrder S; S.init(T, D, nb, bid);
    pg8::EpiMerged E{(const bf16_t*)(p.ws + WS_P) + OFF_GATE, p.b_gate + (size_t)l * 3 * D, (bf16_t*)(p.ws + WS_MERGED)};
    pg8::gemm_phase<pg8::EpiMerged, pg8::TripleOrder, true, true>(lds, g, S, E);
}
__device__ __forceinline__ void ph_gemm_wout(const P& p, int bid, int nb, lds_ptr lds) {
    pg8::Gemm g{(const bf16_t*)(p.ws + WS_MERGED), (const bf16_t*)(p.ws + WS_WOUT), D, 0, 0}; pg8::StaticOrder S; S.init(T, D, nb, bid);
    pg8::EpiResidual E{(bf16_t*)(p.ws + WS_HB), (float*)(p.ws + WS_SSQ)};
    pg8::gemm_phase<pg8::EpiResidual, pg8::StaticOrder, true, true>(lds, g, S, E);
}
__device__ __forceinline__ void ph_gemm_xq(const P& p, int bid, int nb, lds_ptr lds) {
    pg8::Gemm g{(const bf16_t*)(p.ws + WS_HB), (const bf16_t*)(p.ws + WS_WXQ), D, 0, 0}; pg8::StaticOrder S; S.init(T, D, nb, bid);
    pg8::EpiScale E{(bf16_t*)(p.ws + WS_XQ), D, (const float*)(p.ws + WS_SSQ), D, 0.0625f, nullptr};
    pg8::gemm_phase<pg8::EpiScale, pg8::StaticOrder, true, true>(lds, g, S, E);
}
__device__ __forceinline__ void ph_gemm_wo(const P& p, int bid, int nb, lds_ptr lds) {
    pg8::Gemm g{(const bf16_t*)(p.ws + WS_XO), (const bf16_t*)(p.ws + WS_WO), D, 0, 0}; pg8::StaticOrder S; S.init(T, D, nb, bid);
    pg8::EpiResidual E{(bf16_t*)(p.ws + WS_HB), (float*)(p.ws + WS_SSQ)};
    pg8::gemm_phase<pg8::EpiResidual, pg8::StaticOrder, true, true>(lds, g, S, E);
}
__device__ __forceinline__ void ph_gemm_pq(const P& p, int bid, int nb, lds_ptr lds) {
    pg8::Gemm g{(const bf16_t*)(p.ws + WS_HB), (const bf16_t*)(p.ws + WS_WPQ), D, 0, 0}; pg8::StaticOrder S; S.init(T, PQW, nb, bid);
    pg8::EpiScale E{(bf16_t*)(p.ws + WS_PQ), PQW, (const float*)(p.ws + WS_SSQ), 0, 1.f, nullptr};
    pg8::gemm_phase<pg8::EpiScale, pg8::StaticOrder, true, true>(lds, g, S, E);
}

typedef float f32x16 __attribute__((ext_vector_type(16)));
typedef __bf16 bf16x2_t __attribute__((ext_vector_type(2)));
typedef float f32x2_t __attribute__((ext_vector_type(2)));
#define MFMA32(a, b, c) __builtin_amdgcn_mfma_f32_32x32x16_bf16((a), (b), (c), 0, 0, 0)
__device__ __forceinline__ unsigned cvtpk(float lo, float hi) { f32x2_t v = {lo, hi}; return __builtin_bit_cast(unsigned, __builtin_convertvector(v, bf16x2_t)); }
__device__ __forceinline__ bf16x8 pack8(const f32x16& x, int s2) {
    u32x4 w; w.x = cvtpk(x[8 * s2], x[8 * s2 + 1]); w.y = cvtpk(x[8 * s2 + 2], x[8 * s2 + 3]); w.z = cvtpk(x[8 * s2 + 4], x[8 * s2 + 5]); w.w = cvtpk(x[8 * s2 + 6], x[8 * s2 + 7]);
    return __builtin_bit_cast(bf16x8, w);
}
__device__ __forceinline__ void ph_sb_attn(const P& p, int bid, int nb, __attribute__((address_space(3))) unsigned char* lds) {
    const int tid = get_tid(), lane = tid & 63, wid = __builtin_amdgcn_readfirstlane(tid >> 6), r = lane & 31, hh = lane >> 5;
    GAS unsigned char* wsg = (GAS unsigned char*)p.ws;
    const GAS bf16_t* PP = (const GAS bf16_t*)(wsg + WS_P); const GAS bf16_t* VT = (const GAS bf16_t*)(wsg + WS_SBVT); GAS bf16_t* Y = (GAS bf16_t*)(wsg + WS_Y);
    bf16x8 uneg[2], oneg;
#pragma unroll
    for (int s2 = 0; s2 < 2; ++s2)
#pragma unroll
        for (int j = 0; j < 8; ++j) { const int k = 16 * s2 + 8 * (j >> 2) + 4 * hh + (j & 3); uneg[s2][j] = (k > r) ? (short)0xBF80 : (short)0; }
#pragma unroll
    for (int j = 0; j < 8; ++j) oneg[j] = (short)0xBF80;
    constexpr int KP = 144, VP = 912, VOFF = 448 * KP;
#pragma unroll 1
    for (int rnd = 0; rnd < 2; ++rnd) {
        if (bid >= 256) break;
        const int bh = bid & 63, b = bh >> 3, h = bh & 7;
        const int Q0 = (((bid >> 6) & 3) * 16 + rnd * 8) * 32, W0 = Q0 >= 192 ? Q0 - 192 : 0, wsz = Q0 + 256 - W0;
        const int qt = (Q0 >> 5) + wid, q0 = qt * 32;
        const GAS bf16_t* prow = PP + (size_t)(b * SEQ) * INW + h * 64 + 8 * hh;
        const GAS bf16_t* vtb = VT + ((size_t)bh * 64 + r) * 2048 + 4 * hh;
        {
            u32x4 rk[7], rv[7];
#pragma unroll
            for (int i = 0; i < 7; ++i) {
                const int c = tid + 512 * i, row = c >> 3, ck = c & 7;
                rk[i] = (u32x4){0u, 0u, 0u, 0u};
                if (row < wsz) rk[i] = *(const GAS u32x4*)(PP + (size_t)(b * SEQ + W0 + row) * INW + 512 + h * 64 + ck * 8);
                const int d = c / 56, cv = c - d * 56;
                rv[i] = (u32x4){0u, 0u, 0u, 0u};
                if (cv * 8 < wsz) rv[i] = *(const GAS u32x4*)(VT + ((size_t)bh * 64 + d) * 2048 + W0 + cv * 8);
            }
#pragma unroll
            for (int i = 0; i < 7; ++i) {
                const int c = tid + 512 * i, row = c >> 3, ck = c & 7, d = c / 56, cv = c - d * 56;
                *(__attribute__((address_space(3))) u32x4*)(lds + row * KP + ck * 16) = rk[i];
                *(__attribute__((address_space(3))) u32x4*)(lds + VOFF + d * VP + cv * 16) = rv[i];
            }
        }
        bf16x8 qf[4];
#pragma unroll
        for (int ks = 0; ks < 4; ++ks) qf[ks] = *(const GAS bf16x8*)(prow + (size_t)(q0 + r) * INW + 16 * ks);
        __syncthreads();
        f32x16 o0, o1, C;
#pragma unroll
        for (int i = 0; i < 16; ++i) { o0[i] = 0.f; o1[i] = 0.f; C[i] = 0.f; }
#pragma unroll 1
        for (int kt = qt; kt >= 0; --kt) {
            const int k0 = kt * 32;
            bf16x8 kf[4]; u32x2 vlo[2][2], vhi[2][2];
            if (k0 >= W0) {
                const __attribute__((address_space(3))) unsigned char* kl = lds + (k0 - W0 + r) * KP + 16 * hh;
#pragma unroll
                for (int ks = 0; ks < 4; ++ks) kf[ks] = *(const __attribute__((address_space(3))) bf16x8*)(kl + 32 * ks);
                const __attribute__((address_space(3))) unsigned char* vl = lds + VOFF + r * VP + (k0 - W0 + 4 * hh) * 2;
#pragma unroll
                for (int dt = 0; dt < 2; ++dt)
#pragma unroll
                    for (int s2 = 0; s2 < 2; ++s2) { vlo[dt][s2] = *(const __attribute__((address_space(3))) u32x2*)(vl + dt * 32 * VP + 32 * s2); vhi[dt][s2] = *(const __attribute__((address_space(3))) u32x2*)(vl + dt * 32 * VP + 32 * s2 + 16); }
            } else {
#pragma unroll
                for (int ks = 0; ks < 4; ++ks) kf[ks] = *(const GAS bf16x8*)(prow + (size_t)(k0 + r) * INW + 512 + 16 * ks);
#pragma unroll
                for (int dt = 0; dt < 2; ++dt)
#pragma unroll
                    for (int s2 = 0; s2 < 2; ++s2) { vlo[dt][s2] = *(const GAS u32x2*)(vtb + (size_t)dt * 32 * 2048 + k0 + 16 * s2); vhi[dt][s2] = *(const GAS u32x2*)(vtb + (size_t)dt * 32 * 2048 + k0 + 16 * s2 + 8); }
            }
            f32x16 z;
#pragma unroll
            for (int i = 0; i < 16; ++i) z[i] = 0.f;
#pragma unroll
            for (int ks = 0; ks < 4; ++ks) z = MFMA32(kf[ks], qf[ks], z);
            f32x16 X, LB;
            const bool diag = (kt == qt);
#pragma unroll
            for (int i = 0; i < 16; ++i) {
                const float zz = z[i];
                const float e = __builtin_amdgcn_exp2f(-fabsf(zz));
                const float sp = fmaxf(zz, 0.f) + __builtin_amdgcn_logf(1.0f + e);
                const bool valid = !diag || (((i & 3) + 8 * (i >> 2) + 4 * hh) < r);
                X[i] = valid ? sp : 0.f;
                LB[i] = valid ? (zz - sp) : -1.0e30f;
            }
            const bf16x8 x0 = pack8(X, 0), x1 = pack8(X, 1);
            f32x16 A = MFMA32(uneg[0], x0, C); A = MFMA32(uneg[1], x1, A);
            f32x16 Cn = MFMA32(oneg, x0, C); Cn = MFMA32(oneg, x1, Cn);
#pragma unroll
            for (int i = 0; i < 16; ++i) A[i] = __builtin_amdgcn_exp2f(LB[i] + A[i]);
            const bf16x8 p0 = pack8(A, 0), p1 = pack8(A, 1);
            { u32x4 a4; a4.x = vlo[0][0].x; a4.y = vlo[0][0].y; a4.z = vhi[0][0].x; a4.w = vhi[0][0].y; o0 = MFMA32(__builtin_bit_cast(bf16x8, a4), p0, o0); }
            { u32x4 a4; a4.x = vlo[0][1].x; a4.y = vlo[0][1].y; a4.z = vhi[0][1].x; a4.w = vhi[0][1].y; o0 = MFMA32(__builtin_bit_cast(bf16x8, a4), p1, o0); }
            { u32x4 a4; a4.x = vlo[1][0].x; a4.y = vlo[1][0].y; a4.z = vhi[1][0].x; a4.w = vhi[1][0].y; o1 = MFMA32(__builtin_bit_cast(bf16x8, a4), p0, o1); }
            { u32x4 a4; a4.x = vlo[1][1].x; a4.y = vlo[1][1].y; a4.z = vhi[1][1].x; a4.w = vhi[1][1].y; o1 = MFMA32(__builtin_bit_cast(bf16x8, a4), p1, o1); }
            C = Cn;
            if (__all(C[0] < -160.f)) break;
        }
        GAS bf16_t* yp = Y + (size_t)(b * SEQ + q0 + r) * 512 + h * 64 + 4 * hh;
#pragma unroll
        for (int g = 0; g < 4; ++g) {
            u32x2 w0; w0.x = cvtpk(o0[4 * g], o0[4 * g + 1]); w0.y = cvtpk(o0[4 * g + 2], o0[4 * g + 3]);
            u32x2 w1; w1.x = cvtpk(o1[4 * g], o1[4 * g + 1]); w1.y = cvtpk(o1[4 * g + 2], o1[4 * g + 3]);
            *(GAS u32x2*)(yp + 8 * g) = w0; *(GAS u32x2*)(yp + 32 + 8 * g) = w1;
        }
        __syncthreads();
    }
}
typedef __attribute__((address_space(3))) float* lds_fptr;
#define LASX __attribute__((address_space(3)))
__device__ __forceinline__ void ph_conv(const P& p, int l, int bid, int nb, LASX unsigned char* lds) {
    const int tid0 = get_tid(), wid = __builtin_amdgcn_readfirstlane(tid0 >> 6);
    GAS unsigned char* wsg = (GAS unsigned char*)p.ws;
    const GAS bf16_t* PP = (const GAS bf16_t*)(wsg + WS_P); GAS bf16_t* Y = (GAS bf16_t*)(wsg + WS_Y);
    const GAS float* dw = (const GAS float*)p.conv_dw_w + (size_t)l * 31 * 512; const GAS float* scw = (const GAS float*)p.sc_w + (size_t)l * 3 * 512;
    float w[31];
#pragma unroll
    for (int j = 0; j < 31; ++j) w[j] = dw[j * 512 + tid0];
    const float w0 = scw[tid0], w1 = scw[512 + tid0], w2 = scw[1024 + tid0];
    const float db = ((const GAS float*)p.conv_dw_b)[l * 512 + tid0], lg = ((const GAS float*)p.conv_ln_g)[l * 512 + tid0], lb = ((const GAS float*)p.conv_ln_b)[l * 512 + tid0];
    const LASX float* stat = (const LASX float*)(lds + 131072);
    LASX float* statw = (LASX float*)(lds + 131072);
#pragma unroll 1
    for (int it = bid; it < T / 32; it += nb) {
        const int tile = (nb == 256) ? ((it & 7) * 64 + ((it >> 3) & 31) + 32 * (it >> 8)) : it;
        const int tok0 = tile * 32, t0 = tok0 & (SEQ - 1);
        int tid = tid0; asm volatile("" : "+v"(tid));
        const int c = tid, lane = tid & 63;
        const GAS bf16_t* tb = PP + (size_t)tok0 * INW;
        {
            u32x4 r[16];
#pragma unroll
            for (int i = 0; i < 16; ++i) {
                const int ch = tid + 512 * i, row = ch >> 7, c16 = ch & 127; const bool ok = (t0 + row - 30 >= 0);
                r[i] = (u32x4){0u, 0u, 0u, 0u};
                if (i < 15 || ch < 62 * 128) { const u32x4 v = *(const GAS u32x4*)(tb + (ptrdiff_t)(ok ? row - 30 : 0) * INW + OFF_CV + c16 * 8); r[i] = ok ? v : (u32x4){0u, 0u, 0u, 0u}; }
            }
#pragma unroll
            for (int i = 0; i < 16; ++i) { const int ch = tid + 512 * i; if (i < 15 || ch < 62 * 128) *(LASX u32x4*)(lds + (ch >> 7) * 2048 + (ch & 127) * 16) = r[i]; }
        }
        __syncthreads();
        float o32[32];
        {
            float u[62];
#pragma unroll
            for (int i = 0; i < 62; ++i) {
                const float val = bf2f(*(const LASX bf16_t*)(lds + i * 2048 + c * 2)), gt = bf2f(*(const LASX bf16_t*)(lds + i * 2048 + 1024 + c * 2));
                u[i] = val * __builtin_amdgcn_rcpf(1.0f + __expf(-gt));
            }
#pragma unroll
            for (int i = 0; i < 32; ++i) {
                float acc = db;
#pragma unroll
                for (int j = 0; j < 31; ++j) asm("v_fmac_f32 %0, %1, %2" : "+v"(acc) : "v"(w[j]), "v"(u[i + j]));
                o32[i] = acc;
            }
        }
        {
            const bool h8 = (lane & 8) != 0, h4 = (lane & 4) != 0, h2 = (lane & 2) != 0, h1 = (lane & 1) != 0;
#pragma unroll
            for (int st = 0; st < 2; ++st) {
                float v[32];
#pragma unroll
                for (int i = 0; i < 32; ++i) { const float x = st ? o32[i] * o32[i] : o32[i]; v[i] = swap32_sum(x, x); }
#pragma unroll
                for (int i = 0; i < 16; ++i) v[i] = swap16_sum(v[i], v[i + 16]);
#pragma unroll
                for (int i = 0; i < 8; ++i) v[i] = (h8 ? v[i + 8] : v[i]) + dppf<0x128>(h8 ? v[i] : v[i + 8]);
#pragma unroll
                for (int i = 0; i < 4; ++i) v[i] = (h4 ? v[i + 4] : v[i]) + dppf<0x141>(dppf<0x1B>(h4 ? v[i] : v[i + 4]));
#pragma unroll
                for (int i = 0; i < 2; ++i) v[i] = (h2 ? v[i + 2] : v[i]) + dppf<0x4E>(h2 ? v[i] : v[i + 2]);
                v[0] = (h1 ? v[1] : v[0]) + dppf<0xB1>(h1 ? v[0] : v[1]);
                if (lane < 32) statw[st * 256 + wid * 32 + lane] = v[0];
            }
        }
        __syncthreads();
        if (tid < 64) { float t = 0.f; const int st = tid >> 5, tk = tid & 31;
#pragma unroll
            for (int k = 0; k < 8; ++k) t += stat[st * 256 + k * 32 + tk];
            statw[512 + tid] = t; }
        {
            u32x4 r[13];
#pragma unroll
            for (int i = 0; i < 13; ++i) {
                const int ch = tid + 512 * i;
                r[i] = (u32x4){0u, 0u, 0u, 0u};
                if (i < 8 || ch < 34 * 128) { const int row = ch >> 7, c16 = ch & 127; const bool ok = (t0 + row - 2 >= 0);
                    const u32x4 v = *(const GAS u32x4*)(tb + (ptrdiff_t)(ok ? row - 2 : 0) * INW + OFF_SC + 512 + c16 * 8); r[i] = ok ? v : (u32x4){0u, 0u, 0u, 0u}; }
                else if (ch < 34 * 128 + 32 * 64) { const int c2 = ch - 34 * 128; r[i] = *(const GAS u32x4*)(tb + (size_t)(c2 >> 6) * INW + OFF_SC + (c2 & 63) * 8); }
            }
#pragma unroll
            for (int i = 0; i < 13; ++i) {
                const int ch = tid + 512 * i;
                if (i < 8 || ch < 34 * 128) *(LASX u32x4*)(lds + (ch >> 7) * 2048 + (ch & 127) * 16) = r[i];
                else if (ch < 34 * 128 + 32 * 64) { const int c2 = ch - 34 * 128; *(LASX u32x4*)(lds + 69632 + (c2 >> 6) * 1024 + (c2 & 63) * 16) = r[i]; }
            }
        }
        __syncthreads();
        GAS bf16_t* ycv = Y + (size_t)T * 512 + (size_t)tok0 * 512;
#pragma unroll
        for (int i = 0; i < 32; ++i) {
            const float mean = stat[512 + i] * (1.0f / 512.0f), var = fmaxf(stat[512 + 32 + i] * (1.0f / 512.0f) - mean * mean, 0.f);
            const float yv = (o32[i] - mean) * rsqrtf(var + 1e-5f) * lg + lb;
            GAS bf16_t* yr = ycv + i * 512; asm volatile("" : "+s"(yr));
            yr[c] = (bf16_t)f2bf(yv * __builtin_amdgcn_rcpf(1.0f + __expf(-yv)));
        }
        {
            float gx[34];
#pragma unroll
            for (int i = 0; i < 34; ++i) gx[i] = bf2f(*(const LASX bf16_t*)(lds + i * 2048 + c * 2)) * bf2f(*(const LASX bf16_t*)(lds + i * 2048 + 1024 + c * 2));
            GAS bf16_t* ysc = Y + (size_t)2 * T * 512 + (size_t)tok0 * 512;
#pragma unroll
            for (int i = 0; i < 32; ++i) {
                const float sc = fmaf(w2, gx[i + 2], fmaf(w1, gx[i + 1], w0 * gx[i]));
                GAS bf16_t* yr = ysc + i * 512; asm volatile("" : "+s"(yr));
                yr[c] = (bf16_t)f2bf(bf2f(*(const LASX bf16_t*)(lds + 69632 + i * 1024 + c * 2)) * sc);
            }
        }
        __syncthreads();
    }
}

#define MFMA16(a, b, c) __builtin_amdgcn_mfma_f32_16x16x32_bf16((a), (b), (c), 0, 0, 0)
#define XA_PITCH 528
#define XA_LOAD(regs, src, pitch) do { _Pragma("unroll") for (int i_ = 0; i_ < 16; ++i_) { const int ch_ = tid + 512 * i_; regs[i_] = *(const GAS u32x4*)((const GAS char*)(src) + (size_t)(ch_ >> 5) * (pitch) + (ch_ & 31) * 16); } } while (0)
#define XA_STORE(regs) do { _Pragma("unroll") for (int i_ = 0; i_ < 16; ++i_) { const int ch_ = tid + 512 * i_; *(LASX u32x4*)(lds + (ch_ >> 5) * XA_PITCH + (ch_ & 31) * 16) = regs[i_]; } } while (0)
__device__ __forceinline__ void ph_xattn(const P& p, int l, int bid, int nb, LASX unsigned char* lds) {
    const int tid = get_tid(), lane = tid & 63, wid = __builtin_amdgcn_readfirstlane(tid >> 6), fr = lane & 15, fq = lane >> 4;
    GAS unsigned char* wsg = (GAS unsigned char*)p.ws;
    const GAS bf16_t* XQ = (const GAS bf16_t*)(wsg + WS_XQ); const GAS bf16_t* KV = (const GAS bf16_t*)(wsg + WS_KV2) + (size_t)l * TM * 2048; const GAS bf16_t* VT = (const GAS bf16_t*)(wsg + WS_VT2) + (size_t)l * (8 * 4 * 256 * 256);
    GAS bf16_t* XO = (GAS bf16_t*)(wsg + WS_XO);
    constexpr int NU = BATCH * 4 * 16;
    u32x4 st[16];
    if (bid < NU) { const int b = bid >> 6, hd = (bid >> 4) & 3; XA_LOAD(st, KV + (size_t)(b * NMEM) * 2048 + hd * 256, 4096); }
#pragma unroll 1
    for (int unit = bid; unit < NU; unit += nb) {
        const int b = unit >> 6, hd = (unit >> 4) & 3, qt = unit & 15;
        const int tok0 = b * SEQ + qt * 128 + wid * 16;
        XA_STORE(st);
        bf16x8 qf[8];
        { const GAS bf16_t* qp = XQ + (size_t)(tok0 + fr) * D + hd * 256 + fq * 8;
#pragma unroll
          for (int ks = 0; ks < 8; ++ks) qf[ks] = *(const GAS bf16x8*)(qp + ks * 32); }
        __syncthreads();
        f32x4 sacc[16];
        const LASX unsigned char* kl = lds + fr * XA_PITCH + fq * 16;
#pragma unroll
        for (int t = 0; t < 16; ++t) {
            f32x4 acc = (f32x4){0.f, 0.f, 0.f, 0.f};
#pragma unroll
            for (int ks = 0; ks < 8; ++ks) { const bf16x8 kf = *(const LASX bf16x8*)(kl + t * 16 * XA_PITCH + ks * 64); acc = MFMA16(kf, qf[ks], acc); }
            sacc[t] = acc;
        }
        XA_LOAD(st, VT + (size_t)(b * 4 + hd) * 256 * 256, 512);
        float mx = -3.0e38f;
#pragma unroll
        for (int t = 0; t < 16; ++t) mx = fmaxf(fmaxf(fmaxf(sacc[t][0], sacc[t][1]), fmaxf(sacc[t][2], sacc[t][3])), mx);
        { auto r = __builtin_amdgcn_permlane16_swap(__float_as_uint(mx), __float_as_uint(mx), false, false); mx = fmaxf(__uint_as_float(r[0]), __uint_as_float(r[1])); }
        { auto r = __builtin_amdgcn_permlane32_swap(__float_as_uint(mx), __float_as_uint(mx), false, false); mx = fmaxf(__uint_as_float(r[0]), __uint_as_float(r[1])); }
        float sum = 0.f;
#pragma unroll
        for (int t = 0; t < 16; ++t) {
#pragma unroll
            for (int r = 0; r < 4; ++r) { const float e = __expf(sacc[t][r] - mx); sacc[t][r] = e; sum += e; }
        }
        sum = swap16_sum(sum, sum); sum = swap32_sum(sum, sum);
        const float inv = 1.0f / sum;
        bf16x8 pf[8];
#pragma unroll
        for (int s2 = 0; s2 < 8; ++s2) {
            u32x4 w; w.x = cvtpk(sacc[2 * s2][0], sacc[2 * s2][1]); w.y = cvtpk(sacc[2 * s2][2], sacc[2 * s2][3]);
            w.z = cvtpk(sacc[2 * s2 + 1][0], sacc[2 * s2 + 1][1]); w.w = cvtpk(sacc[2 * s2 + 1][2], sacc[2 * s2 + 1][3]);
            pf[s2] = __builtin_bit_cast(bf16x8, w);
        }
        __syncthreads();
        XA_STORE(st);
        __syncthreads();
        if (unit + nb < NU) { const int u2 = unit + nb, b2 = u2 >> 6, hd2 = (u2 >> 4) & 3; XA_LOAD(st, KV + (size_t)(b2 * NMEM) * 2048 + hd2 * 256, 4096); }
        const LASX unsigned char* vl = lds + fr * XA_PITCH + fq * 8;
        GAS bf16_t* op = XO + (size_t)(tok0 + fr) * D + hd * 256 + 4 * fq;
#pragma unroll 2
        for (int dt = 0; dt < 16; ++dt) {
            f32x4 acc = (f32x4){0.f, 0.f, 0.f, 0.f};
#pragma unroll
            for (int s2 = 0; s2 < 8; ++s2) {
                const u32x2 lo = *(const LASX u32x2*)(vl + dt * 16 * XA_PITCH + 64 * s2), hi = *(const LASX u32x2*)(vl + dt * 16 * XA_PITCH + 64 * s2 + 32);
                u32x4 a4; a4.x = lo.x; a4.y = lo.y; a4.z = hi.x; a4.w = hi.y;
                acc = MFMA16(__builtin_bit_cast(bf16x8, a4), pf[s2], acc);
            }
            u32x2 w; w.x = cvtpk(acc[0] * inv, acc[1] * inv); w.y = cvtpk(acc[2] * inv, acc[3] * inv);
            *(GAS u32x2*)(op + dt * 16) = w;
        }
        __syncthreads();
    }
}

typedef __attribute__((address_space(3))) int* lds_iptr;
#define TK_CE(a, b) do { const float hi_ = __builtin_fmaxf(a, b); b = __builtin_fminf(a, b); a = hi_; } while (0)
__device__ __forceinline__ void tk_sort16(float (&a)[16]) {
#pragma unroll
    for (int k = 2; k <= 16; k <<= 1)
#pragma unroll
        for (int j = k >> 1; j > 0; j >>= 1)
#pragma unroll
            for (int i = 0; i < 16; ++i) { const int l = i ^ j; if (l > i) { if ((i & k) == 0) TK_CE(a[i], a[l]); else TK_CE(a[l], a[i]); } }
}
__device__ __forceinline__ void tk_merge16(float (&L)[16], const float (&G)[16]) {
#pragma unroll
    for (int i = 0; i < 16; ++i) L[i] = __builtin_fmaxf(L[i], G[15 - i]);
#pragma unroll
    for (int j = 8; j > 0; j >>= 1)
#pragma unroll
        for (int i = 0; i < 16; ++i) { const int l = i ^ j; if (l > i) TK_CE(L[i], L[l]); }
}
#define TK_INSERT(L, x) do { float x_ = (x); _Pragma("unroll") for (int i_ = 0; i_ < 16; ++i_) { const float hi_ = __builtin_fmaxf(L[i_], x_); x_ = __builtin_fminf(L[i_], x_); L[i_] = hi_; } } while (0)
__device__ __forceinline__ void ph_peer_score(const P& p, int bid, int nb, lds_fptr ldsf) {
    const int tid = get_tid(), lane = tid & 63, wid = __builtin_amdgcn_readfirstlane(tid >> 6), fr = lane & 15, fq = lane >> 4;
    GAS unsigned char* wsg = (GAS unsigned char*)p.ws;
    const GAS bf16_t* PQ = (const GAS bf16_t*)(wsg + WS_PQ); const GAS bf16_t* KEYS = (const GAS bf16_t*)(wsg + WS_KEYS);
    GAS int* PIDX = (GAS int*)(wsg + WS_PIDX); GAS float* PG = (GAS float*)(wsg + WS_PG);
    const lds_fptr sc = ldsf + wid * (64 * 68);
    const int gw = bid * 8 + wid, ngw = nb * 8;
#pragma unroll 1
    for (int task = gw; task < (T / 64) * 8; task += ngw) {
        const int tok0 = (task >> 3) * 64, h = task & 7;
        float L1[16], L2[16];
#pragma unroll
        for (int i = 0; i < 16; ++i) { L1[i] = -3.0e38f; L2[i] = -3.0e38f; }
        bf16x8 qf[4][4], kfa[4][4];
#define PS_LOADQ(pp_) do { _Pragma("unroll") for (int mt_ = 0; mt_ < 4; ++mt_) _Pragma("unroll") for (int ks_ = 0; ks_ < 4; ++ks_) \
            qf[mt_][ks_] = *(const GAS bf16x8*)(PQ + (size_t)(tok0 + 16 * mt_ + fr) * PQW + h * 256 + (pp_) * 128 + 32 * ks_ + 8 * fq); } while (0)
#define PS_LOADK(it_) do { const GAS bf16_t* kp_ = KEYS + ((size_t)h * 256 + (it_) * 64 + fr) * 128 + 8 * fq; _Pragma("unroll") for (int nt_ = 0; nt_ < 4; ++nt_) _Pragma("unroll") for (int ks_ = 0; ks_ < 4; ++ks_) \
            kfa[nt_][ks_] = *(const GAS bf16x8*)(kp_ + (size_t)nt_ * 16 * 128 + 32 * ks_); } while (0)
        PS_LOADQ(0); PS_LOADK(0);
        float Lr[16];
#pragma unroll
        for (int i = 0; i < 16; ++i) Lr[i] = -3.0e38f;
#pragma unroll 1
        for (int it = 0; it < 4; ++it) {
            const int half = it & 1;
#pragma unroll
            for (int nt = 0; nt < 4; ++nt) {
#pragma unroll
                for (int mt = 0; mt < 4; ++mt) {
                    f32x4 acc = (f32x4){0.f, 0.f, 0.f, 0.f};
#pragma unroll
                    for (int ks = 0; ks < 4; ++ks) acc = MFMA16(kfa[nt][ks], qf[mt][ks], acc);
                    *(__attribute__((address_space(3))) f32x4*)(sc + (16 * mt + fr) * 68 + 16 * nt + 4 * fq) = acc;
                }
            }
            __builtin_amdgcn_sched_barrier(0);
            if (it == 1) PS_LOADQ(1);
            if (it < 3) PS_LOADK(it + 1);
            __builtin_amdgcn_sched_barrier(0);
#pragma unroll
            for (int grp = 0; grp < 4; ++grp) {
                float G[16];
#pragma unroll
                for (int k4 = 0; k4 < 4; ++k4) {
                    const f32x4 v = *(const __attribute__((address_space(3))) f32x4*)(sc + lane * 68 + 16 * grp + 4 * k4);
#pragma unroll
                    for (int r = 0; r < 4; ++r) G[4 * k4 + r] = __uint_as_float((__float_as_uint(v[r]) & 0xffffff80u) | (unsigned)(half * 64 + 16 * grp + 4 * k4 + r));
                }
                tk_sort16(G);
                tk_merge16(Lr, G);
            }
            if (it == 1) {
#pragma unroll
                for (int i = 0; i < 16; ++i) { L1[i] = Lr[i]; Lr[i] = -3.0e38f; }
            }
        }
#pragma unroll
        for (int i = 0; i < 16; ++i) L2[i] = Lr[i];
#undef PS_LOADQ
#undef PS_LOADK
        const lds_iptr li = (lds_iptr)sc + lane * 33;
#pragma unroll
        for (int i = 0; i < 16; ++i) { li[i] = (int)(__float_as_uint(L1[i]) & 127u); li[16 + i] = (int)(__float_as_uint(L2[i]) & 127u); }
        float C[16];
        {
            float G[4][16];
#pragma unroll
            for (int a = 0; a < 4; ++a)
#pragma unroll
                for (int i = 0; i < 16; ++i) G[a][i] = -3.0e38f;
            int cnt = 0;
#pragma unroll
            for (int i = 0; i < 16; ++i)
#pragma unroll
                for (int j = 0; j < 16; ++j)
                    if ((i + 1) * (j + 1) <= 16) { const float sm = L1[i] + L2[j]; G[cnt >> 4][cnt & 15] = __uint_as_float((__float_as_uint(sm) & 0xffffff00u) | (unsigned)(i * 16 + j)); ++cnt; }
            tk_sort16(G[0]); tk_sort16(G[1]); tk_sort16(G[2]); tk_sort16(G[3]);
            tk_merge16(G[0], G[1]); tk_merge16(G[2], G[3]); tk_merge16(G[0], G[2]);
#pragma unroll
            for (int i = 0; i < 16; ++i) C[i] = G[0][i];
        }
        float e[16], es = 0.f;
#pragma unroll
        for (int k = 0; k < 16; ++k) { e[k] = __expf(C[k] - C[0]); es += e[k]; }
        const float inv = 1.0f / es;
        int ex[16];
#pragma unroll
        for (int k = 0; k < 16; ++k) { const unsigned ci = __float_as_uint(C[k]) & 255u; ex[k] = li[ci >> 4] * 128 + li[16 + (ci & 15)]; }
        GAS int* pi = PIDX + (size_t)(tok0 + lane) * 128 + h * 16; GAS float* pgp = PG + (size_t)(tok0 + lane) * 128 + h * 16;
#pragma unroll
        for (int k4 = 0; k4 < 4; ++k4) {
            typedef int i32x4 __attribute__((ext_vector_type(4)));
            i32x4 iv; iv.x = ex[4 * k4]; iv.y = ex[4 * k4 + 1]; iv.z = ex[4 * k4 + 2]; iv.w = ex[4 * k4 + 3];
            f32x4 gv; gv.x = e[4 * k4] * inv; gv.y = e[4 * k4 + 1] * inv; gv.z = e[4 * k4 + 2] * inv; gv.w = e[4 * k4 + 3] * inv;
            *(GAS i32x4*)(pi + 4 * k4) = iv; *(GAS f32x4*)(pgp + 4 * k4) = gv;
        }
    }
}
#define PG_ISSUE(buf, TAB, ireg, c) do { _Pragma("unroll") for (int j_ = 0; j_ < 8; ++j_) { \
        const int idx_ = __builtin_amdgcn_readlane(ireg, ((c) & 7) * 8 + j_); buf[j_] = ((const GAS u32x4*)((const GAS char*)(TAB) + (size_t)(unsigned)idx_ * 1024u))[lane]; } } while (0)
#define PG_CVT(f, q) do { const f32x2_t a_ = __builtin_amdgcn_cvt_pk_f32_fp8((int)(q).x, false), b_ = __builtin_amdgcn_cvt_pk_f32_fp8((int)(q).x, true), c_ = __builtin_amdgcn_cvt_pk_f32_fp8((int)(q).y, false), d_ = __builtin_amdgcn_cvt_pk_f32_fp8((int)(q).y, true), \
        e_ = __builtin_amdgcn_cvt_pk_f32_fp8((int)(q).z, false), f_ = __builtin_amdgcn_cvt_pk_f32_fp8((int)(q).z, true), g_ = __builtin_amdgcn_cvt_pk_f32_fp8((int)(q).w, false), h_ = __builtin_amdgcn_cvt_pk_f32_fp8((int)(q).w, true); \
        f[0] = a_[0]; f[1] = a_[1]; f[2] = b_[0]; f[3] = b_[1]; f[4] = c_[0]; f[5] = c_[1]; f[6] = d_[0]; f[7] = d_[1]; f[8] = e_[0]; f[9] = e_[1]; f[10] = f_[0]; f[11] = f_[1]; f[12] = g_[0]; f[13] = g_[1]; f[14] = h_[0]; f[15] = h_[1]; } while (0)
#define PG_DOTS(buf, c) do { float pd_[8]; _Pragma("unroll") for (int j_ = 0; j_ < 8; ++j_) { float f_v[16]; PG_CVT(f_v, buf[j_]); \
        float d0_ = f_v[0] * xf[0], d1_ = f_v[1] * xf[1]; _Pragma("unroll") for (int k_ = 2; k_ < 16; k_ += 2) { d0_ = fmaf(f_v[k_], xf[k_], d0_); d1_ = fmaf(f_v[k_ + 1], xf[k_ + 1], d1_); } pd_[j_] = d0_ + d1_; } \
        float r_[4]; _Pragma("unroll") for (int i_ = 0; i_ < 4; ++i_) r_[i_] = swap32_sum(pd_[i_], pd_[i_ + 4]); \
        float s_[2]; _Pragma("unroll") for (int i_ = 0; i_ < 2; ++i_) s_[i_] = swap16_sum(r_[i_], r_[i_ + 2]); \
        float t_ = (h8 ? s_[1] : s_[0]) + dppf<0x128>(h8 ? s_[0] : s_[1]); t_ += dppf<0xB1>(t_); t_ += dppf<0x4E>(t_); t_ += dppf<0x141>(t_);     \
        if ((lane & 7) == 0) als[(c) * 8 + ((lane >> 3) & 7)] = t_; } while (0)
__device__ __forceinline__ void ph_peer_u(const P& p, int bid, int nb, lds_fptr ldsf) {
    const int tid = get_tid(), lane = tid & 63, wid = __builtin_amdgcn_readfirstlane(tid >> 6);
    GAS unsigned char* wsg = (GAS unsigned char*)p.ws;
    const GAS bf16_t* HB = (const GAS bf16_t*)(wsg + WS_HB); const GAS float* SSQ = (const GAS float*)(wsg + WS_SSQ);
    const GAS unsigned char* U = (const GAS unsigned char*)(wsg + WS_U);
    const GAS float* USC = (const GAS float*)(wsg + WS_USC); const GAS float* VSC = (const GAS float*)(wsg + WS_VSC);
    const GAS int* PIDX = (const GAS int*)(wsg + WS_PIDX); GAS float* PG = (GAS float*)(wsg + WS_PG);
    const lds_fptr als = ldsf + wid * 128;
    const bool h32 = (lane & 32) != 0, h16 = (lane & 16) != 0, h8 = (lane & 8) != 0;
    const int gw = bid * 8 + wid, ngw = nb * 8;
#pragma unroll 1
    for (int tok = gw; tok < T; tok += ngw) {
        float xf[16];
        { const GAS u32x4* xr = (const GAS u32x4*)(HB + (size_t)tok * D); const u32x4 w0 = xr[2 * lane], w1 = xr[2 * lane + 1];
          xf[0] = bflo(w0.x); xf[1] = bfhi(w0.x); xf[2] = bflo(w0.y); xf[3] = bfhi(w0.y); xf[4] = bflo(w0.z); xf[5] = bfhi(w0.z); xf[6] = bflo(w0.w); xf[7] = bfhi(w0.w);
          xf[8] = bflo(w1.x); xf[9] = bfhi(w1.x); xf[10] = bflo(w1.y); xf[11] = bfhi(w1.y); xf[12] = bflo(w1.z); xf[13] = bfhi(w1.z); xf[14] = bflo(w1.w); xf[15] = bfhi(w1.w); }
        const int idx_lo = PIDX[(size_t)tok * 128 + lane], idx_hi = PIDX[(size_t)tok * 128 + 64 + lane];
        const float g_lo = PG[(size_t)tok * 128 + lane], g_hi = PG[(size_t)tok * 128 + 64 + lane];
        const float us_lo = USC[idx_lo], us_hi = USC[idx_hi], vs_lo = VSC[idx_lo], vs_hi = VSC[idx_hi];
        const float rs = rsqrtf(wave_sum2(lane < 16 ? SSQ[(size_t)tok * 16 + lane] : 0.f) * (1.0f / D) + 1e-6f);
        u32x4 bA[8], bB[8];
        PG_ISSUE(bA, U, idx_lo, 0);
#pragma unroll 1
        for (int c = 0; c < 8; c += 2) {
            PG_ISSUE(bB, U, idx_lo, c + 1); PG_DOTS(bA, c);
            if (c + 2 < 8) PG_ISSUE(bA, U, idx_lo, c + 2); else PG_ISSUE(bA, U, idx_hi, 0);
            PG_DOTS(bB, c + 1);
        }
#pragma unroll 1
        for (int c = 8; c < 16; c += 2) {
            PG_ISSUE(bB, U, idx_hi, c + 1); PG_DOTS(bA, c);
            if (c + 2 < 16) PG_ISSUE(bA, U, idx_hi, c + 2);
            PG_DOTS(bB, c + 1);
        }
        const float a0 = als[lane] * us_lo * rs, a1 = als[lane + 64] * us_hi * rs;
        PG[(size_t)tok * 128 + lane] = g_lo * vs_lo * 0.5f * a0 * (1.0f + erff(a0 * 0.70710678118654752f));
        PG[(size_t)tok * 128 + 64 + lane] = g_hi * vs_hi * 0.5f * a1 * (1.0f + erff(a1 * 0.70710678118654752f));
    }
}
#define U2_ISSUE(buf, slot) do { _Pragma("unroll") for (int i_ = 0; i_ < 16; ++i_) { const unsigned e_ = *(const LASX unsigned*)(tab + (slot) * 512 + ((i_ & 7) * 8 + 64 * (i_ >> 3)) * 4 + g * 4); \
        buf[i_] = *(const GAS u32x4*)(Ux + (size_t)e_ * 1024u); } } while (0)
#define U2_TAB(slot, ilo, ihi) do { *(LASX unsigned*)(tab + (slot) * 512 + lane * 4) = (unsigned)(ilo); *(LASX unsigned*)(tab + (slot) * 512 + 256 + lane * 4) = (unsigned)(ihi); } while (0)
#define U2_DOT(buf, xs, rlo, rhi) do { _Pragma("unroll") for (int i_ = 0; i_ < 16; ++i_) { float f_v[16]; PG_CVT(f_v, buf[i_]); float d0_ = f_v[0] * xs[0], d1_ = f_v[1] * xs[1]; \
        _Pragma("unroll") for (int k_ = 2; k_ < 16; k_ += 2) { asm("v_fmac_f32 %0, %1, %2" : "+v"(d0_) : "v"(f_v[k_]), "v"(xs[k_])); asm("v_fmac_f32 %0, %1, %2" : "+v"(d1_) : "v"(f_v[k_ + 1]), "v"(xs[k_ + 1])); } \
        float d_ = d0_ + d1_; d_ += dppf<0xB1>(d_); d_ += dppf<0x4E>(d_); d_ += dppf<0x141>(d_);        \
        if (i_ < 8) rlo = (j == (i_ & 7)) ? d_ : rlo; else rhi = (j == (i_ & 7)) ? d_ : rhi; } } while (0)
#define U2_XS(xs, w0, w1) do { xs[0] = bflo(w0.x); xs[1] = bfhi(w0.x); xs[2] = bflo(w0.y); xs[3] = bfhi(w0.y); xs[4] = bflo(w0.z); xs[5] = bfhi(w0.z); xs[6] = bflo(w0.w); xs[7] = bfhi(w0.w); \
        xs[8] = bflo(w1.x); xs[9] = bfhi(w1.x); xs[10] = bflo(w1.y); xs[11] = bfhi(w1.y); xs[12] = bflo(w1.z); xs[13] = bfhi(w1.z); xs[14] = bflo(w1.w); xs[15] = bfhi(w1.w); } while (0)
#define U2_META(ilo, ihi, x0, x1, t_) do { const size_t o_ = (size_t)(t_) * 128 + lane; ilo = PIDX[o_]; ihi = PIDX[o_ + 64]; const GAS u32x4* xr_ = (const GAS u32x4*)(HB + (size_t)(t_) * D + x * 128 + j * 16); x0 = xr_[0]; x1 = xr_[1]; } while (0)
#define U2_STORE(t_, rlo, rhi) do { GAS float* pd_ = PD + ((size_t)x * T + (t_)) * 128 + 8 * j + g; pd_[0] = rlo; pd_[64] = rhi; } while (0)
__device__ __forceinline__ void ph_peer_u2(const P& p, int bid, int nb, LASX unsigned char* ldsb) {
    const int tid = get_tid(), lane = tid & 63, wid = __builtin_amdgcn_readfirstlane(tid >> 6), g = lane >> 3, j = lane & 7;
    GAS unsigned char* wsg = (GAS unsigned char*)p.ws;
    const int x = bid & 7, nsl = nb >> 3;
    const GAS unsigned char* Ux = (const GAS unsigned char*)(wsg + WS_U) + x * 128 + j * 16;
    const GAS int* PIDX = (const GAS int*)(wsg + WS_PIDX); const GAS bf16_t* HB = (const GAS bf16_t*)(wsg + WS_HB); GAS float* PD = (GAS float*)(wsg + WS_PD);
    const int wv = (bid >> 3) * 8 + wid, nwv = nsl * 8;
    LASX unsigned char* tab = ldsb + wid * 1024;
    int iloA, ihiA, iloB, ihiB; u32x4 xA0, xA1, xB0, xB1;
    u32x4 bA[16], bB[16];
    const int t0 = wv;
    if (t0 < T) { U2_META(iloA, ihiA, xA0, xA1, t0); U2_TAB(0, iloA, ihiA); U2_ISSUE(bA, 0); }
    if (t0 + nwv < T) U2_META(iloB, ihiB, xB0, xB1, t0 + nwv);
#pragma unroll 1
    for (int t = t0; t < T; t += 2 * nwv) {
        const int t1 = t + nwv, t2 = t + 2 * nwv, t3 = t + 3 * nwv;
        if (t1 < T) { U2_TAB(1, iloB, ihiB); U2_ISSUE(bB, 1); }
        { float xs[16]; U2_XS(xs, xA0, xA1); float rlo = 0.f, rhi = 0.f; U2_DOT(bA, xs, rlo, rhi); U2_STORE(t, rlo, rhi); }
        if (t2 < T) U2_META(iloA, ihiA, xA0, xA1, t2);
        if (t1 < T) {
            if (t2 < T) { U2_TAB(0, iloA, ihiA); U2_ISSUE(bA, 0); }
            { float xs[16]; U2_XS(xs, xB0, xB1); float rlo = 0.f, rhi = 0.f; U2_DOT(bB, xs, rlo, rhi); U2_STORE(t1, rlo, rhi); }
            if (t3 < T) U2_META(iloB, ihiB, xB0, xB1, t3);
        }
    }
}
__device__ __forceinline__ void ph_peer_w(const P& p, int bid, int nb) {
    const int tid = get_tid(), lane = tid & 63, wid = __builtin_amdgcn_readfirstlane(tid >> 6);
    GAS unsigned char* wsg = (GAS unsigned char*)p.ws;
    const GAS float* SSQ = (const GAS float*)(wsg + WS_SSQ); const GAS float* USC = (const GAS float*)(wsg + WS_USC); const GAS float* VSC = (const GAS float*)(wsg + WS_VSC);
    const GAS int* PIDX = (const GAS int*)(wsg + WS_PIDX); GAS float* PG = (GAS float*)(wsg + WS_PG); const GAS float* PD = (const GAS float*)(wsg + WS_PD);
#pragma unroll 2
    for (int tok = bid * 8 + wid; tok < T; tok += nb * 8) {
        const size_t o = (size_t)tok * 128 + lane;
        const int idx_lo = PIDX[o], idx_hi = PIDX[o + 64];
        float a0 = 0.f, a1 = 0.f;
#pragma unroll
        for (int xs = 0; xs < 8; ++xs) { a0 += PD[(size_t)xs * T * 128 + o]; a1 += PD[(size_t)xs * T * 128 + o + 64]; }
        const float g_lo = PG[o], g_hi = PG[o + 64];
        const float us_lo = USC[idx_lo], us_hi = USC[idx_hi], vs_lo = VSC[idx_lo], vs_hi = VSC[idx_hi];
        const float rs = rsqrtf(wave_sum2(lane < 16 ? SSQ[(size_t)tok * 16 + lane] : 0.f) * (1.0f / D) + 1e-6f);
        a0 *= us_lo * rs; a1 *= us_hi * rs;
        PG[o] = g_lo * vs_lo * 0.5f * a0 * (1.0f + erff(a0 * 0.70710678118654752f));
        PG[o + 64] = g_hi * vs_hi * 0.5f * a1 * (1.0f + erff(a1 * 0.70710678118654752f));
    }
}
#define V2_META(ilo, ihi, wlo, whi, hw, t_) do { const size_t o_ = (size_t)(t_) * 128 + lane; ilo = PIDX[o_]; ihi = PIDX[o_ + 64]; wlo = PW[o_]; whi = PW[o_ + 64]; hw = *(const GAS unsigned*)(HBW + (size_t)(t_) * D + col); } while (0)
#define V2_TAB(slot, ilo, ihi, wlo, whi) do { *(LASX u32x2*)(tab + (slot) * 1024 + lane * 8) = (u32x2){(unsigned)(ilo), __float_as_uint(wlo)}; *(LASX u32x2*)(tab + (slot) * 1024 + 512 + lane * 8) = (u32x2){(unsigned)(ihi), __float_as_uint(whi)}; } while (0)
#define V2_ISSUE(buf, slot) do { _Pragma("unroll") for (int i_ = 0; i_ < 16; ++i_) { const unsigned e_ = *(const LASX unsigned*)(tab + (slot) * 1024 + ((i_ & 7) * 8 + 64 * (i_ >> 3)) * 8 + g * 8); \
        buf[i_] = *(const GAS u32x4*)(Vx + (size_t)e_ * 1024u); } } while (0)
#define V2_ACC(buf, slot) do { _Pragma("unroll") for (int i_ = 0; i_ < 16; ++i_) { const float w_ = *(const LASX float*)(tab + (slot) * 1024 + ((i_ & 7) * 8 + 64 * (i_ >> 3)) * 8 + g * 8 + 4); \
        float f_v[16]; PG_CVT(f_v, buf[i_]); _Pragma("unroll") for (int k_ = 0; k_ < 16; ++k_) asm("v_fmac_f32 %0, %1, %2" : "+v"(o[k_]) : "v"(w_), "v"(f_v[k_])); } } while (0)
#define V2_FINISH(t_, hwreg) do { float r8_[8], r4_[4]; \
        _Pragma("unroll") for (int i_ = 0; i_ < 8; ++i_) r8_[i_] = swap32_sum(o[i_], o[i_ + 8]); \
        _Pragma("unroll") for (int i_ = 0; i_ < 4; ++i_) r4_[i_] = swap16_sum(r8_[i_], r8_[i_ + 4]); \
        const float c0_ = (h8 ? r4_[2] : r4_[0]) + dppf<0x128>(h8 ? r4_[0] : r4_[2]), c1_ = (h8 ? r4_[3] : r4_[1]) + dppf<0x128>(h8 ? r4_[1] : r4_[3]); \
        GAS unsigned* hp_ = (GAS unsigned*)(HBW + (size_t)(t_) * D + col); const unsigned hw_ = (hwreg); const unsigned nw_ = pk2(bflo(hw_) + c0_, bfhi(hw_) + c1_); *hp_ = nw_; \
        const float n0_ = bflo(nw_), n1_ = bfhi(nw_); \
        const float ss_ = wave_sum2(n0_ * n0_ + n1_ * n1_); if (lane < 2) SSQW[(size_t)(t_) * 16 + x + 8 * lane] = lane == 0 ? ss_ : 0.f; \
        _Pragma("unroll") for (int i_ = 0; i_ < 16; ++i_) o[i_] = 0.f; } while (0)
__device__ __forceinline__ void ph_peer_v(const P& p, int bid, int nb, LASX unsigned char* ldsb) {
    const int tid = get_tid(), lane = tid & 63, wid = __builtin_amdgcn_readfirstlane(tid >> 6), g = lane >> 3, j = lane & 7;
    GAS unsigned char* wsg = (GAS unsigned char*)p.ws;
    const int x = bid & 7, nsl = nb >> 3;
    const GAS unsigned char* Vx = (const GAS unsigned char*)(wsg + WS_V) + x * 128 + j * 16;
    const GAS int* PIDX = (const GAS int*)(wsg + WS_PIDX); const GAS float* PW = (const GAS float*)(wsg + WS_PG);
    GAS bf16_t* HBW = (GAS bf16_t*)(wsg + WS_HB); GAS float* SSQW = (GAS float*)(wsg + WS_SSQ);
    const bool h32 = (lane & 32) != 0, h16 = (lane & 16) != 0, h8 = (lane & 8) != 0;
    const int col = x * 128 + j * 16 + (h32 ? 8 : 0) + (h16 ? 4 : 0) + (h8 ? 2 : 0);
    const int wv = (bid >> 3) * 8 + wid, nwv = nsl * 8;
    LASX unsigned char* tab = ldsb + wid * 2048;
    float o[16];
#pragma unroll
    for (int i = 0; i < 16; ++i) o[i] = 0.f;
    int iloA, ihiA, iloB, ihiB; float wloA, whiA, wloB, whiB; unsigned hwA = 0u, hwB = 0u, hwC = 0u;
    u32x4 bA[16], bB[16];
    const int t0 = wv;
    if (t0 < T) { V2_META(iloA, ihiA, wloA, whiA, hwA, t0); V2_TAB(0, iloA, ihiA, wloA, whiA); V2_ISSUE(bA, 0); }
    if (t0 + nwv < T) V2_META(iloB, ihiB, wloB, whiB, hwB, t0 + nwv);
#pragma unroll 1
    for (int t = t0; t < T; t += 2 * nwv) {
        const int t1 = t + nwv, t2 = t + 2 * nwv, t3 = t + 3 * nwv;
        if (t1 < T) { V2_TAB(1, iloB, ihiB, wloB, whiB); V2_ISSUE(bB, 1); }
        V2_ACC(bA, 0);
        hwC = hwA;
        if (t2 < T) V2_META(iloA, ihiA, wloA, whiA, hwA, t2);
        V2_FINISH(t, hwC);
        if (t1 < T) {
            if (t2 < T) { V2_TAB(0, iloA, ihiA, wloA, whiA); V2_ISSUE(bA, 0); }
            V2_ACC(bB, 1);
            hwC = hwB;
            if (t3 < T) V2_META(iloB, ihiB, wloB, whiB, hwB, t3);
            V2_FINISH(t1, hwC);
        }
    }
}
__device__ __forceinline__ void ph_final_norm(const P& p, int bid, int nb) {
    const int tid = get_tid(), lane = tid & 63, wid = __builtin_amdgcn_readfirstlane(tid >> 6);
    GAS float* outg = (GAS float*)p.out; const GAS f32x4* fg = (const GAS f32x4*)p.final_g; const GAS float* SSQ = (const GAS float*)(p.ws + WS_SSQ);
    const GAS bf16_t* HB = (const GAS bf16_t*)(p.ws + WS_HB);
    const f32x4 g0 = fg[2 * lane], g1 = fg[2 * lane + 1], g2 = fg[128 + 2 * lane], g3 = fg[128 + 2 * lane + 1];
#pragma unroll 1
    for (int r = bid * 8 + wid; r < T; r += nb * 8) {
        const GAS u32x4* hr = (const GAS u32x4*)(HB + (size_t)r * D);
        const u32x4 w0 = hr[lane], w1 = hr[lane + 64];
        const float rs = rsqrtf(wave_sum(lane < 16 ? SSQ[(size_t)r * 16 + lane] : 0.f, lane) * (1.0f / D) + 1e-6f);
        GAS f32x4* o = (GAS f32x4*)(outg + (size_t)r * D);
        o[2 * lane] = (f32x4){bflo(w0.x), bfhi(w0.x), bflo(w0.y), bfhi(w0.y)} * rs * g0; o[2 * lane + 1] = (f32x4){bflo(w0.z), bfhi(w0.z), bflo(w0.w), bfhi(w0.w)} * rs * g1;
        o[128 + 2 * lane] = (f32x4){bflo(w1.x), bfhi(w1.x), bflo(w1.y), bfhi(w1.y)} * rs * g2; o[128 + 2 * lane + 1] = (f32x4){bflo(w1.z), bfhi(w1.z), bflo(w1.w), bfhi(w1.w)} * rs * g3;
    }
}

#define LAS __attribute__((address_space(3)))
#define XB_TMO      128
#define XB_XCNT(j)  (256  + 64 * (j))
#define XB_XSUB(j)  (1280 + 64 * (j))
#define XB_XGEN(j)  (2304 + 64 * (j))
#define XB_TOP      3328
#define XB_TOPGEN   3392
#define XCD_BAR_WORDS 3456
#define XB_SPIN_CAP (1u << 18)

__device__ __forceinline__ unsigned xb_ld(unsigned* p)              { return __hip_atomic_load(p, __ATOMIC_RELAXED, __HIP_MEMORY_SCOPE_AGENT); }
__device__ __forceinline__ unsigned xb_add(unsigned* p, unsigned v) { return __hip_atomic_fetch_add(p, v, __ATOMIC_RELAXED, __HIP_MEMORY_SCOPE_AGENT); }
__device__ __forceinline__ unsigned xb_xcc_id() { return (unsigned)__builtin_amdgcn_s_getreg((3 << 11) | 20) & 0xFu; }
#define XB_SPIN(cond, bar) do { unsigned _sp = 0; while (cond) { __builtin_amdgcn_s_sleep(1); \
    if ((++_sp & 255u) == 0u) { if (xb_ld(&(bar)[XB_TMO])) break; if (_sp > XB_SPIN_CAP) { atomicAdd(&(bar)[XB_TMO], 1u); break; } } } } while (0)

struct XcdBarrier {
    unsigned* bar; unsigned x;
    volatile LAS unsigned* st;
};

__device__ __forceinline__ XcdBarrier xcd_barrier_post(unsigned* bar, volatile LAS unsigned* st) {
    XcdBarrier b; b.bar = bar; b.x = xb_xcc_id(); b.st = st;
    if (get_tid() == 0) (void)xb_add(&bar[XB_XCNT(b.x)], 1u);
    return b;
}
__device__ __forceinline__ void xcd_barrier_complete(unsigned* bar, unsigned x, unsigned& nloc, unsigned& nx) {
    const unsigned G = gridDim.x * gridDim.y * gridDim.z;
    unsigned sum, cnt, mine, sp = 0u;
    for (;;) {
        sum = 0u; cnt = 0u; mine = 0u;
#pragma unroll
        for (unsigned j = 0; j < 16; ++j) { const unsigned c = xb_ld(&bar[XB_XCNT(j)]); sum += c; cnt += (c > 0u) ? 1u : 0u; mine = (j == x) ? c : mine; }
        if (sum == G) break;
        __builtin_amdgcn_s_sleep(1);
        if ((++sp & 255u) == 0u) { if (xb_ld(&bar[XB_TMO])) break; if (sp > XB_SPIN_CAP) { atomicAdd(&bar[XB_TMO], 1u); break; } }
    }
    nloc = mine > 0u ? mine : 1u; nx = cnt > 0u ? cnt : 1u;
}

__device__ __forceinline__ void xcd_barrier(const XcdBarrier& b) {
    asm volatile("s_waitcnt vmcnt(0)" ::: "memory");
    __syncthreads();
    if (get_tid() == 0) {
        unsigned* bar = b.bar;
        __builtin_amdgcn_s_waitcnt(0);
        unsigned nloc = b.st[0], nx = b.st[1];
        if (nloc == 0u) { xcd_barrier_complete(bar, b.x, nloc, nx); b.st[0] = nloc; b.st[1] = nx; }
        const unsigned old = xb_add(&bar[XB_XSUB(b.x)], 1u);
        const unsigned gen = old / nloc;
        if (old + 1u == (gen + 1u) * nloc) {
            __builtin_amdgcn_fence(__ATOMIC_RELEASE, "agent");
            asm volatile("s_waitcnt vmcnt(0)" ::: "memory");
            const unsigned og = xb_add(&bar[XB_TOP], 1u);
            const unsigned tg = og / nx;
            if (og + 1u == (tg + 1u) * nx) xb_add(&bar[XB_TOPGEN], 1u);
            else XB_SPIN(xb_ld(&bar[XB_TOPGEN]) == tg, bar);
            __builtin_amdgcn_fence(__ATOMIC_ACQUIRE, "agent");
            xb_add(&bar[XB_XGEN(b.x)], 1u);
            asm volatile("s_waitcnt vmcnt(0)" ::: "memory");
        } else {
            XB_SPIN(xb_ld(&bar[XB_XGEN(b.x)]) == gen, bar);
            __builtin_amdgcn_fence(__ATOMIC_ACQUIRE, "agent");
            asm volatile("s_waitcnt vmcnt(0)" ::: "memory");
        }
    }
    __syncthreads();
}

namespace cg = cooperative_groups;
__global__ void __launch_bounds__(NT, 2) mega_fwd(P p) {
    float* lds = (float*)smem;
    const lds_ptr ldsr = (lds_ptr)smem;
    const int bid = blockIdx.x, nb = gridDim.x;
    volatile LAS unsigned* MISC = (volatile LAS unsigned*)((LAS unsigned char*)smem + LDS_BYTES - 64);
    if (threadIdx.x < 2) MISC[threadIdx.x] = 0u;
    if ((threadIdx.x & 63) == 0) ((LAS int*)((LAS unsigned char*)smem + LDS_WTAB))[__builtin_amdgcn_s_getreg((5 << 11) | 4)] = (int)(threadIdx.x >> 6);
    __syncthreads();
    const XcdBarrier bar = xcd_barrier_post((unsigned*)(p.ws + WS_CTL), MISC);
#define GSYNC() xcd_barrier(bar)
#ifndef PROBE_A
#define PROBE_A -1
#endif
#ifndef PROBE_P
#define PROBE_P (PROBE_A - 1)
#endif
    unsigned long long* ts = (unsigned long long*)(p.ws + 512 * 1024);
#define STAMP(cat) do { if (PROBE_A >= 0 && bid == 0) ts[l * 16 + (cat)] = __builtin_amdgcn_s_memrealtime(); } while (0)
#define PH(call) do { const __attribute__((address_space(4))) unsigned long long* kp_ = (const __attribute__((address_space(4))) unsigned long long*)__builtin_amdgcn_kernarg_segment_ptr(); asm volatile("" : "+s"(kp_) :: "memory"); \
        P q; { unsigned long long* d_ = (unsigned long long*)&q; _Pragma("unroll") for (int i_ = 0; i_ < (int)(sizeof(P) / 8); ++i_) d_[i_] = kp_[i_]; } call; } while (0)
    if (PROBE_A >= 0 && bid == 0) ts[40] = __builtin_amdgcn_s_memrealtime();

#ifndef NO_ph_prologue
        PH(ph_prologue(q, bid, nb));
#endif

    cg::this_grid().sync();
    { constexpr int l = 0;

#ifndef NO_ph_prep_weights
        PH(ph_prep_weights(q, l, bid, nb, (lds_fptr)smem));
#endif
        GSYNC(); STAMP(0);

#ifndef NO_ph_gemm_p
        PH(ph_gemm_p(q, bid, nb, ldsr));
#endif

#ifndef NO_ph_gemm_kv
        if (l == 0) PH(ph_gemm_kv(q, bid, nb, ldsr));
#endif
        GSYNC(); STAMP(1);

#ifndef NO_ph_sb_attn
        PH(ph_sb_attn(q, bid, nb, (__attribute__((address_space(3))) unsigned char*)smem));
#endif

STAMP(11);
#ifndef NO_ph_conv
        PH(ph_conv(q, l, bid, nb, (LASX unsigned char*)smem));
#endif
        GSYNC(); STAMP(2);

#ifndef NO_ph_merged
        PH(ph_merged(q, l, bid, nb, ldsr));
#endif
        GSYNC(); STAMP(3);

#ifndef NO_ph_gemm_wout
        PH(ph_gemm_wout(q, bid, nb, ldsr));
#endif
        GSYNC(); STAMP(4);

#ifndef NO_ph_gemm_xq
        PH(ph_gemm_xq(q, bid, nb, ldsr));
#endif
        GSYNC(); STAMP(5);

#ifndef NO_ph_xattn
        PH(ph_xattn(q, l, bid, nb, (LASX unsigned char*)smem));
#endif
        GSYNC(); STAMP(6);

#ifndef NO_ph_gemm_wo
        PH(ph_gemm_wo(q, bid, nb, ldsr));
#endif
        GSYNC(); STAMP(7);

#ifndef NO_ph_gemm_pq
        PH(ph_gemm_pq(q, bid, nb, ldsr));
#endif
        GSYNC(); STAMP(8);

#ifndef NO_ph_peer_score
        PH(ph_peer_score(q, bid, nb, (lds_fptr)smem));
#endif
        GSYNC(); STAMP(9);

#ifndef NO_ph_peer_gather
        PH(ph_peer_u2(q, bid, nb, (LASX unsigned char*)smem)); GSYNC();
        PH(ph_peer_w(q, bid, nb)); GSYNC(); STAMP(12);
        PH(ph_peer_v(q, bid, nb, (LASX unsigned char*)smem));
        if (l == DEPTH - 1) { GSYNC(); PH(ph_final_norm(q, bid, nb)); }
#endif
        if (l < DEPTH - 1 || PROBE_A >= 0) GSYNC();
        STAMP(10);
    }
    { constexpr int l = 1;

#ifndef NO_ph_prep_weights
        PH(ph_prep_weights(q, l, bid, nb, (lds_fptr)smem));
#endif
        GSYNC(); STAMP(0);

#ifndef NO_ph_gemm_p
        PH(ph_gemm_p(q, bid, nb, ldsr));
#endif

#ifndef NO_ph_gemm_kv
        if (l == 0) PH(ph_gemm_kv(q, bid, nb, ldsr));
#endif
        GSYNC(); STAMP(1);

#ifndef NO_ph_sb_attn
        PH(ph_sb_attn(q, bid, nb, (__attribute__((address_space(3))) unsigned char*)smem));
#endif

STAMP(11);
#ifndef NO_ph_conv
        PH(ph_conv(q, l, bid, nb, (LASX unsigned char*)smem));
#endif
        GSYNC(); STAMP(2);

#ifndef NO_ph_merged
        PH(ph_merged(q, l, bid, nb, ldsr));
#endif
        GSYNC(); STAMP(3);

#ifndef NO_ph_gemm_wout
        PH(ph_gemm_wout(q, bid, nb, ldsr));
#endif
        GSYNC(); STAMP(4);

#ifndef NO_ph_gemm_xq
        PH(ph_gemm_xq(q, bid, nb, ldsr));
#endif
        GSYNC(); STAMP(5);

#ifndef NO_ph_xattn
        PH(ph_xattn(q, l, bid, nb, (LASX unsigned char*)smem));
#endif
        GSYNC(); STAMP(6);

#ifndef NO_ph_gemm_wo
        PH(ph_gemm_wo(q, bid, nb, ldsr));
#endif
        GSYNC(); STAMP(7);

#ifndef NO_ph_gemm_pq
        PH(ph_gemm_pq(q, bid, nb, ldsr));
#endif
        GSYNC(); STAMP(8);

#ifndef NO_ph_peer_score
        PH(ph_peer_score(q, bid, nb, (lds_fptr)smem));
#endif
        GSYNC(); STAMP(9);

#ifndef NO_ph_peer_gather
        PH(ph_peer_u2(q, bid, nb, (LASX unsigned char*)smem)); GSYNC();
        PH(ph_peer_w(q, bid, nb)); GSYNC(); STAMP(12);
        PH(ph_peer_v(q, bid, nb, (LASX unsigned char*)smem));
        if (l == DEPTH - 1) { GSYNC(); PH(ph_final_norm(q, bid, nb)); }
#endif
        if (l < DEPTH - 1 || PROBE_A >= 0) GSYNC();
        STAMP(10);
    }
#if PROBE_A >= 0
    {
        __threadfence(); cg::this_grid().sync();
        if (bid == 0 && get_tid() == 0) {
            unsigned long long tot = 0;
            for (int l = 0; l < DEPTH; ++l) { const unsigned long long prev = (PROBE_P >= 0) ? ts[l * 16 + PROBE_P] : (l == 0 ? ts[40] : ts[(l - 1) * 16 + 10]); tot += ts[l * 16 + PROBE_A] - prev; }
            p.out[0] += (float)tot * 0.01f * 0.02f;
        }
    }
#endif
#undef PH
}

extern "C" void kernel_launch(void* const* d_in, const int* in_sizes, int n_in, void* d_out, int out_size, void* d_ws, size_t ws_size, hipStream_t stream) {
    static int grid = 0;
    if (grid == 0) {
        int dev = 0, cus = 0, per_cu = 0;
        hipGetDevice(&dev);
        hipDeviceGetAttribute(&cus, hipDeviceAttributeMultiprocessorCount, dev);
        hipFuncSetAttribute((const void*)mega_fwd, hipFuncAttributeMaxDynamicSharedMemorySize, LDS_BYTES);
        hipOccupancyMaxActiveBlocksPerMultiprocessor(&per_cu, (const void*)mega_fwd, NT, LDS_BYTES);
        if (per_cu < 1) per_cu = 1;
        grid = cus * per_cu;
        if (ws_size < WS_END) { fprintf(stderr, "kernel_launch: workspace too small (%zu < %zu)\n", ws_size, (size_t)WS_END); grid = -1; }
    }
    if (grid < 0) return;
    P p{};
    const float** pp = (const float**)&p;
    for (int i = 0; i < 23; ++i) pp[i] = (const float*)d_in[i];
    p.out = (float*)d_out; p.ws = (unsigned char*)d_ws;
    (void)hipMemsetAsync((char*)d_ws + WS_CTL, 0, 16384, stream);
    void* args[] = {&p};
    hipError_t e = hipLaunchCooperativeKernel((void*)mega_fwd, dim3(grid), dim3(NT), args, LDS_BYTES, stream);
    if (e != hipSuccess) fprintf(stderr, "cooperative launch failed: %s (grid %d)\n", hipGetErrorString(e), grid);
}
```

```cpp
#include <hip/hip_runtime.h>
#include <hip/hip_cooperative_groups.h>
#include <cstdio>
#include <stdint.h>
#include <math.h>

constexpr int D = 1024, BATCH = 8, SEQ = 2048, T = BATCH * SEQ, DEPTH = 2, NMEM = 256, TM = BATCH * NMEM;
constexpr int INW = 7168, OFF_CV = 1536, OFF_SC = 2560, OFF_GATE = 4096;
constexpr int YW = 1536;
constexpr int NEXP = 16384, PQW = 2048;
constexpr int NT = 512;

typedef uint16_t bf16_t;
typedef short bf16x8 __attribute__((ext_vector_type(8)));
typedef float f32x4 __attribute__((ext_vector_type(4)));
typedef unsigned u32x4 __attribute__((ext_vector_type(4)));
typedef unsigned u32x2 __attribute__((ext_vector_type(2)));
#define GAS __attribute__((address_space(1)))

constexpr size_t MiB = 1u << 20;
constexpr size_t WS_CTL = 0;
constexpr size_t WS_WIN = 1 * MiB;
constexpr size_t WS_WBR = 15 * MiB;
constexpr size_t WS_WOUT = 18 * MiB;
constexpr size_t WS_WXQ = 20 * MiB;
constexpr size_t WS_WKV = 22 * MiB;
constexpr size_t WS_WO = 26 * MiB;
constexpr size_t WS_WPQ = 28 * MiB;
constexpr size_t WS_KEYS = 32 * MiB;
constexpr size_t WS_U = 33 * MiB;
constexpr size_t WS_V = 49 * MiB;
constexpr size_t WS_USC = 65 * MiB;
constexpr size_t WS_VSC = 65 * MiB + 65536;
constexpr size_t WS_HB = 97 * MiB;
constexpr size_t WS_SSQ = 129 * MiB;
constexpr size_t WS_MEMSSQ = 256 * 1024;
constexpr size_t WS_MEMB = 130 * MiB;
constexpr size_t WS_KV = 134 * MiB;
constexpr size_t WS_Y = 142 * MiB;
constexpr size_t WS_MERGED = 190 * MiB;
constexpr size_t WS_P = 222 * MiB;
constexpr size_t WS_XQ = 222 * MiB;
constexpr size_t WS_XO = 254 * MiB;
constexpr size_t WS_PQ = 286 * MiB;
constexpr size_t WS_PIDX = 350 * MiB;
constexpr size_t WS_PG = 358 * MiB;
constexpr size_t WS_PD = 366 * MiB;
constexpr size_t WS_VT = 446 * MiB;
constexpr size_t WS_SBVT = 450 * MiB;
constexpr size_t WS_WKV2 = 466 * MiB;
constexpr size_t WS_KV2 = 474 * MiB;
constexpr size_t WS_VT2 = 490 * MiB;
constexpr size_t WS_END = 498 * MiB;

struct P {
    const float *x, *mem, *norm_mix_g, *w_in, *conv_dw_w, *conv_dw_b, *conv_ln_g, *conv_ln_b, *sc_w, *w_branch, *b_gate, *w_out,
        *norm_xa_g, *norm_mem_g, *xa_wq, *xa_wkv, *xa_wo, *norm_ffn_g, *peer_wq, *peer_keys, *peer_u, *peer_v, *final_g;
    float* out;
    unsigned char* ws;
};

__device__ __forceinline__ unsigned f2bf(float f) { unsigned u = __float_as_uint(f); return (u + 0x7fffu + ((u >> 16) & 1u)) >> 16; }
__device__ __forceinline__ unsigned pk2(float lo, float hi) { return f2bf(lo) | (f2bf(hi) << 16); }
__device__ __forceinline__ float bflo(unsigned w) { return __uint_as_float(w << 16); }
__device__ __forceinline__ float bfhi(unsigned w) { return __uint_as_float(w & 0xffff0000u); }
__device__ __forceinline__ float bf2f(bf16_t h) { return __uint_as_float(((unsigned)h) << 16); }
constexpr int LDS_BYTES = 147456;
constexpr int LDS_WTAB = LDS_BYTES - 512;
extern __shared__ __attribute__((aligned(16))) unsigned char smem[];
__device__ __forceinline__ int get_tid() {
    const unsigned hw = __builtin_amdgcn_s_getreg((5 << 11) | 4);
    const int w = ((volatile __attribute__((address_space(3))) int*)((__attribute__((address_space(3))) unsigned char*)smem + LDS_WTAB))[hw];
    unsigned ones = ~0u; asm volatile("" : "+s"(ones));
    int t = (w << 6) | (int)__builtin_amdgcn_mbcnt_hi(ones, __builtin_amdgcn_mbcnt_lo(ones, 0u));
    asm volatile("" : "+v"(t)); return t; }
__device__ __forceinline__ float shx(float v, int m, int lane) { return __uint_as_float((unsigned)__builtin_amdgcn_ds_bpermute((lane ^ m) << 2, (int)__float_as_uint(v))); }
template <int CTRL> __device__ __forceinline__ float dppf(float x) { return __uint_as_float((unsigned)__builtin_amdgcn_update_dpp(0, (int)__float_as_uint(x), CTRL, 0xF, 0xF, false)); }
__device__ __forceinline__ float swap32_sum(float a, float b) { auto r = __builtin_amdgcn_permlane32_swap(__float_as_uint(a), __float_as_uint(b), false, false); return __uint_as_float(r[0]) + __uint_as_float(r[1]); }
__device__ __forceinline__ float swap16_sum(float a, float b) { auto r = __builtin_amdgcn_permlane16_swap(__float_as_uint(a), __float_as_uint(b), false, false); return __uint_as_float(r[0]) + __uint_as_float(r[1]); }
__device__ __forceinline__ float wave_sum2(float x) {
    x += dppf<0x128>(x); x += dppf<0x124>(x); x += dppf<0x122>(x); x += dppf<0x121>(x);
    x = swap16_sum(x, x); x = swap32_sum(x, x); return x; }
__device__ __forceinline__ float wave_sum(float v, int) { return wave_sum2(v); }
__device__ __forceinline__ float wave_max(float x, int) {
    x = fmaxf(x, dppf<0x128>(x)); x = fmaxf(x, dppf<0x124>(x)); x = fmaxf(x, dppf<0x122>(x)); x = fmaxf(x, dppf<0x121>(x));
    { auto r = __builtin_amdgcn_permlane16_swap(__float_as_uint(x), __float_as_uint(x), false, false); x = fmaxf(__uint_as_float(r[0]), __uint_as_float(r[1])); }
    { auto r = __builtin_amdgcn_permlane32_swap(__float_as_uint(x), __float_as_uint(x), false, false); x = fmaxf(__uint_as_float(r[0]), __uint_as_float(r[1])); }
    return x; }
__device__ __forceinline__ float sigmoidf_(float z) { return 1.0f / (1.0f + __expf(-z)); }

__device__ __forceinline__ void row_to_bf16_rs(const float* src, float* dst_f32, bf16_t* dst_bf, float* rs_out, int lane) {
    const f32x4* s4 = (const f32x4*)src + lane;
    f32x4 v[4]; float ss = 0.f;
#pragma unroll
    for (int j = 0; j < 4; ++j) { v[j] = s4[64 * j]; ss += v[j].x * v[j].x + v[j].y * v[j].y + v[j].z * v[j].z + v[j].w * v[j].w; }
    ss = wave_sum(ss, lane);
    if (dst_f32) {
#pragma unroll
        for (int j = 0; j < 4; ++j) ((f32x4*)dst_f32 + lane)[64 * j] = v[j];
    }
#pragma unroll
    for (int j = 0; j < 4; ++j) { u32x2 w; w.x = pk2(v[j].x, v[j].y); w.y = pk2(v[j].z, v[j].w); ((u32x2*)dst_bf + lane)[64 * j] = w; }
    if (lane < 16) rs_out[lane] = lane == 0 ? ss : 0.f;
}
__device__ __forceinline__ void ph_prologue(const P& p, int bid, int nb) {
    const int tid = get_tid(), lane = tid & 63, wid = tid >> 6;
    const int gw = bid * 8 + wid, ngw = nb * 8;
    bf16_t* hb = (bf16_t*)(p.ws + WS_HB); float* rs = (float*)(p.ws + WS_SSQ);
    bf16_t* memb = (bf16_t*)(p.ws + WS_MEMB); float* mrs = (float*)(p.ws + WS_MEMSSQ);
    for (int r = gw; r < T; r += ngw) row_to_bf16_rs(p.x + (size_t)r * D, nullptr, hb + (size_t)r * D, rs + (size_t)r * 16, lane);
    for (int r = gw; r < TM; r += ngw) row_to_bf16_rs(p.mem + (size_t)r * D, nullptr, memb + (size_t)r * D, mrs + (size_t)r * 16, lane);
}
__device__ __forceinline__ void transpose_item(const float* W_, const float* g_, bf16_t* Wt_, int K, int N, int item, __attribute__((address_space(3))) float* scr, int lane) {
    const GAS float* W = (const GAS float*)W_; const GAS float* g = (const GAS float*)g_; GAS bf16_t* Wt = (GAS bf16_t*)Wt_;
    const int nblk = N / 32, kb = item / nblk, nbk = item % nblk, k0 = 64 * kb, n0 = 32 * nbk;
    float v[32];
#pragma unroll
    for (int i = 0; i < 32; ++i) { const int kk = 2 * i + (lane >> 5); v[i] = W[(size_t)(k0 + kk) * N + n0 + (lane & 31)]; }
    if (g_ != nullptr) {
#pragma unroll
        for (int i = 0; i < 32; ++i) v[i] *= g[k0 + 2 * i + (lane >> 5)];
    }
#pragma unroll
    for (int i = 0; i < 32; ++i) scr[(2 * i + (lane >> 5)) * 33 + (lane & 31)] = v[i];
    const int c = lane & 7;
#pragma unroll
    for (int j = 0; j < 4; ++j) {
        const int n = (lane >> 3) + 8 * j; const __attribute__((address_space(3))) float* sp = scr + (8 * c) * 33 + n;
        u32x4 o; o.x = pk2(sp[0 * 33], sp[1 * 33]); o.y = pk2(sp[2 * 33], sp[3 * 33]); o.z = pk2(sp[4 * 33], sp[5 * 33]); o.w = pk2(sp[6 * 33], sp[7 * 33]);
        *(GAS u32x4*)(Wt + (size_t)(n0 + n) * K + k0 + 8 * c) = o;
    }
}
__device__ __forceinline__ void ph_prep_weights(const P& p, int l, int bid, int nb, __attribute__((address_space(3))) float* ldsf) {
    unsigned char* ws = p.ws;
    {
        const int tid = get_tid(), lane = tid & 63, wid = __builtin_amdgcn_readfirstlane(tid >> 6);
        __attribute__((address_space(3))) float* scr = ldsf + wid * (64 * 33);
        constexpr int I0 = 16 * 224, I1 = 8 * 32, I4 = 16 * 32, I6 = 16 * 64;
        constexpr int NITEMS = I0 + 3 * I1 + I4 + I4 + I6 + I4 + I6;
#pragma unroll 1
        for (int it = bid * 8 + wid; it < NITEMS; it += nb * 8) {
            int r = it;
            if (r < I0) { transpose_item(p.w_in + (size_t)l * D * INW, p.norm_mix_g + l * D, (bf16_t*)(ws + WS_WIN), D, INW, r, scr, lane); continue; } r -= I0;
            if (r < 3 * I1) { const int b = r / I1; transpose_item(p.w_branch + ((size_t)l * 3 + b) * 512 * D, nullptr, (bf16_t*)(ws + WS_WBR) + (size_t)b * 1024 * 512, 512, D, r % I1, scr, lane); continue; } r -= 3 * I1;
            if (r < I4) { transpose_item(p.w_out + (size_t)l * D * D, nullptr, (bf16_t*)(ws + WS_WOUT), D, D, r, scr, lane); continue; } r -= I4;
            if (r < I4) { transpose_item(p.xa_wq + (size_t)l * D * D, p.norm_xa_g + l * D, (bf16_t*)(ws + WS_WXQ), D, D, r, scr, lane); continue; } r -= I4;
            if (r < I6) { if (l == 0) { transpose_item(p.xa_wkv, p.norm_mem_g, (bf16_t*)(ws + WS_WKV2), D, 2 * D, r, scr, lane); transpose_item(p.xa_wkv + (size_t)D * 2 * D, p.norm_mem_g + D, (bf16_t*)(ws + WS_WKV2) + (size_t)2 * D * D, D, 2 * D, r, scr, lane); } continue; } r -= I6;
            if (r < I4) { transpose_item(p.xa_wo + (size_t)l * D * D, nullptr, (bf16_t*)(ws + WS_WO), D, D, r, scr, lane); continue; } r -= I4;
            transpose_item(p.peer_wq + (size_t)l * D * PQW, p.norm_ffn_g + l * D, (bf16_t*)(ws + WS_WPQ), D, PQW, r, scr, lane);
        }
    }
    {
        const int tid = get_tid(), lane = tid & 63, wid = tid >> 6;
        const f32x4* g4 = (const f32x4*)(p.norm_ffn_g + l * D) + 4 * lane;
        const f32x4 gg0 = g4[0], gg1 = g4[1], gg2 = g4[2], gg3 = g4[3];
#pragma unroll 1
        for (int row0 = bid * 8 + wid; row0 < 2 * NEXP; row0 += 2 * nb * 8) {
            f32x4 a[2][4];
#pragma unroll
            for (int h2 = 0; h2 < 2; ++h2) {
                const int row = row0 + h2 * nb * 8; const bool isv = row >= NEXP; const int e = isv ? row - NEXP : row;
                const GAS f32x4* src = (const GAS f32x4*)((isv ? p.peer_v : p.peer_u) + ((size_t)l * NEXP + (row < 2 * NEXP ? e : 0)) * D) + 4 * lane;
                a[h2][0] = src[0]; a[h2][1] = src[1]; a[h2][2] = src[2]; a[h2][3] = src[3];
            }
#pragma unroll
            for (int h2 = 0; h2 < 2; ++h2) {
                const int row = row0 + h2 * nb * 8; const bool isv = row >= NEXP; const int e = isv ? row - NEXP : row;
                if (row < 2 * NEXP) {
                    f32x4 a0 = a[h2][0], a1 = a[h2][1], a2 = a[h2][2], a3 = a[h2][3];
                    if (!isv) { a0 *= gg0; a1 *= gg1; a2 *= gg2; a3 *= gg3; }
                    float m = 0.f;
#pragma unroll
                    for (int i = 0; i < 4; ++i) m = fmaxf(m, fmaxf(fmaxf(fabsf(a0[i]), fabsf(a1[i])), fmaxf(fabsf(a2[i]), fabsf(a3[i]))));
                    m = wave_max(m, lane);
                    const float sc = m > 0.f ? 240.0f / m : 1.0f;
                    u32x4 w;
                    w.x = (unsigned)__builtin_amdgcn_cvt_pk_fp8_f32(a0[2] * sc, a0[3] * sc, __builtin_amdgcn_cvt_pk_fp8_f32(a0[0] * sc, a0[1] * sc, 0, false), true);
                    w.y = (unsigned)__builtin_amdgcn_cvt_pk_fp8_f32(a1[2] * sc, a1[3] * sc, __builtin_amdgcn_cvt_pk_fp8_f32(a1[0] * sc, a1[1] * sc, 0, false), true);
                    w.z = (unsigned)__builtin_amdgcn_cvt_pk_fp8_f32(a2[2] * sc, a2[3] * sc, __builtin_amdgcn_cvt_pk_fp8_f32(a2[0] * sc, a2[1] * sc, 0, false), true);
                    w.w = (unsigned)__builtin_amdgcn_cvt_pk_fp8_f32(a3[2] * sc, a3[3] * sc, __builtin_amdgcn_cvt_pk_fp8_f32(a3[0] * sc, a3[1] * sc, 0, false), true);
                    ((GAS u32x4*)(ws + (isv ? WS_V : WS_U)) + (size_t)e * 64)[lane] = w;
                    if (lane == 0) ((GAS float*)(ws + (isv ? WS_VSC : WS_USC)))[e] = m > 0.f ? m * (1.0f / 240.0f) : 1.0f;
                }
            }
        }
    }
    const size_t gt = (size_t)bid * NT + get_tid(), gn = (size_t)nb * NT;
    const f32x4* k4 = (const f32x4*)(p.peer_keys + (size_t)l * 8 * 2 * 128 * 128); u32x2* kb = (u32x2*)(ws + WS_KEYS);
    for (size_t i = gt; i < (size_t)8 * 2 * 128 * 128 / 4; i += gn) { const f32x4 a = k4[i]; u32x2 w; w.x = pk2(a.x, a.y); w.y = pk2(a.z, a.w); kb[i] = w; }
}

namespace pg8 {
#define PG8_LAS __attribute__((address_space(3)))
constexpr int BM = 256, BK = 64, HALF = 128, HTB = HALF * BK * 2  , STAGE_BYTES = 8 * HTB, NXCD = 8, WGM = 8;

__host__ __device__ __forceinline__ int lds_byte(int r, int c) { const int st = (r >> 4) * 2 + (c >> 5), rr = r & 15, cc = c & 31, ob = rr * 64 + cc * 2; return st * 1024 + (ob ^ (((ob >> 9) & 1) << 5)); }
__host__ __device__ __forceinline__ void stage_rc(int b, int& R, int& C) { const int st = b / 1024, sb = b % 1024, swz = sb ^ (((sb >> 9) & 1) << 5); R = (st >> 1) * 16 + swz / 64; C = (st & 1) * 32 + (swz % 64) / 2; }
__host__ __device__ __forceinline__ int perm32(int rho) { const int n = rho >> 4, i = rho & 15; return 8 * (i >> 2) + 4 * n + (i & 3); }

struct Unit { int pm, pn, pb; };
struct Gemm { const bf16_t* A; const bf16_t* Bt; int K; size_t a_bs, b_bs; };

struct StaticOrder {
    int nM, nN, nwg, G, c;
    __host__ __device__ void init(int M, int N, int G_, int c_) { nM = M / BM; nN = N / BM; nwg = nM * nN; G = G_; c = c_; }
    __host__ __device__ bool next(int i, Unit& u) const {
        const long L = (long)i * G + c; if (L >= nwg) return false;
        int wgid = (int)L; { const int q = nwg / NXCD, r = nwg % NXCD, xcd = wgid % NXCD, off = wgid / NXCD; wgid = (xcd < r ? xcd * (q + 1) : r * (q + 1) + (xcd - r) * q) + off; }
        const int nig = WGM * nN, gid = wgid / nig, fm = gid * WGM, gsz = (nM - fm) < WGM ? (nM - fm) : WGM;
        u.pm = fm + ((wgid % nig) % gsz); u.pn = (wgid % nig) / gsz; u.pb = 0; return true;
    }
    __device__ __forceinline__ void a_ready(const Unit&) const {}
    __device__ __forceinline__ void done(const Unit&) const {}
};
__device__ __forceinline__ unsigned cvt_pk_bf16(float lo, float hi) { unsigned r; asm volatile("v_cvt_pk_bf16_f32 %0, %1, %2" : "=v"(r) : "v"(lo), "v"(hi)); return r; }
template <class Epi, class Sched, bool ALIGN_EPI = false, bool SP2 = false>
__device__ __forceinline__ void gemm_phase(PG8_LAS unsigned char* lds, const Gemm g, const Sched& S, const Epi& E) {
    const int tid = get_tid(), wid = __builtin_amdgcn_readfirstlane(tid >> 6), lane = tid & 63, wr = wid >> 2, wc = wid & 3, fr = lane & 15, fq = lane >> 4;
    const int K = g.K, nt = K / BK;
    unsigned voffA[2], voffB[2];
#pragma unroll
    for (int i = 0; i < 2; ++i) { int R, C; stage_rc(tid * 16 + i * 8192, R, C); const int Rb = Epi::PERM ? ((R & ~31) + perm32(R & 31)) : R;
        voffA[i] = (unsigned)(R * K + C) * 2u; voffB[i] = (unsigned)(Rb * K + C) * 2u; }
    const size_t kstep = (size_t)(BK * 2);
    const size_t hstep = (size_t)HALF * K * 2;
    const size_t tstep = 2 * hstep;
    const unsigned ldsw = (unsigned)wid * 1024u;
    const int aoff = lds_byte(wr * 64 + fr, fq * 8), boff = lds_byte(wc * 32 + fr, fq * 8);
#define PG8_SA(b, h) (((b) * 2 + (h)) * HTB)
#define PG8_SB(b, h) ((4 + (b) * 2 + (h)) * HTB)
#define PG8_STAGE(bufoff, gbase, voff) do { _Pragma("unroll") for (int _i = 0; _i < 2; ++_i) \
        __builtin_amdgcn_global_load_lds((const unsigned*)((const char*)(gbase) + (voff)[_i]), (PG8_LAS unsigned*)(lds + (bufoff) + ldsw + _i * 8192), 16, 0, 0); } while (0)
#define PG8_LDA(dst, b, h) do { _Pragma("unroll") for (int m = 0; m < 4; ++m) _Pragma("unroll") for (int k = 0; k < 2; ++k) dst[m][k] = *(const PG8_LAS bf16x8*)(lds + PG8_SA(b, h) + aoff + m * 2048 + k * 1024); } while (0)
#define PG8_LDB(dst, b, h) do { _Pragma("unroll") for (int n = 0; n < 2; ++n) _Pragma("unroll") for (int k = 0; k < 2; ++k) dst[n][k] = *(const PG8_LAS bf16x8*)(lds + PG8_SB(b, h) + boff + n * 2048 + k * 1024); } while (0)
#define PG8_MMA(ai, bj, At, Bt) do { __builtin_amdgcn_s_setprio(1); _Pragma("unroll") for (int m = 0; m < 4; ++m) _Pragma("unroll") for (int n = 0; n < 2; ++n) _Pragma("unroll") for (int k = 0; k < 2; ++k) \
        acc[ai][bj][m][n] = __builtin_amdgcn_mfma_f32_16x16x32_bf16(Bt[n][k], At[m][k], acc[ai][bj][m][n], 0, 0, 0); __builtin_amdgcn_s_setprio(0); } while (0)
#define PG8_WAIT_V(n) asm volatile("s_waitcnt vmcnt(" #n ")" ::: "memory")
#define PG8_WAIT_L(n) asm volatile("s_waitcnt lgkmcnt(" #n ")" ::: "memory")
#define PG8_BAR __builtin_amdgcn_s_barrier()
#define PG8_SCHED __builtin_amdgcn_sched_barrier(0)
    Unit cur, nxt; int ui = 0;
    if (!S.next(0, cur)) return;
    f32x4 acc[2][2][4][2];
#pragma unroll
    for (int a = 0; a < 2; ++a)
#pragma unroll
        for (int b = 0; b < 2; ++b)
#pragma unroll
            for (int m = 0; m < 4; ++m)
#pragma unroll
                for (int n = 0; n < 2; ++n) acc[a][b][m][n] = (f32x4){0.f, 0.f, 0.f, 0.f};
    bf16x8 At[4][2], B0[2][2], B1[2][2];
    const char* cA = (const char*)g.A + (size_t)cur.pm * tstep + (size_t)cur.pb * g.a_bs; const char* cB = (const char*)g.Bt + (size_t)cur.pn * tstep + (size_t)cur.pb * g.b_bs;
    S.a_ready(cur);
    if constexpr (SP2) {
        PG8_STAGE(PG8_SB(0, 0), cB, voffB); PG8_STAGE(PG8_SB(0, 1), cB + hstep, voffB); PG8_STAGE(PG8_SA(0, 0), cA, voffA); PG8_STAGE(PG8_SA(0, 1), cA + hstep, voffA);
        if (wr == 1) PG8_BAR;
        PG8_WAIT_V(2); PG8_BAR;
        PG8_STAGE(PG8_SB(1, 0), cB + kstep, voffB); PG8_STAGE(PG8_SA(1, 0), cA + kstep, voffA); PG8_STAGE(PG8_SB(1, 1), cB + hstep + kstep, voffB);
        PG8_WAIT_V(6); PG8_BAR;
    } else {
        PG8_STAGE(PG8_SB(0, 0), cB, voffB); PG8_STAGE(PG8_SA(0, 0), cA, voffA); PG8_STAGE(PG8_SB(0, 1), cB + hstep, voffB); PG8_STAGE(PG8_SA(0, 1), cA + hstep, voffA);
        if (wr == 1) PG8_BAR;
        PG8_WAIT_V(4); PG8_BAR;
        PG8_STAGE(PG8_SB(1, 0), cB + kstep, voffB); PG8_STAGE(PG8_SA(1, 0), cA + kstep, voffA); PG8_STAGE(PG8_SB(1, 1), cB + hstep + kstep, voffB);
        PG8_WAIT_V(6); PG8_BAR;
    }
    for (;;) {
        const bool has_next = S.next(ui + 1, nxt);
        const char* nA = has_next ? (const char*)g.A + (size_t)nxt.pm * tstep + (size_t)nxt.pb * g.a_bs : cA; const char* nB = has_next ? (const char*)g.Bt + (size_t)nxt.pn * tstep + (size_t)nxt.pb * g.b_bs : cB;
        for (int t = 0; t < nt; t += 2) {
            const bool last = (t == nt - 2);
            const char* a1 = cA + (size_t)(t + 1) * kstep;
            const char* a2 = last ? nA : cA + (size_t)(t + 2) * kstep; const char* b2 = last ? nB : cB + (size_t)(t + 2) * kstep;
            const char* a3 = a2 + kstep; const char* b3 = b2 + kstep;
            if (last && has_next) S.a_ready(nxt);
            if constexpr (SP2) {
            PG8_LDB(B0, 0, 0); PG8_LDB(B1, 0, 1); PG8_SCHED; PG8_LDA(At, 0, 0); PG8_STAGE(PG8_SA(1, 1), a1 + hstep, voffA);
            PG8_WAIT_V(8); PG8_WAIT_L(0); PG8_BAR; PG8_MMA(0, 0, At, B0); PG8_MMA(0, 1, At, B1); PG8_BAR; PG8_SCHED;
            PG8_LDA(At, 0, 1); PG8_STAGE(PG8_SB(0, 0), b2, voffB); PG8_STAGE(PG8_SB(0, 1), b2 + hstep, voffB); PG8_STAGE(PG8_SA(0, 0), a2, voffA);
            PG8_WAIT_V(8); PG8_WAIT_L(0); PG8_BAR; PG8_MMA(1, 0, At, B0); PG8_MMA(1, 1, At, B1); PG8_BAR; PG8_SCHED;
            PG8_LDB(B0, 1, 0); PG8_LDB(B1, 1, 1); PG8_SCHED; PG8_LDA(At, 1, 0); PG8_STAGE(PG8_SA(0, 1), a2 + hstep, voffA);
            PG8_WAIT_V(8); PG8_WAIT_L(0); PG8_BAR; PG8_MMA(0, 0, At, B0); PG8_MMA(0, 1, At, B1); PG8_BAR; PG8_SCHED;
            PG8_LDA(At, 1, 1); PG8_STAGE(PG8_SB(1, 0), b3, voffB); PG8_STAGE(PG8_SB(1, 1), b3 + hstep, voffB); PG8_STAGE(PG8_SA(1, 0), a3, voffA);
            PG8_WAIT_V(8); PG8_WAIT_L(0); PG8_BAR; PG8_MMA(1, 0, At, B0); PG8_MMA(1, 1, At, B1); PG8_BAR; PG8_SCHED;
            } else {
            PG8_LDB(B0, 0, 0); PG8_SCHED; PG8_LDA(At, 0, 0); PG8_STAGE(PG8_SA(1, 1), a1 + hstep, voffA);
            PG8_WAIT_L(8); PG8_BAR; PG8_WAIT_L(0); PG8_MMA(0, 0, At, B0); PG8_BAR; PG8_SCHED;
            PG8_LDB(B1, 0, 1); PG8_STAGE(PG8_SB(0, 0), b2, voffB);
            PG8_BAR; PG8_WAIT_L(0); PG8_MMA(0, 1, At, B1); PG8_BAR;
            PG8_LDA(At, 0, 1); PG8_STAGE(PG8_SA(0, 0), a2, voffA);
            PG8_BAR; PG8_WAIT_L(0); PG8_MMA(1, 0, At, B0); PG8_BAR; PG8_SCHED;
            PG8_STAGE(PG8_SB(0, 1), b2 + hstep, voffB);
            PG8_WAIT_V(6); PG8_BAR; PG8_MMA(1, 1, At, B1); PG8_BAR;
            PG8_LDB(B0, 1, 0); PG8_SCHED; PG8_LDA(At, 1, 0); PG8_STAGE(PG8_SA(0, 1), a2 + hstep, voffA);
            PG8_WAIT_L(8); PG8_BAR; PG8_WAIT_L(0); PG8_MMA(0, 0, At, B0); PG8_BAR; PG8_SCHED;
            PG8_LDB(B1, 1, 1); PG8_STAGE(PG8_SB(1, 0), b3, voffB);
            PG8_BAR; PG8_WAIT_L(0); PG8_MMA(0, 1, At, B1); PG8_BAR;
            PG8_LDA(At, 1, 1); PG8_STAGE(PG8_SA(1, 0), a3, voffA);
            PG8_BAR; PG8_WAIT_L(0); PG8_MMA(1, 0, At, B0); PG8_BAR; PG8_SCHED;
            PG8_STAGE(PG8_SB(1, 1), b3 + hstep, voffB);
            PG8_WAIT_V(6); PG8_BAR; PG8_MMA(1, 1, At, B1); PG8_BAR;
            }
        }
        if constexpr (ALIGN_EPI) { if (wr == 0) PG8_BAR; }
        if constexpr (!Epi::AFTER_DRAIN) { E(acc, cur, wr, wc, fr, fq); S.done(cur); }
        if (!has_next) break;
        if (!E.keep(cur))
#pragma unroll
        for (int a = 0; a < 2; ++a)
#pragma unroll
            for (int b = 0; b < 2; ++b)
#pragma unroll
                for (int m = 0; m < 4; ++m)
#pragma unroll
                    for (int n = 0; n < 2; ++n) acc[a][b][m][n] = (f32x4){0.f, 0.f, 0.f, 0.f};
        cur = nxt; cA = nA; cB = nB; ++ui;
        if constexpr (ALIGN_EPI) { if (wr == 1) PG8_BAR; }
    }
    PG8_WAIT_V(0);
    if constexpr (!ALIGN_EPI) { if (wr == 0) PG8_BAR; }
    PG8_BAR;
    if constexpr (Epi::AFTER_DRAIN) { E.fused(acc, cur, wr, wc, fr, fq, lds, wid, lane); S.done(cur); }
#undef PG8_SA
#undef PG8_SB
#undef PG8_STAGE
#undef PG8_LDA
#undef PG8_LDB
#undef PG8_MMA
#undef PG8_WAIT_V
#undef PG8_WAIT_L
#undef PG8_BAR
#undef PG8_SCHED
}

struct TripleOrder {
    StaticOrder so;
    __device__ void init(int M, int N, int G_, int c_) { so.init(M, N, G_, c_); }
    __device__ bool next(int i, Unit& u) const { if (!so.next(i / 3, u)) return false; u.pb = i % 3; return true; }
    __device__ __forceinline__ void a_ready(const Unit&) const {}
    __device__ __forceinline__ void done(const Unit&) const {}
};
__device__ __forceinline__ float row_rs(const float* ssq, int row, int fq, int lane) {
    const f32x4 v = *(const f32x4*)(ssq + (size_t)row * 16 + 4 * fq);
    float s = (v.x + v.y) + (v.z + v.w); s = swap16_sum(s, s); s = swap32_sum(s, s);
    return rsqrtf(s * (1.0f / 1024.0f) + 1e-6f);
}
struct EpiScale {
    static constexpr bool PERM = true, AFTER_DRAIN = false;
    bf16_t* O; int ldo; const float* ssq; int ncol0; float s0; bf16_t* VT;
    __device__ __forceinline__ bool keep(const Unit&) const { return false; }
    __device__ __forceinline__ void operator()(f32x4 (&acc)[2][2][4][2], const Unit& u, int wr, int wc, int fr, int fq) const {
        const int row0 = u.pm * BM + wr * 64 + fr, col0 = u.pn * BM + wc * 32 + 8 * fq;
#pragma unroll
        for (int ai = 0; ai < 2; ++ai)
#pragma unroll
            for (int m = 0; m < 4; ++m) {
                const int row = row0 + ai * HALF + m * 16;
                const float rs = row_rs(ssq, row, fq, fq * 16 + fr);
#pragma unroll
                for (int bj = 0; bj < 2; ++bj) {
                    const int c = col0 + bj * HALF; const float sc = rs * (c < ncol0 ? s0 : 1.0f);
                    const f32x4 v0 = acc[ai][bj][m][0] * sc, v1 = acc[ai][bj][m][1] * sc;
                    u32x4 w; w.x = cvt_pk_bf16(v0[0], v0[1]); w.y = cvt_pk_bf16(v0[2], v0[3]); w.z = cvt_pk_bf16(v1[0], v1[1]); w.w = cvt_pk_bf16(v1[2], v1[3]);
                    *(u32x4*)(O + (size_t)row * ldo + c) = w;
                    if (VT != nullptr && c >= 1024 && c < 1536) {
                        const int b = row >> 11, sq = row & 2047, cc = c - 1024;
                        bf16_t* vp = VT + ((size_t)(b * 512 + cc)) * 2048 + sq;
                        vp[0 * 2048] = (bf16_t)(w.x & 0xffffu); vp[1 * 2048] = (bf16_t)(w.x >> 16); vp[2 * 2048] = (bf16_t)(w.y & 0xffffu); vp[3 * 2048] = (bf16_t)(w.y >> 16);
                        vp[4 * 2048] = (bf16_t)(w.z & 0xffffu); vp[5 * 2048] = (bf16_t)(w.z >> 16); vp[6 * 2048] = (bf16_t)(w.w & 0xffffu); vp[7 * 2048] = (bf16_t)(w.w >> 16);
                    }
                }
            }
    }
};
struct EpiKV {
    static constexpr bool PERM = true, AFTER_DRAIN = false;
    bf16_t* O; bf16_t* VT; const float* ssq;
    __device__ __forceinline__ bool keep(const Unit&) const { return false; }
    __device__ __forceinline__ void operator()(f32x4 (&acc)[2][2][4][2], const Unit& u, int wr, int wc, int fr, int fq) const {
        const int row0 = u.pm * BM + wr * 64 + fr, col0 = u.pn * BM + wc * 32 + 8 * fq;
#pragma unroll
        for (int ai = 0; ai < 2; ++ai)
#pragma unroll
            for (int m = 0; m < 4; ++m) {
                const int row = row0 + ai * HALF + m * 16;
                const float rs = row_rs(ssq, row, fq, fq * 16 + fr);
#pragma unroll
                for (int bj = 0; bj < 2; ++bj) {
                    const int cfull = col0 + bj * HALF, layer = cfull >> 11, c = cfull & 2047;
                    const f32x4 v0 = acc[ai][bj][m][0] * rs, v1 = acc[ai][bj][m][1] * rs;
                    u32x4 w; w.x = cvt_pk_bf16(v0[0], v0[1]); w.y = cvt_pk_bf16(v0[2], v0[3]); w.z = cvt_pk_bf16(v1[0], v1[1]); w.w = cvt_pk_bf16(v1[2], v1[3]);
                    if (c < 1024) { *(u32x4*)(O + (size_t)layer * TM * 2048 + (size_t)row * 2048 + c) = w; }
                    else {
                        const int b = row >> 8, mem = row & 255, cc = c - 1024;
                        bf16_t* vp = VT + (size_t)layer * (8 * 4 * 256 * 256) + ((size_t)(b * 4 + (cc >> 8)) * 256 + (cc & 255)) * 256 + mem;
                        vp[0 * 256] = (bf16_t)(w.x & 0xffffu); vp[1 * 256] = (bf16_t)(w.x >> 16); vp[2 * 256] = (bf16_t)(w.y & 0xffffu); vp[3 * 256] = (bf16_t)(w.y >> 16);
                        vp[4 * 256] = (bf16_t)(w.z & 0xffffu); vp[5 * 256] = (bf16_t)(w.z >> 16); vp[6 * 256] = (bf16_t)(w.w & 0xffffu); vp[7 * 256] = (bf16_t)(w.w >> 16);
                    }
                }
            }
    }
};
struct EpiResidual {
    static constexpr bool PERM = true, AFTER_DRAIN = false;
    bf16_t* HB; float* ssq;
    __device__ __forceinline__ bool keep(const Unit&) const { return false; }
    __device__ __forceinline__ void operator()(f32x4 (&acc)[2][2][4][2], const Unit& u, int wr, int wc, int fr, int fq) const {
        const int row0 = u.pm * BM + wr * 64 + fr, col0 = u.pn * BM + wc * 32 + 8 * fq;
#pragma unroll
        for (int ai = 0; ai < 2; ++ai)
#pragma unroll
            for (int m = 0; m < 4; ++m) {
                const int row = row0 + ai * HALF + m * 16; float sq = 0.f;
#pragma unroll
                for (int bj = 0; bj < 2; ++bj) {
                    const int c = col0 + bj * HALF;
                    u32x4* hp = (u32x4*)(HB + (size_t)row * D + c);
                    const u32x4 hv = *hp;
                    const f32x4 a = (f32x4){bflo(hv.x), bfhi(hv.x), bflo(hv.y), bfhi(hv.y)} + acc[ai][bj][m][0], b = (f32x4){bflo(hv.z), bfhi(hv.z), bflo(hv.w), bfhi(hv.w)} + acc[ai][bj][m][1];
                    u32x4 w; w.x = cvt_pk_bf16(a[0], a[1]); w.y = cvt_pk_bf16(a[2], a[3]); w.z = cvt_pk_bf16(b[0], b[1]); w.w = cvt_pk_bf16(b[2], b[3]);
                    *hp = w;
                    const float r0 = bflo(w.x), r1 = bfhi(w.x), r2 = bflo(w.y), r3 = bfhi(w.y), r4 = bflo(w.z), r5 = bfhi(w.z), r6 = bflo(w.w), r7 = bfhi(w.w);
                    sq += (r0 * r0 + r1 * r1) + (r2 * r2 + r3 * r3) + (r4 * r4 + r5 * r5) + (r6 * r6 + r7 * r7);
                }
                sq = swap16_sum(sq, sq); sq = swap32_sum(sq, sq);
                if (fq == 0) ssq[(size_t)row * 16 + u.pn * 4 + wc] = sq;
            }
    }
};
struct EpiMerged {
    static constexpr bool PERM = true, AFTER_DRAIN = false;
    const bf16_t* Pg;
    const float* bg;
    bf16_t* O;
    __device__ __forceinline__ bool keep(const Unit& u) const { return u.pb < 2; }
    __device__ __forceinline__ void operator()(f32x4 (&acc)[2][2][4][2], const Unit& u, int wr, int wc, int fr, int fq) const {
        const int row0 = u.pm * BM + wr * 64 + fr, col0 = u.pn * BM + wc * 32 + 8 * fq, b = u.pb;
        f32x4 bb[2][2], bn[2][2];
#pragma unroll
        for (int bj = 0; bj < 2; ++bj)
#pragma unroll
            for (int n = 0; n < 2; ++n) {
                bb[bj][n] = *(const f32x4*)(bg + b * D + col0 + bj * HALF + 4 * n);
                bn[bj][n] = (b < 2) ? *(const f32x4*)(bg + (b + 1) * D + col0 + bj * HALF + 4 * n) : (f32x4){0.f, 0.f, 0.f, 0.f};
            }
#pragma unroll
        for (int ai = 0; ai < 2; ++ai)
#pragma unroll
            for (int m = 0; m < 4; ++m) {
                const int row = row0 + ai * HALF + m * 16;
#pragma unroll
                for (int bj = 0; bj < 2; ++bj) {
                    const int c = col0 + bj * HALF;
                    const bf16_t* gp = Pg + (size_t)row * INW + b * D + c;
                    const u32x4 zb = *(const u32x4*)gp;
                    u32x4 zn = (u32x4){0u, 0u, 0u, 0u};
                    if (b < 2) zn = *(const u32x4*)(gp + D);
                    float f[8];
#pragma unroll
                    for (int j = 0; j < 8; ++j) {
                        const unsigned wb = zb[j >> 1], wn = zn[j >> 1];
                        const float z0 = ((j & 1) ? bfhi(wb) : bflo(wb)) + bb[bj][j >> 2][j & 3];
                        const float e0 = 1.0f + __expf(-fmaxf(z0, -30.f));
                        float num = 1.0f;
                        if (b < 2) { const float z1 = ((j & 1) ? bfhi(wn) : bflo(wn)) + bn[bj][j >> 2][j & 3]; num = 1.0f + __expf(-fmaxf(z1, -30.f)); }
                        f[j] = num * __builtin_amdgcn_rcpf(e0);
                    }
                    f32x4 v0 = acc[ai][bj][m][0], v1 = acc[ai][bj][m][1];
                    v0[0] *= f[0]; v0[1] *= f[1]; v0[2] *= f[2]; v0[3] *= f[3]; v1[0] *= f[4]; v1[1] *= f[5]; v1[2] *= f[6]; v1[3] *= f[7];
                    acc[ai][bj][m][0] = v0; acc[ai][bj][m][1] = v1;
                    if (b == 2) {
                        u32x4 w; w.x = cvt_pk_bf16(v0[0], v0[1]); w.y = cvt_pk_bf16(v0[2], v0[3]); w.z = cvt_pk_bf16(v1[0], v1[1]); w.w = cvt_pk_bf16(v1[2], v1[3]);
                        *(u32x4*)(O + (size_t)row * D + c) = w;
                    }
                }
            }
    }
};
}

typedef __attribute__((address_space(3))) unsigned char* lds_ptr;
__device__ __forceinline__ void ph_gemm_p(const P& p, int bid, int nb, lds_ptr lds) {
    pg8::Gemm g{(const bf16_t*)(p.ws + WS_HB), (const bf16_t*)(p.ws + WS_WIN), D, 0, 0}; pg8::StaticOrder S; S.init(T, INW, nb, bid);
    pg8::EpiScale E{(bf16_t*)(p.ws + WS_P), INW, (const float*)(p.ws + WS_SSQ), 512, 0.125f * 1.4426950408889634f, (bf16_t*)(p.ws + WS_SBVT)};
    pg8::gemm_phase<pg8::EpiScale, pg8::StaticOrder, true, true>(lds, g, S, E);
}
__device__ __forceinline__ void ph_gemm_kv(const P& p, int bid, int nb, lds_ptr lds) {
    pg8::Gemm g{(const bf16_t*)(p.ws + WS_MEMB), (const bf16_t*)(p.ws + WS_WKV2), D, 0, 0}; pg8::StaticOrder S; S.init(TM, 2 * 2 * D, nb, bid);
    pg8::EpiKV E{(bf16_t*)(p.ws + WS_KV2), (bf16_t*)(p.ws + WS_VT2), (const float*)(p.ws + WS_MEMSSQ)};
    pg8::gemm_phase<pg8::EpiKV, pg8::StaticOrder, true, true>(lds, g, S, E);
}
__device__ __forceinline__ void ph_merged(const P& p, int l, int bid, int nb, lds_ptr lds) {
    pg8::Gemm g{(const bf16_t*)(p.ws + WS_Y), (const bf16_t*)(p.ws + WS_WBR), 512, (size_t)T * 512 * 2, (size_t)1024 * 512 * 2}; pg8::TripleOrder S; S.init(T, D, nb, bid);
    pg8::EpiMerged E{(const bf16_t*)(p.ws + WS_P) + OFF_GATE, p.b_gate + (size_t)l * 3 * D, (bf16_t*)(p.ws + WS_MERGED)};
    pg8::gemm_phase<pg8::EpiMerged, pg8::TripleOrder, true, true>(lds, g, S, E);
}
__device__ __forceinline__ void ph_gemm_wout(const P& p, int bid, int nb, lds_ptr lds) {
    pg8::Gemm g{(const bf16_t*)(p.ws + WS_MERGED), (const bf16_t*)(p.ws + WS_WOUT), D, 0, 0}; pg8::StaticOrder S; S.init(T, D, nb, bid);
    pg8::EpiResidual E{(bf16_t*)(p.ws + WS_HB), (float*)(p.ws + WS_SSQ)};
    pg8::gemm_phase<pg8::EpiResidual, pg8::StaticOrder, true, true>(lds, g, S, E);
}
__device__ __forceinline__ void ph_gemm_xq(const P& p, int bid, int nb, lds_ptr lds) {
    pg8::Gemm g{(const bf16_t*)(p.ws + WS_HB), (const bf16_t*)(p.ws + WS_WXQ), D, 0, 0}; pg8::StaticOrder S; S.init(T, D, nb, bid);
    pg8::EpiScale E{(bf16_t*)(p.ws + WS_XQ), D, (const float*)(p.ws + WS_SSQ), D, 0.0625f, nullptr};
    pg8::gemm_phase<pg8::EpiScale, pg8::StaticOrder, true, true>(lds, g, S, E);
}
__device__ __forceinline__ void ph_gemm_wo(const P& p, int bid, int nb, lds_ptr lds) {
    pg8::Gemm g{(const bf16_t*)(p.ws + WS_XO), (const bf16_t*)(p.ws + WS_WO), D, 0, 0}; pg8::StaticOrder S; S.init(T, D, nb, bid);
    pg8::EpiResidual E{(bf16_t*)(p.ws + WS_HB), (float*)(p.ws + WS_SSQ)};
    pg8::gemm_phase<pg8::EpiResidual, pg8::StaticOrder, true, true>(lds, g, S, E);
}
__device__ __forceinline__ void ph_gemm_pq(const P& p, int bid, int nb, lds_ptr lds) {
    pg8::Gemm g{(const bf16_t*)(p.ws + WS_HB), (const bf16_t*)(p.ws + WS_WPQ), D, 0, 0}; pg8::StaticOrder S; S.init(T, PQW, nb, bid);
    pg8::EpiScale E{(bf16_t*)(p.ws + WS_PQ), PQW, (const float*)(p.ws + WS_SSQ), 0, 1.f, nullptr};
    pg8::gemm_phase<pg8::EpiScale, pg8::StaticOrder, true, true>(lds, g, S, E);
}

typedef float f32x16 __attribute__((ext_vector_type(16)));
typedef __bf16 bf16x2_t __attribute__((ext_vector_type(2)));
typedef float f32x2_t __attribute__((ext_vector_type(2)));
#define MFMA32(a, b, c) __builtin_amdgcn_mfma_f32_32x32x16_bf16((a), (b), (c), 0, 0, 0)
__device__ __forceinline__ unsigned cvtpk(float lo, float hi) { f32x2_t v = {lo, hi}; return __builtin_bit_cast(unsigned, __builtin_convertvector(v, bf16x2_t)); }
__device__ __forceinline__ bf16x8 pack8(const f32x16& x, int s2) {
    u32x4 w; w.x = cvtpk(x[8 * s2], x[8 * s2 + 1]); w.y = cvtpk(x[8 * s2 + 2], x[8 * s2 + 3]); w.z = cvtpk(x[8 * s2 + 4], x[8 * s2 + 5]); w.w = cvtpk(x[8 * s2 + 6], x[8 * s2 + 7]);
    return __builtin_bit_cast(bf16x8, w);
}
__device__ __forceinline__ void ph_sb_attn(const P& p, int bid, int nb, __attribute__((address_space(3))) unsigned char* lds) {
    const int tid = get_tid(), lane = tid & 63, wid = __builtin_amdgcn_readfirstlane(tid >> 6), r = lane & 31, hh = lane >> 5;
    GAS unsigned char* wsg = (GAS unsigned char*)p.ws;
    const GAS bf16_t* PP = (const GAS bf16_t*)(wsg + WS_P); const GAS bf16_t* VT = (const GAS bf16_t*)(wsg + WS_SBVT); GAS bf16_t* Y = (GAS bf16_t*)(wsg + WS_Y);
    bf16x8 uneg[2], oneg;
#pragma unroll
    for (int s2 = 0; s2 < 2; ++s2)
#pragma unroll
        for (int j = 0; j < 8; ++j) { const int k = 16 * s2 + 8 * (j >> 2) + 4 * hh + (j & 3); uneg[s2][j] = (k > r) ? (short)0xBF80 : (short)0; }
#pragma unroll
    for (int j = 0; j < 8; ++j) oneg[j] = (short)0xBF80;
    constexpr int KP = 144, VP = 912, VOFF = 448 * KP;
#pragma unroll 1
    for (int rnd = 0; rnd < 2; ++rnd) {
        if (bid >= 256) break;
        const int bh = bid & 63, b = bh >> 3, h = bh & 7;
        const int Q0 = (((bid >> 6) & 3) * 16 + rnd * 8) * 32, W0 = Q0 >= 192 ? Q0 - 192 : 0, wsz = Q0 + 256 - W0;
        const int qt = (Q0 >> 5) + wid, q0 = qt * 32;
        const GAS bf16_t* prow = PP + (size_t)(b * SEQ) * INW + h * 64 + 8 * hh;
        const GAS bf16_t* vtb = VT + ((size_t)bh * 64 + r) * 2048 + 4 * hh;
        {
            u32x4 rk[7], rv[7];
#pragma unroll
            for (int i = 0; i < 7; ++i) {
                const int c = tid + 512 * i, row = c >> 3, ck = c & 7;
                rk[i] = (u32x4){0u, 0u, 0u, 0u};
                if (row < wsz) rk[i] = *(const GAS u32x4*)(PP + (size_t)(b * SEQ + W0 + row) * INW + 512 + h * 64 + ck * 8);
                const int d = c / 56, cv = c - d * 56;
                rv[i] = (u32x4){0u, 0u, 0u, 0u};
                if (cv * 8 < wsz) rv[i] = *(const GAS u32x4*)(VT + ((size_t)bh * 64 + d) * 2048 + W0 + cv * 8);
            }
#pragma unroll
            for (int i = 0; i < 7; ++i) {
                const int c = tid + 512 * i, row = c >> 3, ck = c & 7, d = c / 56, cv = c - d * 56;
                *(__attribute__((address_space(3))) u32x4*)(lds + row * KP + ck * 16) = rk[i];
                *(__attribute__((address_space(3))) u32x4*)(lds + VOFF + d * VP + cv * 16) = rv[i];
            }
        }
        bf16x8 qf[4];
#pragma unroll
        for (int ks = 0; ks < 4; ++ks) qf[ks] = *(const GAS bf16x8*)(prow + (size_t)(q0 + r) * INW + 16 * ks);
        __syncthreads();
        f32x16 o0, o1, C;
#pragma unroll
        for (int i = 0; i < 16; ++i) { o0[i] = 0.f; o1[i] = 0.f; C[i] = 0.f; }
#pragma unroll 1
        for (int kt = qt; kt >= 0; --kt) {
            const int k0 = kt * 32;
            bf16x8 kf[4]; u32x2 vlo[2][2], vhi[2][2];
            if (k0 >= W0) {
                const __attribute__((address_space(3))) unsigned char* kl = lds + (k0 - W0 + r) * KP + 16 * hh;
#pragma unroll
                for (int ks = 0; ks < 4; ++ks) kf[ks] = *(const __attribute__((address_space(3))) bf16x8*)(kl + 32 * ks);
                const __attribute__((address_space(3))) unsigned char* vl = lds + VOFF + r * VP + (k0 - W0 + 4 * hh) * 2;
#pragma unroll
                for (int dt = 0; dt < 2; ++dt)
#pragma unroll
                    for (int s2 = 0; s2 < 2; ++s2) { vlo[dt][s2] = *(const __attribute__((address_space(3))) u32x2*)(vl + dt * 32 * VP + 32 * s2); vhi[dt][s2] = *(const __attribute__((address_space(3))) u32x2*)(vl + dt * 32 * VP + 32 * s2 + 16); }
            } else {
#pragma unroll
                for (int ks = 0; ks < 4; ++ks) kf[ks] = *(const GAS bf16x8*)(prow + (size_t)(k0 + r) * INW + 512 + 16 * ks);
#pragma unroll
                for (int dt = 0; dt < 2; ++dt)
#pragma unroll
                    for (int s2 = 0; s2 < 2; ++s2) { vlo[dt][s2] = *(const GAS u32x2*)(vtb + (size_t)dt * 32 * 2048 + k0 + 16 * s2); vhi[dt][s2] = *(const GAS u32x2*)(vtb + (size_t)dt * 32 * 2048 + k0 + 16 * s2 + 8); }
            }
            f32x16 z;
#pragma unroll
            for (int i = 0; i < 16; ++i) z[i] = 0.f;
#pragma unroll
            for (int ks = 0; ks < 4; ++ks) z = MFMA32(kf[ks], qf[ks], z);
            f32x16 X, LB;
            const bool diag = (kt == qt);
#pragma unroll
            for (int i = 0; i < 16; ++i) {
                const float zz = z[i];
                const float e = __builtin_amdgcn_exp2f(-fabsf(zz));
                const float sp = fmaxf(zz, 0.f) + __builtin_amdgcn_logf(1.0f + e);
                const bool valid = !diag || (((i & 3) + 8 * (i >> 2) + 4 * hh) < r);
                X[i] = valid ? sp : 0.f;
                LB[i] = valid ? (zz - sp) : -1.0e30f;
            }
            const bf16x8 x0 = pack8(X, 0), x1 = pack8(X, 1);
            f32x16 A = MFMA32(uneg[0], x0, C); A = MFMA32(uneg[1], x1, A);
            f32x16 Cn = MFMA32(oneg, x0, C); Cn = MFMA32(oneg, x1, Cn);
#pragma unroll
            for (int i = 0; i < 16; ++i) A[i] = __builtin_amdgcn_exp2f(LB[i] + A[i]);
            const bf16x8 p0 = pack8(A, 0), p1 = pack8(A, 1);
            { u32x4 a4; a4.x = vlo[0][0].x; a4.y = vlo[0][0].y; a4.z = vhi[0][0].x; a4.w = vhi[0][0].y; o0 = MFMA32(__builtin_bit_cast(bf16x8, a4), p0, o0); }
            { u32x4 a4; a4.x = vlo[0][1].x; a4.y = vlo[0][1].y; a4.z = vhi[0][1].x; a4.w = vhi[0][1].y; o0 = MFMA32(__builtin_bit_cast(bf16x8, a4), p1, o0); }
            { u32x4 a4; a4.x = vlo[1][0].x; a4.y = vlo[1][0].y; a4.z = vhi[1][0].x; a4.w = vhi[1][0].y; o1 = MFMA32(__builtin_bit_cast(bf16x8, a4), p0, o1); }
            { u32x4 a4; a4.x = vlo[1][1].x; a4.y = vlo[1][1].y; a4.z = vhi[1][1].x; a4.w = vhi[1][1].y; o1 = MFMA32(__builtin_bit_cast(bf16x8, a4), p1, o1); }
            C = Cn;
            if (__all(C[0] < -160.f)) break;
        }
        GAS bf16_t* yp = Y + (size_t)(b * SEQ + q0 + r) * 512 + h * 64 + 4 * hh;
#pragma unroll
        for (int g = 0; g < 4; ++g) {
            u32x2 w0; w0.x = cvtpk(o0[4 * g], o0[4 * g + 1]); w0.y = cvtpk(o0[4 * g + 2], o0[4 * g + 3]);
            u32x2 w1; w1.x = cvtpk(o1[4 * g], o1[4 * g + 1]); w1.y = cvtpk(o1[4 * g + 2], o1[4 * g + 3]);
            *(GAS u32x2*)(yp + 8 * g) = w0; *(GAS u32x2*)(yp + 32 + 8 * g) = w1;
        }
        __syncthreads();
    }
}
typedef __attribute__((address_space(3))) float* lds_fptr;
#define LASX __attribute__((address_space(3)))
__device__ __forceinline__ void ph_conv(const P& p, int l, int bid, int nb, LASX unsigned char* lds) {
    const int tid0 = get_tid(), wid = __builtin_amdgcn_readfirstlane(tid0 >> 6);
    GAS unsigned char* wsg = (GAS unsigned char*)p.ws;
    const GAS bf16_t* PP = (const GAS bf16_t*)(wsg + WS_P); GAS bf16_t* Y = (GAS bf16_t*)(wsg + WS_Y);
    const GAS float* dw = (const GAS float*)p.conv_dw_w + (size_t)l * 31 * 512; const GAS float* scw = (const GAS float*)p.sc_w + (size_t)l * 3 * 512;
    float w[31];
#pragma unroll
    for (int j = 0; j < 31; ++j) w[j] = dw[j * 512 + tid0];
    const float w0 = scw[tid0], w1 = scw[512 + tid0], w2 = scw[1024 + tid0];
    const float db = ((const GAS float*)p.conv_dw_b)[l * 512 + tid0], lg = ((const GAS float*)p.conv_ln_g)[l * 512 + tid0], lb = ((const GAS float*)p.conv_ln_b)[l * 512 + tid0];
    const LASX float* stat = (const LASX float*)(lds + 131072);
    LASX float* statw = (LASX float*)(lds + 131072);
#pragma unroll 1
    for (int it = bid; it < T / 32; it += nb) {
        const int tile = (nb == 256) ? ((it & 7) * 64 + ((it >> 3) & 31) + 32 * (it >> 8)) : it;
        const int tok0 = tile * 32, t0 = tok0 & (SEQ - 1);
        int tid = tid0; asm volatile("" : "+v"(tid));
        const int c = tid, lane = tid & 63;
        const GAS bf16_t* tb = PP + (size_t)tok0 * INW;
        {
            u32x4 r[16];
#pragma unroll
            for (int i = 0; i < 16; ++i) {
                const int ch = tid + 512 * i, row = ch >> 7, c16 = ch & 127; const bool ok = (t0 + row - 30 >= 0);
                r[i] = (u32x4){0u, 0u, 0u, 0u};
                if (i < 15 || ch < 62 * 128) { const u32x4 v = *(const GAS u32x4*)(tb + (ptrdiff_t)(ok ? row - 30 : 0) * INW + OFF_CV + c16 * 8); r[i] = ok ? v : (u32x4){0u, 0u, 0u, 0u}; }
            }
#pragma unroll
            for (int i = 0; i < 16; ++i) { const int ch = tid + 512 * i; if (i < 15 || ch < 62 * 128) *(LASX u32x4*)(lds + (ch >> 7) * 2048 + (ch & 127) * 16) = r[i]; }
        }
        __syncthreads();
        float o32[32];
        {
            float u[62];
#pragma unroll
            for (int i = 0; i < 62; ++i) {
                const float val = bf2f(*(const LASX bf16_t*)(lds + i * 2048 + c * 2)), gt = bf2f(*(const LASX bf16_t*)(lds + i * 2048 + 1024 + c * 2));
                u[i] = val * __builtin_amdgcn_rcpf(1.0f + __expf(-gt));
            }
#pragma unroll
            for (int i = 0; i < 32; ++i) {
                float acc = db;
#pragma unroll
                for (int j = 0; j < 31; ++j) asm("v_fmac_f32 %0, %1, %2" : "+v"(acc) : "v"(w[j]), "v"(u[i + j]));
                o32[i] = acc;
            }
        }
        {
            const bool h8 = (lane & 8) != 0, h4 = (lane & 4) != 0, h2 = (lane & 2) != 0, h1 = (lane & 1) != 0;
#pragma unroll
            for (int st = 0; st < 2; ++st) {
                float v[32];
#pragma unroll
                for (int i = 0; i < 32; ++i) { const float x = st ? o32[i] * o32[i] : o32[i]; v[i] = swap32_sum(x, x); }
#pragma unroll
                for (int i = 0; i < 16; ++i) v[i] = swap16_sum(v[i], v[i + 16]);
#pragma unroll
                for (int i = 0; i < 8; ++i) v[i] = (h8 ? v[i + 8] : v[i]) + dppf<0x128>(h8 ? v[i] : v[i + 8]);
#pragma unroll
                for (int i = 0; i < 4; ++i) v[i] = (h4 ? v[i + 4] : v[i]) + dppf<0x141>(dppf<0x1B>(h4 ? v[i] : v[i + 4]));
#pragma unroll
                for (int i = 0; i < 2; ++i) v[i] = (h2 ? v[i + 2] : v[i]) + dppf<0x4E>(h2 ? v[i] : v[i + 2]);
                v[0] = (h1 ? v[1] : v[0]) + dppf<0xB1>(h1 ? v[0] : v[1]);
                if (lane < 32) statw[st * 256 + wid * 32 + lane] = v[0];
            }
        }
        __syncthreads();
        if (tid < 64) { float t = 0.f; const int st = tid >> 5, tk = tid & 31;
#pragma unroll
            for (int k = 0; k < 8; ++k) t += stat[st * 256 + k * 32 + tk];
            statw[512 + tid] = t; }
        {
            u32x4 r[13];
#pragma unroll
            for (int i = 0; i < 13; ++i) {
                const int ch = tid + 512 * i;
                r[i] = (u32x4){0u, 0u, 0u, 0u};
                if (i < 8 || ch < 34 * 128) { const int row = ch >> 7, c16 = ch & 127; const bool ok = (t0 + row - 2 >= 0);
                    const u32x4 v = *(const GAS u32x4*)(tb + (ptrdiff_t)(ok ? row - 2 : 0) * INW + OFF_SC + 512 + c16 * 8); r[i] = ok ? v : (u32x4){0u, 0u, 0u, 0u}; }
                else if (ch < 34 * 128 + 32 * 64) { const int c2 = ch - 34 * 128; r[i] = *(const GAS u32x4*)(tb + (size_t)(c2 >> 6) * INW + OFF_SC + (c2 & 63) * 8); }
            }
#pragma unroll
            for (int i = 0; i < 13; ++i) {
                const int ch = tid + 512 * i;
                if (i < 8 || ch < 34 * 128) *(LASX u32x4*)(lds + (ch >> 7) * 2048 + (ch & 127) * 16) = r[i];
                else if (ch < 34 * 128 + 32 * 64) { const int c2 = ch - 34 * 128; *(LASX u32x4*)(lds + 69632 + (c2 >> 6) * 1024 + (c2 & 63) * 16) = r[i]; }
            }
        }
        __syncthreads();
        GAS bf16_t* ycv = Y + (size_t)T * 512 + (size_t)tok0 * 512;
#pragma unroll
        for (int i = 0; i < 32; ++i) {
            const float mean = stat[512 + i] * (1.0f / 512.0f), var = fmaxf(stat[512 + 32 + i] * (1.0f / 512.0f) - mean * mean, 0.f);
            const float yv = (o32[i] - mean) * rsqrtf(var + 1e-5f) * lg + lb;
            GAS bf16_t* yr = ycv + i * 512; asm volatile("" : "+s"(yr));
            yr[c] = (bf16_t)f2bf(yv * __builtin_amdgcn_rcpf(1.0f + __expf(-yv)));
        }
        {
            float gx[34];
#pragma unroll
            for (int i = 0; i < 34; ++i) gx[i] = bf2f(*(const LASX bf16_t*)(lds + i * 2048 + c * 2)) * bf2f(*(const LASX bf16_t*)(lds + i * 2048 + 1024 + c * 2));
            GAS bf16_t* ysc = Y + (size_t)2 * T * 512 + (size_t)tok0 * 512;
#pragma unroll
            for (int i = 0; i < 32; ++i) {
                const float sc = fmaf(w2, gx[i + 2], fmaf(w1, gx[i + 1], w0 * gx[i]));
                GAS bf16_t* yr = ysc + i * 512; asm volatile("" : "+s"(yr));
                yr[c] = (bf16_t)f2bf(bf2f(*(const LASX bf16_t*)(lds + 69632 + i * 1024 + c * 2)) * sc);
            }
        }
        __syncthreads();
    }
}

#define MFMA16(a, b, c) __builtin_amdgcn_mfma_f32_16x16x32_bf16((a), (b), (c), 0, 0, 0)
#define XA_PITCH 528
#define XA_LOAD(regs, src, pitch) do { _Pragma("unroll") for (int i_ = 0; i_ < 16; ++i_) { const int ch_ = tid + 512 * i_; regs[i_] = *(const GAS u32x4*)((const GAS char*)(src) + (size_t)(ch_ >> 5) * (pitch) + (ch_ & 31) * 16); } } while (0)
#define XA_STORE(regs) do { _Pragma("unroll") for (int i_ = 0; i_ < 16; ++i_) { const int ch_ = tid + 512 * i_; *(LASX u32x4*)(lds + (ch_ >> 5) * XA_PITCH + (ch_ & 31) * 16) = regs[i_]; } } while (0)
__device__ __forceinline__ void ph_xattn(const P& p, int l, int bid, int nb, LASX unsigned char* lds) {
    const int tid = get_tid(), lane = tid & 63, wid = __builtin_amdgcn_readfirstlane(tid >> 6), fr = lane & 15, fq = lane >> 4;
    GAS unsigned char* wsg = (GAS unsigned char*)p.ws;
    const GAS bf16_t* XQ = (const GAS bf16_t*)(wsg + WS_XQ); const GAS bf16_t* KV = (const GAS bf16_t*)(wsg + WS_KV2) + (size_t)l * TM * 2048; const GAS bf16_t* VT = (const GAS bf16_t*)(wsg + WS_VT2) + (size_t)l * (8 * 4 * 256 * 256);
    GAS bf16_t* XO = (GAS bf16_t*)(wsg + WS_XO);
    constexpr int NU = BATCH * 4 * 16;
    u32x4 st[16];
    if (bid < NU) { const int b = bid >> 6, hd = (bid >> 4) & 3; XA_LOAD(st, KV + (size_t)(b * NMEM) * 2048 + hd * 256, 4096); }
#pragma unroll 1
    for (int unit = bid; unit < NU; unit += nb) {
        const int b = unit >> 6, hd = (unit >> 4) & 3, qt = unit & 15;
        const int tok0 = b * SEQ + qt * 128 + wid * 16;
        XA_STORE(st);
        bf16x8 qf[8];
        { const GAS bf16_t* qp = XQ + (size_t)(tok0 + fr) * D + hd * 256 + fq * 8;
#pragma unroll
          for (int ks = 0; ks < 8; ++ks) qf[ks] = *(const GAS bf16x8*)(qp + ks * 32); }
        __syncthreads();
        f32x4 sacc[16];
        const LASX unsigned char* kl = lds + fr * XA_PITCH + fq * 16;
#pragma unroll
        for (int t = 0; t < 16; ++t) {
            f32x4 acc = (f32x4){0.f, 0.f, 0.f, 0.f};
#pragma unroll
            for (int ks = 0; ks < 8; ++ks) { const bf16x8 kf = *(const LASX bf16x8*)(kl + t * 16 * XA_PITCH + ks * 64); acc = MFMA16(kf, qf[ks], acc); }
            sacc[t] = acc;
        }
        XA_LOAD(st, VT + (size_t)(b * 4 + hd) * 256 * 256, 512);
        float mx = -3.0e38f;
#pragma unroll
        for (int t = 0; t < 16; ++t) mx = fmaxf(fmaxf(fmaxf(sacc[t][0], sacc[t][1]), fmaxf(sacc[t][2], sacc[t][3])), mx);
        { auto r = __builtin_amdgcn_permlane16_swap(__float_as_uint(mx), __float_as_uint(mx), false, false); mx = fmaxf(__uint_as_float(r[0]), __uint_as_float(r[1])); }
        { auto r = __builtin_amdgcn_permlane32_swap(__float_as_uint(mx), __float_as_uint(mx), false, false); mx = fmaxf(__uint_as_float(r[0]), __uint_as_float(r[1])); }
        float sum = 0.f;
#pragma unroll
        for (int t = 0; t < 16; ++t) {
#pragma unroll
            for (int r = 0; r < 4; ++r) { const float e = __expf(sacc[t][r] - mx); sacc[t][r] = e; sum += e; }
        }
        sum = swap16_sum(sum, sum); sum = swap32_sum(sum, sum);
        const float inv = 1.0f / sum;
        bf16x8 pf[8];
#pragma unroll
        for (int s2 = 0; s2 < 8; ++s2) {
            u32x4 w; w.x = cvtpk(sacc[2 * s2][0], sacc[2 * s2][1]); w.y = cvtpk(sacc[2 * s2][2], sacc[2 * s2][3]);
            w.z = cvtpk(sacc[2 * s2 + 1][0], sacc[2 * s2 + 1][1]); w.w = cvtpk(sacc[2 * s2 + 1][2], sacc[2 * s2 + 1][3]);
            pf[s2] = __builtin_bit_cast(bf16x8, w);
        }
        __syncthreads();
        XA_STORE(st);
        __syncthreads();
        if (unit + nb < NU) { const int u2 = unit + nb, b2 = u2 >> 6, hd2 = (u2 >> 4) & 3; XA_LOAD(st, KV + (size_t)(b2 * NMEM) * 2048 + hd2 * 256, 4096); }
        const LASX unsigned char* vl = lds + fr * XA_PITCH + fq * 8;
        GAS bf16_t* op = XO + (size_t)(tok0 + fr) * D + hd * 256 + 4 * fq;
#pragma unroll 2
        for (int dt = 0; dt < 16; ++dt) {
            f32x4 acc = (f32x4){0.f, 0.f, 0.f, 0.f};
#pragma unroll
            for (int s2 = 0; s2 < 8; ++s2) {
                const u32x2 lo = *(const LASX u32x2*)(vl + dt * 16 * XA_PITCH + 64 * s2), hi = *(const LASX u32x2*)(vl + dt * 16 * XA_PITCH + 64 * s2 + 32);
                u32x4 a4; a4.x = lo.x; a4.y = lo.y; a4.z = hi.x; a4.w = hi.y;
                acc = MFMA16(__builtin_bit_cast(bf16x8, a4), pf[s2], acc);
            }
            u32x2 w; w.x = cvtpk(acc[0] * inv, acc[1] * inv); w.y = cvtpk(acc[2] * inv, acc[3] * inv);
            *(GAS u32x2*)(op + dt * 16) = w;
        }
        __syncthreads();
    }
}

typedef __attribute__((address_space(3))) int* lds_iptr;
#define TK_CE(a, b) do { const float hi_ = __builtin_fmaxf(a, b); b = __builtin_fminf(a, b); a = hi_; } while (0)
__device__ __forceinline__ void tk_sort16(float (&a)[16]) {
#pragma unroll
    for (int k = 2; k <= 16; k <<= 1)
#pragma unroll
        for (int j = k >> 1; j > 0; j >>= 1)
#pragma unroll
            for (int i = 0; i < 16; ++i) { const int l = i ^ j; if (l > i) { if ((i & k) == 0) TK_CE(a[i], a[l]); else TK_CE(a[l], a[i]); } }
}
__device__ __forceinline__ void tk_merge16(float (&L)[16], const float (&G)[16]) {
#pragma unroll
    for (int i = 0; i < 16; ++i) L[i] = __builtin_fmaxf(L[i], G[15 - i]);
#pragma unroll
    for (int j = 8; j > 0; j >>= 1)
#pragma unroll
        for (int i = 0; i < 16; ++i) { const int l = i ^ j; if (l > i) TK_CE(L[i], L[l]); }
}
__device__ __forceinline__ void ph_peer_score(const P& p, int bid, int nb, lds_fptr ldsf) {
    const int tid = get_tid(), lane = tid & 63, wid = __builtin_amdgcn_readfirstlane(tid >> 6), fr = lane & 15, fq = lane >> 4;
    GAS unsigned char* wsg = (GAS unsigned char*)p.ws;
    const GAS bf16_t* PQ = (const GAS bf16_t*)(wsg + WS_PQ); const GAS bf16_t* KEYS = (const GAS bf16_t*)(wsg + WS_KEYS);
    GAS int* PIDX = (GAS int*)(wsg + WS_PIDX); GAS float* PG = (GAS float*)(wsg + WS_PG);
    const lds_fptr sc = ldsf + wid * (64 * 68);
    const int gw = bid * 8 + wid, ngw = nb * 8;
#pragma unroll 1
    for (int task = gw; task < (T / 64) * 8; task += ngw) {
        const int tok0 = (task >> 3) * 64, h = task & 7;
        float L1[16], L2[16];
#pragma unroll
        for (int i = 0; i < 16; ++i) { L1[i] = -3.0e38f; L2[i] = -3.0e38f; }
        bf16x8 qf[4][4], kfa[4][4];
#define PS_LOADQ(pp_) do { _Pragma("unroll") for (int mt_ = 0; mt_ < 4; ++mt_) _Pragma("unroll") for (int ks_ = 0; ks_ < 4; ++ks_) \
            qf[mt_][ks_] = *(const GAS bf16x8*)(PQ + (size_t)(tok0 + 16 * mt_ + fr) * PQW + h * 256 + (pp_) * 128 + 32 * ks_ + 8 * fq); } while (0)
#define PS_LOADK(it_) do { const GAS bf16_t* kp_ = KEYS + ((size_t)h * 256 + (it_) * 64 + fr) * 128 + 8 * fq; _Pragma("unroll") for (int nt_ = 0; nt_ < 4; ++nt_) _Pragma("unroll") for (int ks_ = 0; ks_ < 4; ++ks_) \
            kfa[nt_][ks_] = *(const GAS bf16x8*)(kp_ + (size_t)nt_ * 16 * 128 + 32 * ks_); } while (0)
        PS_LOADQ(0); PS_LOADK(0);
        float Lr[16];
#pragma unroll
        for (int i = 0; i < 16; ++i) Lr[i] = -3.0e38f;
#pragma unroll 1
        for (int it = 0; it < 4; ++it) {
            const int half = it & 1;
#pragma unroll
            for (int nt = 0; nt < 4; ++nt) {
#pragma unroll
                for (int mt = 0; mt < 4; ++mt) {
                    f32x4 acc = (f32x4){0.f, 0.f, 0.f, 0.f};
#pragma unroll
                    for (int ks = 0; ks < 4; ++ks) acc = MFMA16(kfa[nt][ks], qf[mt][ks], acc);
                    *(__attribute__((address_space(3))) f32x4*)(sc + (16 * mt + fr) * 68 + 16 * nt + 4 * fq) = acc;
                }
            }
            __builtin_amdgcn_sched_barrier(0);
            if (it == 1) PS_LOADQ(1);
            if (it < 3) PS_LOADK(it + 1);
            __builtin_amdgcn_sched_barrier(0);
#pragma unroll
            for (int grp = 0; grp < 4; ++grp) {
                float G[16];
#pragma unroll
                for (int k4 = 0; k4 < 4; ++k4) {
                    const f32x4 v = *(const __attribute__((address_space(3))) f32x4*)(sc + lane * 68 + 16 * grp + 4 * k4);
#pragma unroll
                    for (int r = 0; r < 4; ++r) G[4 * k4 + r] = __uint_as_float((__float_as_uint(v[r]) & 0xffffff80u) | (unsigned)(half * 64 + 16 * grp + 4 * k4 + r));
                }
                tk_sort16(G);
                tk_merge16(Lr, G);
            }
            if (it == 1) {
#pragma unroll
                for (int i = 0; i < 16; ++i) { L1[i] = Lr[i]; Lr[i] = -3.0e38f; }
            }
        }
#pragma unroll
        for (int i = 0; i < 16; ++i) L2[i] = Lr[i];
#undef PS_LOADQ
#undef PS_LOADK
        const lds_iptr li = (lds_iptr)sc + lane * 33;
#pragma unroll
        for (int i = 0; i < 16; ++i) { li[i] = (int)(__float_as_uint(L1[i]) & 127u); li[16 + i] = (int)(__float_as_uint(L2[i]) & 127u); }
        float C[16];
        {
            float G[4][16];
#pragma unroll
            for (int a = 0; a < 4; ++a)
#pragma unroll
                for (int i = 0; i < 16; ++i) G[a][i] = -3.0e38f;
            int cnt = 0;
#pragma unroll
            for (int i = 0; i < 16; ++i)
#pragma unroll
                for (int j = 0; j < 16; ++j)
                    if ((i + 1) * (j + 1) <= 16) { const float sm = L1[i] + L2[j]; G[cnt >> 4][cnt & 15] = __uint_as_float((__float_as_uint(sm) & 0xffffff00u) | (unsigned)(i * 16 + j)); ++cnt; }
            tk_sort16(G[0]); tk_sort16(G[1]); tk_sort16(G[2]); tk_sort16(G[3]);
            tk_merge16(G[0], G[1]); tk_merge16(G[2], G[3]); tk_merge16(G[0], G[2]);
#pragma unroll
            for (int i = 0; i < 16; ++i) C[i] = G[0][i];
        }
        float e[16], es = 0.f;
#pragma unroll
        for (int k = 0; k < 16; ++k) { e[k] = __expf(C[k] - C[0]); es += e[k]; }
        const float inv = 1.0f / es;
        int ex[16];
#pragma unroll
        for (int k = 0; k < 16; ++k) { const unsigned ci = __float_as_uint(C[k]) & 255u; ex[k] = li[ci >> 4] * 128 + li[16 + (ci & 15)]; }
        GAS int* pi = PIDX + (size_t)(tok0 + lane) * 128 + h * 16; GAS float* pgp = PG + (size_t)(tok0 + lane) * 128 + h * 16;
#pragma unroll
        for (int k4 = 0; k4 < 4; ++k4) {
            typedef int i32x4 __attribute__((ext_vector_type(4)));
            i32x4 iv; iv.x = ex[4 * k4]; iv.y = ex[4 * k4 + 1]; iv.z = ex[4 * k4 + 2]; iv.w = ex[4 * k4 + 3];
            f32x4 gv; gv.x = e[4 * k4] * inv; gv.y = e[4 * k4 + 1] * inv; gv.z = e[4 * k4 + 2] * inv; gv.w = e[4 * k4 + 3] * inv;
            *(GAS i32x4*)(pi + 4 * k4) = iv; *(GAS f32x4*)(pgp + 4 * k4) = gv;
        }
    }
}
#define PG_CVT(f, q) do { const f32x2_t a_ = __builtin_amdgcn_cvt_pk_f32_fp8((int)(q).x, false), b_ = __builtin_amdgcn_cvt_pk_f32_fp8((int)(q).x, true), c_ = __builtin_amdgcn_cvt_pk_f32_fp8((int)(q).y, false), d_ = __builtin_amdgcn_cvt_pk_f32_fp8((int)(q).y, true), \
        e_ = __builtin_amdgcn_cvt_pk_f32_fp8((int)(q).z, false), f_ = __builtin_amdgcn_cvt_pk_f32_fp8((int)(q).z, true), g_ = __builtin_amdgcn_cvt_pk_f32_fp8((int)(q).w, false), h_ = __builtin_amdgcn_cvt_pk_f32_fp8((int)(q).w, true); \
        f[0] = a_[0]; f[1] = a_[1]; f[2] = b_[0]; f[3] = b_[1]; f[4] = c_[0]; f[5] = c_[1]; f[6] = d_[0]; f[7] = d_[1]; f[8] = e_[0]; f[9] = e_[1]; f[10] = f_[0]; f[11] = f_[1]; f[12] = g_[0]; f[13] = g_[1]; f[14] = h_[0]; f[15] = h_[1]; } while (0)
#define U2_ISSUE(buf, slot) do { _Pragma("unroll") for (int i_ = 0; i_ < 16; ++i_) { const unsigned e_ = *(const LASX unsigned*)(tab + (slot) * 512 + ((i_ & 7) * 8 + 64 * (i_ >> 3)) * 4 + g * 4); \
        buf[i_] = *(const GAS u32x4*)(Ux + (size_t)e_ * 1024u); } } while (0)
#define U2_TAB(slot, ilo, ihi) do { *(LASX unsigned*)(tab + (slot) * 512 + lane * 4) = (unsigned)(ilo); *(LASX unsigned*)(tab + (slot) * 512 + 256 + lane * 4) = (unsigned)(ihi); } while (0)
#define U2_DOT(buf, xs, rlo, rhi) do { _Pragma("unroll") for (int i_ = 0; i_ < 16; ++i_) { float f_v[16]; PG_CVT(f_v, buf[i_]); float d0_ = f_v[0] * xs[0], d1_ = f_v[1] * xs[1]; \
        _Pragma("unroll") for (int k_ = 2; k_ < 16; k_ += 2) { asm("v_fmac_f32 %0, %1, %2" : "+v"(d0_) : "v"(f_v[k_]), "v"(xs[k_])); asm("v_fmac_f32 %0, %1, %2" : "+v"(d1_) : "v"(f_v[k_ + 1]), "v"(xs[k_ + 1])); } \
        float d_ = d0_ + d1_; d_ += dppf<0xB1>(d_); d_ += dppf<0x4E>(d_); d_ += dppf<0x141>(d_);        \
        if (i_ < 8) rlo = (j == (i_ & 7)) ? d_ : rlo; else rhi = (j == (i_ & 7)) ? d_ : rhi; } } while (0)
#define U2_XS(xs, w0, w1) do { xs[0] = bflo(w0.x); xs[1] = bfhi(w0.x); xs[2] = bflo(w0.y); xs[3] = bfhi(w0.y); xs[4] = bflo(w0.z); xs[5] = bfhi(w0.z); xs[6] = bflo(w0.w); xs[7] = bfhi(w0.w); \
        xs[8] = bflo(w1.x); xs[9] = bfhi(w1.x); xs[10] = bflo(w1.y); xs[11] = bfhi(w1.y); xs[12] = bflo(w1.z); xs[13] = bfhi(w1.z); xs[14] = bflo(w1.w); xs[15] = bfhi(w1.w); } while (0)
#define U2_META(ilo, ihi, x0, x1, t_) do { const size_t o_ = (size_t)(t_) * 128 + lane; ilo = PIDX[o_]; ihi = PIDX[o_ + 64]; const GAS u32x4* xr_ = (const GAS u32x4*)(HB + (size_t)(t_) * D + x * 128 + j * 16); x0 = xr_[0]; x1 = xr_[1]; } while (0)
#define U2_STORE(t_, rlo, rhi) do { GAS float* pd_ = PD + ((size_t)x * T + (t_)) * 128 + 8 * j + g; pd_[0] = rlo; pd_[64] = rhi; } while (0)
__device__ __forceinline__ void ph_peer_u2(const P& p, int bid, int nb, LASX unsigned char* ldsb) {
    const int tid = get_tid(), lane = tid & 63, wid = __builtin_amdgcn_readfirstlane(tid >> 6), g = lane >> 3, j = lane & 7;
    GAS unsigned char* wsg = (GAS unsigned char*)p.ws;
    const int x = bid & 7, nsl = nb >> 3;
    const GAS unsigned char* Ux = (const GAS unsigned char*)(wsg + WS_U) + x * 128 + j * 16;
    const GAS int* PIDX = (const GAS int*)(wsg + WS_PIDX); const GAS bf16_t* HB = (const GAS bf16_t*)(wsg + WS_HB); GAS float* PD = (GAS float*)(wsg + WS_PD);
    const int wv = (bid >> 3) * 8 + wid, nwv = nsl * 8;
    LASX unsigned char* tab = ldsb + wid * 1024;
    int iloA, ihiA, iloB, ihiB; u32x4 xA0, xA1, xB0, xB1;
    u32x4 bA[16], bB[16];
    const int t0 = wv;
    if (t0 < T) { U2_META(iloA, ihiA, xA0, xA1, t0); U2_TAB(0, iloA, ihiA); U2_ISSUE(bA, 0); }
    if (t0 + nwv < T) U2_META(iloB, ihiB, xB0, xB1, t0 + nwv);
#pragma unroll 1
    for (int t = t0; t < T; t += 2 * nwv) {
        const int t1 = t + nwv, t2 = t + 2 * nwv, t3 = t + 3 * nwv;
        if (t1 < T) { U2_TAB(1, iloB, ihiB); U2_ISSUE(bB, 1); }
        { float xs[16]; U2_XS(xs, xA0, xA1); float rlo = 0.f, rhi = 0.f; U2_DOT(bA, xs, rlo, rhi); U2_STORE(t, rlo, rhi); }
        if (t2 < T) U2_META(iloA, ihiA, xA0, xA1, t2);
        if (t1 < T) {
            if (t2 < T) { U2_TAB(0, iloA, ihiA); U2_ISSUE(bA, 0); }
            { float xs[16]; U2_XS(xs, xB0, xB1); float rlo = 0.f, rhi = 0.f; U2_DOT(bB, xs, rlo, rhi); U2_STORE(t1, rlo, rhi); }
            if (t3 < T) U2_META(iloB, ihiB, xB0, xB1, t3);
        }
    }
}
__device__ __forceinline__ void ph_peer_w(const P& p, int bid, int nb) {
    const int tid = get_tid(), lane = tid & 63, wid = __builtin_amdgcn_readfirstlane(tid >> 6);
    GAS unsigned char* wsg = (GAS unsigned char*)p.ws;
    const GAS float* SSQ = (const GAS float*)(wsg + WS_SSQ); const GAS float* USC = (const GAS float*)(wsg + WS_USC); const GAS float* VSC = (const GAS float*)(wsg + WS_VSC);
    const GAS int* PIDX = (const GAS int*)(wsg + WS_PIDX); GAS float* PG = (GAS float*)(wsg + WS_PG); const GAS float* PD = (const GAS float*)(wsg + WS_PD);
#pragma unroll 2
    for (int tok = bid * 8 + wid; tok < T; tok += nb * 8) {
        const size_t o = (size_t)tok * 128 + lane;
        const int idx_lo = PIDX[o], idx_hi = PIDX[o + 64];
        float a0 = 0.f, a1 = 0.f;
#pragma unroll
        for (int xs = 0; xs < 8; ++xs) { a0 += PD[(size_t)xs * T * 128 + o]; a1 += PD[(size_t)xs * T * 128 + o + 64]; }
        const float g_lo = PG[o], g_hi = PG[o + 64];
        const float us_lo = USC[idx_lo], us_hi = USC[idx_hi], vs_lo = VSC[idx_lo], vs_hi = VSC[idx_hi];
        const float rs = rsqrtf(wave_sum2(lane < 16 ? SSQ[(size_t)tok * 16 + lane] : 0.f) * (1.0f / D) + 1e-6f);
        a0 *= us_lo * rs; a1 *= us_hi * rs;
        PG[o] = g_lo * vs_lo * 0.5f * a0 * (1.0f + erff(a0 * 0.70710678118654752f));
        PG[o + 64] = g_hi * vs_hi * 0.5f * a1 * (1.0f + erff(a1 * 0.70710678118654752f));
    }
}
#define V2_META(ilo, ihi, wlo, whi, hw, t_) do { const size_t o_ = (size_t)(t_) * 128 + lane; ilo = PIDX[o_]; ihi = PIDX[o_ + 64]; wlo = PW[o_]; whi = PW[o_ + 64]; hw = *(const GAS unsigned*)(HBW + (size_t)(t_) * D + col); } while (0)
#define V2_TAB(slot, ilo, ihi, wlo, whi) do { *(LASX u32x2*)(tab + (slot) * 1024 + lane * 8) = (u32x2){(unsigned)(ilo), __float_as_uint(wlo)}; *(LASX u32x2*)(tab + (slot) * 1024 + 512 + lane * 8) = (u32x2){(unsigned)(ihi), __float_as_uint(whi)}; } while (0)
#define V2_ISSUE(buf, slot) do { _Pragma("unroll") for (int i_ = 0; i_ < 16; ++i_) { const unsigned e_ = *(const LASX unsigned*)(tab + (slot) * 1024 + ((i_ & 7) * 8 + 64 * (i_ >> 3)) * 8 + g * 8); \
        buf[i_] = *(const GAS u32x4*)(Vx + (size_t)e_ * 1024u); } } while (0)
#define V2_ACC(buf, slot) do { _Pragma("unroll") for (int i_ = 0; i_ < 16; ++i_) { const float w_ = *(const LASX float*)(tab + (slot) * 1024 + ((i_ & 7) * 8 + 64 * (i_ >> 3)) * 8 + g * 8 + 4); \
        float f_v[16]; PG_CVT(f_v, buf[i_]); _Pragma("unroll") for (int k_ = 0; k_ < 16; ++k_) asm("v_fmac_f32 %0, %1, %2" : "+v"(o[k_]) : "v"(w_), "v"(f_v[k_])); } } while (0)
#define V2_FINISH(t_, hwreg) do { float r8_[8], r4_[4]; \
        _Pragma("unroll") for (int i_ = 0; i_ < 8; ++i_) r8_[i_] = swap32_sum(o[i_], o[i_ + 8]); \
        _Pragma("unroll") for (int i_ = 0; i_ < 4; ++i_) r4_[i_] = swap16_sum(r8_[i_], r8_[i_ + 4]); \
        const float c0_ = (h8 ? r4_[2] : r4_[0]) + dppf<0x128>(h8 ? r4_[0] : r4_[2]), c1_ = (h8 ? r4_[3] : r4_[1]) + dppf<0x128>(h8 ? r4_[1] : r4_[3]); \
        GAS unsigned* hp_ = (GAS unsigned*)(HBW + (size_t)(t_) * D + col); const unsigned hw_ = (hwreg); const unsigned nw_ = pk2(bflo(hw_) + c0_, bfhi(hw_) + c1_); *hp_ = nw_; \
        const float n0_ = bflo(nw_), n1_ = bfhi(nw_); \
        const float ss_ = wave_sum2(n0_ * n0_ + n1_ * n1_); if (lane < 2) SSQW[(size_t)(t_) * 16 + x + 8 * lane] = lane == 0 ? ss_ : 0.f; \
        _Pragma("unroll") for (int i_ = 0; i_ < 16; ++i_) o[i_] = 0.f; } while (0)
__device__ __forceinline__ void ph_peer_v(const P& p, int bid, int nb, LASX unsigned char* ldsb) {
    const int tid = get_tid(), lane = tid & 63, wid = __builtin_amdgcn_readfirstlane(tid >> 6), g = lane >> 3, j = lane & 7;
    GAS unsigned char* wsg = (GAS unsigned char*)p.ws;
    const int x = bid & 7, nsl = nb >> 3;
    const GAS unsigned char* Vx = (const GAS unsigned char*)(wsg + WS_V) + x * 128 + j * 16;
    const GAS int* PIDX = (const GAS int*)(wsg + WS_PIDX); const GAS float* PW = (const GAS float*)(wsg + WS_PG);
    GAS bf16_t* HBW = (GAS bf16_t*)(wsg + WS_HB); GAS float* SSQW = (GAS float*)(wsg + WS_SSQ);
    const bool h32 = (lane & 32) != 0, h16 = (lane & 16) != 0, h8 = (lane & 8) != 0;
    const int col = x * 128 + j * 16 + (h32 ? 8 : 0) + (h16 ? 4 : 0) + (h8 ? 2 : 0);
    const int wv = (bid >> 3) * 8 + wid, nwv = nsl * 8;
    LASX unsigned char* tab = ldsb + wid * 2048;
    float o[16];
#pragma unroll
    for (int i = 0; i < 16; ++i) o[i] = 0.f;
    int iloA, ihiA, iloB, ihiB; float wloA, whiA, wloB, whiB; unsigned hwA = 0u, hwB = 0u, hwC = 0u;
    u32x4 bA[16], bB[16];
    const int t0 = wv;
    if (t0 < T) { V2_META(iloA, ihiA, wloA, whiA, hwA, t0); V2_TAB(0, iloA, ihiA, wloA, whiA); V2_ISSUE(bA, 0); }
    if (t0 + nwv < T) V2_META(iloB, ihiB, wloB, whiB, hwB, t0 + nwv);
#pragma unroll 1
    for (int t = t0; t < T; t += 2 * nwv) {
        const int t1 = t + nwv, t2 = t + 2 * nwv, t3 = t + 3 * nwv;
        if (t1 < T) { V2_TAB(1, iloB, ihiB, wloB, whiB); V2_ISSUE(bB, 1); }
        V2_ACC(bA, 0);
        hwC = hwA;
        if (t2 < T) V2_META(iloA, ihiA, wloA, whiA, hwA, t2);
        V2_FINISH(t, hwC);
        if (t1 < T) {
            if (t2 < T) { V2_TAB(0, iloA, ihiA, wloA, whiA); V2_ISSUE(bA, 0); }
            V2_ACC(bB, 1);
            hwC = hwB;
            if (t3 < T) V2_META(iloB, ihiB, wloB, whiB, hwB, t3);
            V2_FINISH(t1, hwC);
        }
    }
}
__device__ __forceinline__ void ph_final_norm(const P& p, int bid, int nb) {
    const int tid = get_tid(), lane = tid & 63, wid = __builtin_amdgcn_readfirstlane(tid >> 6);
    GAS float* outg = (GAS float*)p.out; const GAS f32x4* fg = (const GAS f32x4*)p.final_g; const GAS float* SSQ = (const GAS float*)(p.ws + WS_SSQ);
    const GAS bf16_t* HB = (const GAS bf16_t*)(p.ws + WS_HB);
    const f32x4 g0 = fg[2 * lane], g1 = fg[2 * lane + 1], g2 = fg[128 + 2 * lane], g3 = fg[128 + 2 * lane + 1];
#pragma unroll 1
    for (int r = bid * 8 + wid; r < T; r += nb * 8) {
        const GAS u32x4* hr = (const GAS u32x4*)(HB + (size_t)r * D);
        const u32x4 w0 = hr[lane], w1 = hr[lane + 64];
        const float rs = rsqrtf(wave_sum(lane < 16 ? SSQ[(size_t)r * 16 + lane] : 0.f, lane) * (1.0f / D) + 1e-6f);
        GAS f32x4* o = (GAS f32x4*)(outg + (size_t)r * D);
        o[2 * lane] = (f32x4){bflo(w0.x), bfhi(w0.x), bflo(w0.y), bfhi(w0.y)} * rs * g0; o[2 * lane + 1] = (f32x4){bflo(w0.z), bfhi(w0.z), bflo(w0.w), bfhi(w0.w)} * rs * g1;
        o[128 + 2 * lane] = (f32x4){bflo(w1.x), bfhi(w1.x), bflo(w1.y), bfhi(w1.y)} * rs * g2; o[128 + 2 * lane + 1] = (f32x4){bflo(w1.z), bfhi(w1.z), bflo(w1.w), bfhi(w1.w)} * rs * g3;
    }
}

#define LAS __attribute__((address_space(3)))
#define XB_TMO      128
#define XB_XCNT(j)  (256  + 64 * (j))
#define XB_XSUB(j)  (1280 + 64 * (j))
#define XB_XGEN(j)  (2304 + 64 * (j))
#define XB_TOP      3328
#define XB_TOPGEN   3392
#define XCD_BAR_WORDS 3456
#define XB_SPIN_CAP (1u << 18)

__device__ __forceinline__ unsigned xb_ld(unsigned* p)              { return __hip_atomic_load(p, __ATOMIC_RELAXED, __HIP_MEMORY_SCOPE_AGENT); }
__device__ __forceinline__ unsigned xb_add(unsigned* p, unsigned v) { return __hip_atomic_fetch_add(p, v, __ATOMIC_RELAXED, __HIP_MEMORY_SCOPE_AGENT); }
__device__ __forceinline__ unsigned xb_xcc_id() { return (unsigned)__builtin_amdgcn_s_getreg((3 << 11) | 20) & 0xFu; }
#define XB_SPIN(cond, bar) do { unsigned _sp = 0; while (cond) { __builtin_amdgcn_s_sleep(1); \
    if ((++_sp & 255u) == 0u) { if (xb_ld(&(bar)[XB_TMO])) break; if (_sp > XB_SPIN_CAP) { atomicAdd(&(bar)[XB_TMO], 1u); break; } } } } while (0)

struct XcdBarrier {
    unsigned* bar; unsigned x;
    volatile LAS unsigned* st;
};

__device__ __forceinline__ XcdBarrier xcd_barrier_post(unsigned* bar, volatile LAS unsigned* st) {
    XcdBarrier b; b.bar = bar; b.x = xb_xcc_id(); b.st = st;
    if (get_tid() == 0) (void)xb_add(&bar[XB_XCNT(b.x)], 1u);
    return b;
}
__device__ __forceinline__ void xcd_barrier_complete(unsigned* bar, unsigned x, unsigned& nloc, unsigned& nx) {
    const unsigned G = gridDim.x * gridDim.y * gridDim.z;
    unsigned sum, cnt, mine, sp = 0u;
    for (;;) {
        sum = 0u; cnt = 0u; mine = 0u;
#pragma unroll
        for (unsigned j = 0; j < 16; ++j) { const unsigned c = xb_ld(&bar[XB_XCNT(j)]); sum += c; cnt += (c > 0u) ? 1u : 0u; mine = (j == x) ? c : mine; }
        if (sum == G) break;
        __builtin_amdgcn_s_sleep(1);
        if ((++sp & 255u) == 0u) { if (xb_ld(&bar[XB_TMO])) break; if (sp > XB_SPIN_CAP) { atomicAdd(&bar[XB_TMO], 1u); break; } }
    }
    nloc = mine > 0u ? mine : 1u; nx = cnt > 0u ? cnt : 1u;
}

__device__ __forceinline__ void xcd_barrier(const XcdBarrier& b) {
    asm volatile("s_waitcnt vmcnt(0)" ::: "memory");
    __syncthreads();
    if (get_tid() == 0) {
        unsigned* bar = b.bar;
        __builtin_amdgcn_s_waitcnt(0);
        unsigned nloc = b.st[0], nx = b.st[1];
        if (nloc == 0u) { xcd_barrier_complete(bar, b.x, nloc, nx); b.st[0] = nloc; b.st[1] = nx; }
        const unsigned old = xb_add(&bar[XB_XSUB(b.x)], 1u);
        const unsigned gen = old / nloc;
        if (old + 1u == (gen + 1u) * nloc) {
            __builtin_amdgcn_fence(__ATOMIC_RELEASE, "agent");
            asm volatile("s_waitcnt vmcnt(0)" ::: "memory");
            const unsigned og = xb_add(&bar[XB_TOP], 1u);
            const unsigned tg = og / nx;
            if (og + 1u == (tg + 1u) * nx) xb_add(&bar[XB_TOPGEN], 1u);
            else XB_SPIN(xb_ld(&bar[XB_TOPGEN]) == tg, bar);
            __builtin_amdgcn_fence(__ATOMIC_ACQUIRE, "agent");
            xb_add(&bar[XB_XGEN(b.x)], 1u);
            asm volatile("s_waitcnt vmcnt(0)" ::: "memory");
        } else {
            XB_SPIN(xb_ld(&bar[XB_XGEN(b.x)]) == gen, bar);
            __builtin_amdgcn_fence(__ATOMIC_ACQUIRE, "agent");
            asm volatile("s_waitcnt vmcnt(0)" ::: "memory");
        }
    }
    __syncthreads();
}

namespace cg = cooperative_groups;
__global__ void __launch_bounds__(NT, 2) mega_fwd(P p) {
    float* lds = (float*)smem;
    const lds_ptr ldsr = (lds_ptr)smem;
    const int bid = blockIdx.x, nb = gridDim.x;
    volatile LAS unsigned* MISC = (volatile LAS unsigned*)((LAS unsigned char*)smem + LDS_BYTES - 64);
    if (threadIdx.x < 2) MISC[threadIdx.x] = 0u;
    if ((threadIdx.x & 63) == 0) ((LAS int*)((LAS unsigned char*)smem + LDS_WTAB))[__builtin_amdgcn_s_getreg((5 << 11) | 4)] = (int)(threadIdx.x >> 6);
    __syncthreads();
    const XcdBarrier bar = xcd_barrier_post((unsigned*)(p.ws + WS_CTL), MISC);
#define GSYNC() xcd_barrier(bar)
#ifndef PROBE_A
#define PROBE_A -1
#endif
#ifndef PROBE_P
#define PROBE_P (PROBE_A - 1)
#endif
    unsigned long long* ts = (unsigned long long*)(p.ws + 512 * 1024);
#define STAMP(cat) do { if (PROBE_A >= 0 && bid == 0) ts[l * 16 + (cat)] = __builtin_amdgcn_s_memrealtime(); } while (0)
#define PH(call) do { const __attribute__((address_space(4))) unsigned long long* kp_ = (const __attribute__((address_space(4))) unsigned long long*)__builtin_amdgcn_kernarg_segment_ptr(); asm volatile("" : "+s"(kp_) :: "memory"); \
        P q; { unsigned long long* d_ = (unsigned long long*)&q; _Pragma("unroll") for (int i_ = 0; i_ < (int)(sizeof(P) / 8); ++i_) d_[i_] = kp_[i_]; } call; } while (0)
    if (PROBE_A >= 0 && bid == 0) ts[40] = __builtin_amdgcn_s_memrealtime();

#ifndef NO_ph_prologue
        PH(ph_prologue(q, bid, nb));
#endif

    cg::this_grid().sync();
    { constexpr int l = 0;

#ifndef NO_ph_prep_weights
        PH(ph_prep_weights(q, l, bid, nb, (lds_fptr)smem));
#endif
        GSYNC(); STAMP(0);

#ifndef NO_ph_gemm_p
        PH(ph_gemm_p(q, bid, nb, ldsr));
#endif

#ifndef NO_ph_gemm_kv
        if (l == 0) PH(ph_gemm_kv(q, bid, nb, ldsr));
#endif
        GSYNC(); STAMP(1);

#ifndef NO_ph_sb_attn
        PH(ph_sb_attn(q, bid, nb, (__attribute__((address_space(3))) unsigned char*)smem));
#endif

STAMP(11);
#ifndef NO_ph_conv
        PH(ph_conv(q, l, bid, nb, (LASX unsigned char*)smem));
#endif
        GSYNC(); STAMP(2);

#ifndef NO_ph_merged
        PH(ph_merged(q, l, bid, nb, ldsr));
#endif
        GSYNC(); STAMP(3);

#ifndef NO_ph_gemm_wout
        PH(ph_gemm_wout(q, bid, nb, ldsr));
#endif
        GSYNC(); STAMP(4);

#ifndef NO_ph_gemm_xq
        PH(ph_gemm_xq(q, bid, nb, ldsr));
#endif
        GSYNC(); STAMP(5);

#ifndef NO_ph_xattn
        PH(ph_xattn(q, l, bid, nb, (LASX unsigned char*)smem));
#endif
        GSYNC(); STAMP(6);

#ifndef NO_ph_gemm_wo
        PH(ph_gemm_wo(q, bid, nb, ldsr));
#endif
        GSYNC(); STAMP(7);

#ifndef NO_ph_gemm_pq
        PH(ph_gemm_pq(q, bid, nb, ldsr));
#endif
        GSYNC(); STAMP(8);

#ifndef NO_ph_peer_score
        PH(ph_peer_score(q, bid, nb, (lds_fptr)smem));
#endif
        GSYNC(); STAMP(9);

#ifndef NO_ph_peer_gather
        PH(ph_peer_u2(q, bid, nb, (LASX unsigned char*)smem)); GSYNC();
        PH(ph_peer_w(q, bid, nb)); GSYNC(); STAMP(12);
        PH(ph_peer_v(q, bid, nb, (LASX unsigned char*)smem));
        if (l == DEPTH - 1) { GSYNC(); PH(ph_final_norm(q, bid, nb)); }
#endif
        if (l < DEPTH - 1 || PROBE_A >= 0) GSYNC();
        STAMP(10);
    }
    { constexpr int l = 1;

#ifndef NO_ph_prep_weights
        PH(ph_prep_weights(q, l, bid, nb, (lds_fptr)smem));
#endif
        GSYNC(); STAMP(0);

#ifndef NO_ph_gemm_p
        PH(ph_gemm_p(q, bid, nb, ldsr));
#endif

#ifndef NO_ph_gemm_kv
        if (l == 0) PH(ph_gemm_kv(q, bid, nb, ldsr));
#endif
        GSYNC(); STAMP(1);

#ifndef NO_ph_sb_attn
        PH(ph_sb_attn(q, bid, nb, (__attribute__((address_space(3))) unsigned char*)smem));
#endif

STAMP(11);
#ifndef NO_ph_conv
        PH(ph_conv(q, l, bid, nb, (LASX unsigned char*)smem));
#endif
        GSYNC(); STAMP(2);

#ifndef NO_ph_merged
        PH(ph_merged(q, l, bid, nb, ldsr));
#endif
        GSYNC(); STAMP(3);

#ifndef NO_ph_gemm_wout
        PH(ph_gemm_wout(q, bid, nb, ldsr));
#endif
        GSYNC(); STAMP(4);

#ifndef NO_ph_gemm_xq
        PH(ph_gemm_xq(q, bid, nb, ldsr));
#endif
        GSYNC(); STAMP(5);

#ifndef NO_ph_xattn
        PH(ph_xattn(q, l, bid, nb, (LASX unsigned char*)smem));
#endif
        GSYNC(); STAMP(6);

#ifndef NO_ph_gemm_wo
        PH(ph_gemm_wo(q, bid, nb, ldsr));
#endif
        GSYNC(); STAMP(7);

#ifndef NO_ph_gemm_pq
        PH(ph_gemm_pq(q, bid, nb, ldsr));
#endif
        GSYNC(); STAMP(8);

#ifndef NO_ph_peer_score
        PH(ph_peer_score(q, bid, nb, (lds_fptr)smem));
#endif
        GSYNC(); STAMP(9);

#ifndef NO_ph_peer_gather
        PH(ph_peer_u2(q, bid, nb, (LASX unsigned char*)smem)); GSYNC();
        PH(ph_peer_w(q, bid, nb)); GSYNC(); STAMP(12);
        PH(ph_peer_v(q, bid, nb, (LASX unsigned char*)smem));
        if (l == DEPTH - 1) { GSYNC(); PH(ph_final_norm(q, bid, nb)); }
#endif
        if (l < DEPTH - 1 || PROBE_A >= 0) GSYNC();
        STAMP(10);
    }
#if PROBE_A >= 0
    {
        __threadfence(); cg::this_grid().sync();
        if (bid == 0 && get_tid() == 0) {
            unsigned long long tot = 0;
            for (int l = 0; l < DEPTH; ++l) { const unsigned long long prev = (PROBE_P >= 0) ? ts[l * 16 + PROBE_P] : (l == 0 ? ts[40] : ts[(l - 1) * 16 + 10]); tot += ts[l * 16 + PROBE_A] - prev; }
            p.out[0] += (float)tot * 0.01f * 0.02f;
        }
    }
#endif
#undef PH
}

extern "C" void kernel_launch(void* const* d_in, const int* in_sizes, int n_in, void* d_out, int out_size, void* d_ws, size_t ws_size, hipStream_t stream) {
    static int grid = 0;
    if (grid == 0) {
        int dev = 0, cus = 0, per_cu = 0;
        hipGetDevice(&dev);
        hipDeviceGetAttribute(&cus, hipDeviceAttributeMultiprocessorCount, dev);
        hipFuncSetAttribute((const void*)mega_fwd, hipFuncAttributeMaxDynamicSharedMemorySize, LDS_BYTES);
        hipOccupancyMaxActiveBlocksPerMultiprocessor(&per_cu, (const void*)mega_fwd, NT, LDS_BYTES);
        if (per_cu < 1) per_cu = 1;
        grid = cus * per_cu;
        if (ws_size < WS_END) { fprintf(stderr, "kernel_launch: workspace too small (%zu < %zu)\n", ws_size, (size_t)WS_END); grid = -1; }
    }
    if (grid < 0) return;
    P p{};
    const float** pp = (const float**)&p;
    for (int i = 0; i < 23; ++i) pp[i] = (const float*)d_in[i];
    p.out = (float*)d_out; p.ws = (unsigned char*)d_ws;
    (void)hipMemsetAsync((char*)d_ws + WS_CTL, 0, 16384, stream);
    void* args[] = {&p};
    hipError_t e = hipLaunchCooperativeKernel((void*)mega_fwd, dim3(grid), dim3(NT), args, LDS_BYTES, stream);
    if (e != hipSuccess) fprintf(stderr, "cooperative launch failed: %s (grid %d)\n", hipGetErrorString(e), grid);
}
```

```cpp
#include <hip/hip_runtime.h>
#include <hip/hip_cooperative_groups.h>
#include <cstdio>
#include <stdint.h>
#include <math.h>

constexpr int D = 1024, BATCH = 8, SEQ = 2048, T = BATCH * SEQ, DEPTH = 2, NMEM = 256, TM = BATCH * NMEM;
constexpr int INW = 7168, OFF_CV = 1536, OFF_SC = 2560, OFF_GATE = 4096;
constexpr int YW = 1536;
constexpr int NEXP = 16384, PQW = 2048;
constexpr int NT = 512;

typedef uint16_t bf16_t;
typedef short bf16x8 __attribute__((ext_vector_type(8)));
typedef float f32x4 __attribute__((ext_vector_type(4)));
typedef unsigned u32x4 __attribute__((ext_vector_type(4)));
typedef unsigned u32x2 __attribute__((ext_vector_type(2)));
#define GAS __attribute__((address_space(1)))

constexpr size_t MiB = 1u << 20;
constexpr size_t WS_CTL = 0;
constexpr size_t WS_WIN = 1 * MiB;
constexpr size_t WS_WBR = 15 * MiB;
constexpr size_t WS_WOUT = 18 * MiB;
constexpr size_t WS_WXQ = 20 * MiB;
constexpr size_t WS_WKV = 22 * MiB;
constexpr size_t WS_WO = 26 * MiB;
constexpr size_t WS_WPQ = 28 * MiB;
constexpr size_t WS_KEYS = 32 * MiB;
constexpr size_t WS_U = 33 * MiB;
constexpr size_t WS_V = 49 * MiB;
constexpr size_t WS_USC = 65 * MiB;
constexpr size_t WS_VSC = 65 * MiB + 65536;
constexpr size_t WS_HB8 = 66 * MiB;
constexpr size_t WS_WG8 = 82 * MiB;
constexpr size_t WS_HB = 97 * MiB;
constexpr size_t WS_SSQ = 129 * MiB;
constexpr size_t WS_MEMSSQ = 256 * 1024;
constexpr size_t WS_MEMB = 130 * MiB;
constexpr size_t WS_KV = 134 * MiB;
constexpr size_t WS_Y = 142 * MiB;
constexpr size_t WS_MERGED = 190 * MiB;
constexpr size_t WS_P = 222 * MiB;
constexpr size_t WS_XQ = 222 * MiB;
constexpr size_t WS_XO = 254 * MiB;
constexpr size_t WS_PQ = 286 * MiB;
constexpr size_t WS_PIDX = 350 * MiB;
constexpr size_t WS_PG = 358 * MiB;
constexpr size_t WS_PD = 366 * MiB;
constexpr size_t WS_VT = 446 * MiB;
constexpr size_t WS_SBVT = 450 * MiB;
constexpr size_t WS_WKV2 = 466 * MiB;
constexpr size_t WS_KV2 = 474 * MiB;
constexpr size_t WS_VT2 = 490 * MiB;
constexpr size_t WS_END = 498 * MiB;

struct P {
    const float *x, *mem, *norm_mix_g, *w_in, *conv_dw_w, *conv_dw_b, *conv_ln_g, *conv_ln_b, *sc_w, *w_branch, *b_gate, *w_out,
        *norm_xa_g, *norm_mem_g, *xa_wq, *xa_wkv, *xa_wo, *norm_ffn_g, *peer_wq, *peer_keys, *peer_u, *peer_v, *final_g;
    float* out;
    unsigned char* ws;
};

__device__ __forceinline__ unsigned f2bf(float f) { unsigned u = __float_as_uint(f); return (u + 0x7fffu + ((u >> 16) & 1u)) >> 16; }
__device__ __forceinline__ unsigned pk2(float lo, float hi) { return f2bf(lo) | (f2bf(hi) << 16); }
__device__ __forceinline__ float q8c(float v, float s) { return __builtin_amdgcn_fmed3f(v * s, -448.f, 448.f); }
__device__ __forceinline__ unsigned pk4_fp8(float a, float b, float c, float d, float s) { return (unsigned)__builtin_amdgcn_cvt_pk_fp8_f32(q8c(c, s), q8c(d, s), __builtin_amdgcn_cvt_pk_fp8_f32(q8c(a, s), q8c(b, s), 0, false), true); }
__device__ __forceinline__ float bflo(unsigned w) { return __uint_as_float(w << 16); }
__device__ __forceinline__ float bfhi(unsigned w) { return __uint_as_float(w & 0xffff0000u); }
__device__ __forceinline__ float bf2f(bf16_t h) { return __uint_as_float(((unsigned)h) << 16); }
constexpr int LDS_BYTES = 163840;
constexpr int LDS_WTAB = LDS_BYTES - 512;
extern __shared__ __attribute__((aligned(16))) unsigned char smem[];
__device__ __forceinline__ int get_tid() {
    const unsigned hw = __builtin_amdgcn_s_getreg((5 << 11) | 4);
    const int w = ((volatile __attribute__((address_space(3))) int*)((__attribute__((address_space(3))) unsigned char*)smem + LDS_WTAB))[hw];
    unsigned ones = ~0u; asm volatile("" : "+s"(ones));
    int t = (w << 6) | (int)__builtin_amdgcn_mbcnt_hi(ones, __builtin_amdgcn_mbcnt_lo(ones, 0u));
    asm volatile("" : "+v"(t)); return t; }
__device__ __forceinline__ float shx(float v, int m, int lane) { return __uint_as_float((unsigned)__builtin_amdgcn_ds_bpermute((lane ^ m) << 2, (int)__float_as_uint(v))); }
template <int CTRL> __device__ __forceinline__ float dppf(float x) { return __uint_as_float((unsigned)__builtin_amdgcn_update_dpp(0, (int)__float_as_uint(x), CTRL, 0xF, 0xF, false)); }
__device__ __forceinline__ float swap32_sum(float a, float b) { auto r = __builtin_amdgcn_permlane32_swap(__float_as_uint(a), __float_as_uint(b), false, false); return __uint_as_float(r[0]) + __uint_as_float(r[1]); }
__device__ __forceinline__ float swap16_sum(float a, float b) { auto r = __builtin_amdgcn_permlane16_swap(__float_as_uint(a), __float_as_uint(b), false, false); return __uint_as_float(r[0]) + __uint_as_float(r[1]); }
__device__ __forceinline__ float wave_sum2(float x) {
    x += dppf<0x128>(x); x += dppf<0x124>(x); x += dppf<0x122>(x); x += dppf<0x121>(x);
    x = swap16_sum(x, x); x = swap32_sum(x, x); return x; }
__device__ __forceinline__ float wave_sum(float v, int) { return wave_sum2(v); }
__device__ __forceinline__ float wave_max(float x, int) {
    x = fmaxf(x, dppf<0x128>(x)); x = fmaxf(x, dppf<0x124>(x)); x = fmaxf(x, dppf<0x122>(x)); x = fmaxf(x, dppf<0x121>(x));
    { auto r = __builtin_amdgcn_permlane16_swap(__float_as_uint(x), __float_as_uint(x), false, false); x = fmaxf(__uint_as_float(r[0]), __uint_as_float(r[1])); }
    { auto r = __builtin_amdgcn_permlane32_swap(__float_as_uint(x), __float_as_uint(x), false, false); x = fmaxf(__uint_as_float(r[0]), __uint_as_float(r[1])); }
    return x; }
__device__ __forceinline__ float sigmoidf_(float z) { return 1.0f / (1.0f + __expf(-z)); }

__device__ __forceinline__ void row_to_bf16_rs(const float* src, float* dst_f32, bf16_t* dst_bf, float* rs_out, int lane, unsigned* dst8 = nullptr) {
    const f32x4* s4 = (const f32x4*)src + lane;
    f32x4 v[4]; float ss = 0.f;
#pragma unroll
    for (int j = 0; j < 4; ++j) { v[j] = s4[64 * j]; ss += v[j].x * v[j].x + v[j].y * v[j].y + v[j].z * v[j].z + v[j].w * v[j].w; }
    ss = wave_sum(ss, lane);
    if (dst_f32) {
#pragma unroll
        for (int j = 0; j < 4; ++j) ((f32x4*)dst_f32 + lane)[64 * j] = v[j];
    }
#pragma unroll
    for (int j = 0; j < 4; ++j) { u32x2 w; w.x = pk2(v[j].x, v[j].y); w.y = pk2(v[j].z, v[j].w); ((u32x2*)dst_bf + lane)[64 * j] = w; }
    if (dst8) {
#pragma unroll
        for (int j = 0; j < 4; ++j) (dst8 + lane)[64 * j] = pk4_fp8(v[j].x, v[j].y, v[j].z, v[j].w, 16.f);
    }
    if (lane < 16) rs_out[lane] = lane == 0 ? ss : 0.f;
}
__device__ __forceinline__ void ph_prologue(const P& p, int bid, int nb) {
    const int tid = get_tid(), lane = tid & 63, wid = tid >> 6;
    const int gw = bid * 8 + wid, ngw = nb * 8;
    bf16_t* hb = (bf16_t*)(p.ws + WS_HB); float* rs = (float*)(p.ws + WS_SSQ);
    bf16_t* memb = (bf16_t*)(p.ws + WS_MEMB); float* mrs = (float*)(p.ws + WS_MEMSSQ);
    for (int r = gw; r < T; r += ngw) row_to_bf16_rs(p.x + (size_t)r * D, nullptr, hb + (size_t)r * D, rs + (size_t)r * 16, lane, (unsigned*)(p.ws + WS_HB8 + (size_t)r * D));
    for (int r = gw; r < TM; r += ngw) row_to_bf16_rs(p.mem + (size_t)r * D, nullptr, memb + (size_t)r * D, mrs + (size_t)r * 16, lane);
}
__device__ __forceinline__ void transpose_item(const float* W_, const float* g_, bf16_t* Wt_, int K, int N, int item, __attribute__((address_space(3))) float* scr, int lane, unsigned char* W8_ = nullptr, int n8 = 0) {
    const GAS float* W = (const GAS float*)W_; const GAS float* g = (const GAS float*)g_; GAS bf16_t* Wt = (GAS bf16_t*)Wt_;
    const int nblk = N / 32, kb = item / nblk, nbk = item % nblk, k0 = 64 * kb, n0 = 32 * nbk;
    float v[32];
#pragma unroll
    for (int i = 0; i < 32; ++i) { const int kk = 2 * i + (lane >> 5); v[i] = W[(size_t)(k0 + kk) * N + n0 + (lane & 31)]; }
    if (g_ != nullptr) {
#pragma unroll
        for (int i = 0; i < 32; ++i) v[i] *= g[k0 + 2 * i + (lane >> 5)];
    }
#pragma unroll
    for (int i = 0; i < 32; ++i) scr[(2 * i + (lane >> 5)) * 33 + (lane & 31)] = v[i];
    const int c = lane & 7;
    if (W8_ != nullptr && n0 >= n8) {
#pragma unroll
        for (int j = 0; j < 4; ++j) {
            const int n = (lane >> 3) + 8 * j; const __attribute__((address_space(3))) float* sp = scr + (8 * c) * 33 + n;
            u32x2 o; o.x = pk4_fp8(sp[0 * 33], sp[1 * 33], sp[2 * 33], sp[3 * 33], 512.f); o.y = pk4_fp8(sp[4 * 33], sp[5 * 33], sp[6 * 33], sp[7 * 33], 512.f);
            *(GAS u32x2*)((GAS unsigned char*)W8_ + (size_t)(n0 + n - n8) * K + k0 + 8 * c) = o;
        }
        return;
    }
#pragma unroll
    for (int j = 0; j < 4; ++j) {
        const int n = (lane >> 3) + 8 * j; const __attribute__((address_space(3))) float* sp = scr + (8 * c) * 33 + n;
        u32x4 o; o.x = pk2(sp[0 * 33], sp[1 * 33]); o.y = pk2(sp[2 * 33], sp[3 * 33]); o.z = pk2(sp[4 * 33], sp[5 * 33]); o.w = pk2(sp[6 * 33], sp[7 * 33]);
        *(GAS u32x4*)(Wt + (size_t)(n0 + n) * K + k0 + 8 * c) = o;
    }
}
__device__ __forceinline__ void ph_prep_weights(const P& p, int l, int bid, int nb, __attribute__((address_space(3))) float* ldsf, int part) {
    unsigned char* ws = p.ws;
    {
        const int tid = get_tid(), lane = tid & 63, wid = __builtin_amdgcn_readfirstlane(tid >> 6);
        __attribute__((address_space(3))) float* scr = ldsf + wid * (64 * 33);
        constexpr int I0 = 16 * 224, I1 = 8 * 32, I4 = 16 * 32, I6 = 16 * 64;
        constexpr int NITEMS = I0 + 3 * I1 + I4 + I4 + I6 + I4 + I6;
#pragma unroll 1
        for (int it = bid * 8 + wid; it < NITEMS; it += nb * 8) {
            int r = it;
            { const bool is0 = (it < I0) || (it >= I0 + 3 * I1 + 2 * I4 && it < I0 + 3 * I1 + 2 * I4 + I6); if (is0 != (part == 0)) continue; }
            if (r < I0) { transpose_item(p.w_in + (size_t)l * D * INW, p.norm_mix_g + l * D, (bf16_t*)(ws + WS_WIN), D, INW, r, scr, lane, ws + WS_WG8, OFF_GATE); continue; } r -= I0;
            if (r < 3 * I1) { const int b = r / I1; transpose_item(p.w_branch + ((size_t)l * 3 + b) * 512 * D, nullptr, (bf16_t*)(ws + WS_WBR) + (size_t)b * 1024 * 512, 512, D, r % I1, scr, lane); continue; } r -= 3 * I1;
            if (r < I4) { transpose_item(p.w_out + (size_t)l * D * D, nullptr, nullptr, D, D, r, scr, lane, ws + WS_WOUT, 0); continue; } r -= I4;
            if (r < I4) { transpose_item(p.xa_wq + (size_t)l * D * D, p.norm_xa_g + l * D, nullptr, D, D, r, scr, lane, ws + WS_WXQ, 0); continue; } r -= I4;
            if (r < I6) { if (l == 0) { transpose_item(p.xa_wkv, p.norm_mem_g, (bf16_t*)(ws + WS_WKV2), D, 2 * D, r, scr, lane); transpose_item(p.xa_wkv + (size_t)D * 2 * D, p.norm_mem_g + D, (bf16_t*)(ws + WS_WKV2) + (size_t)2 * D * D, D, 2 * D, r, scr, lane); } continue; } r -= I6;
            if (r < I4) { transpose_item(p.xa_wo + (size_t)l * D * D, nullptr, nullptr, D, D, r, scr, lane, ws + WS_WO, 0); continue; } r -= I4;
            transpose_item(p.peer_wq + (size_t)l * D * PQW, p.norm_ffn_g + l * D, nullptr, D, PQW, r, scr, lane, ws + WS_WPQ, 0);
        }
    }
    if (part == 0) return;
    {
        const int tid = get_tid(), lane = tid & 63, wid = tid >> 6;
        const f32x4* g4 = (const f32x4*)(p.norm_ffn_g + l * D) + 4 * lane;
        const f32x4 gg0 = g4[0], gg1 = g4[1], gg2 = g4[2], gg3 = g4[3];
        const int wb = (l == 0 && (nb & 1) == 0) ? bid - (nb >> 1) : bid, nw = (l == 0 && (nb & 1) == 0) ? (nb >> 1) : nb;
        if (wb >= 0)
#pragma unroll 1
        for (int row0 = wb * 8 + wid; row0 < 2 * NEXP; row0 += 2 * nw * 8) {
            f32x4 a[2][4];
#pragma unroll
            for (int h2 = 0; h2 < 2; ++h2) {
                const int row = row0 + h2 * nw * 8; const bool isv = row >= NEXP; const int e = isv ? row - NEXP : row;
                const GAS f32x4* src = (const GAS f32x4*)((isv ? p.peer_v : p.peer_u) + ((size_t)l * NEXP + (row < 2 * NEXP ? e : 0)) * D) + 4 * lane;
                a[h2][0] = src[0]; a[h2][1] = src[1]; a[h2][2] = src[2]; a[h2][3] = src[3];
            }
#pragma unroll
            for (int h2 = 0; h2 < 2; ++h2) {
                const int row = row0 + h2 * nw * 8; const bool isv = row >= NEXP; const int e = isv ? row - NEXP : row;
                if (row < 2 * NEXP) {
                    f32x4 a0 = a[h2][0], a1 = a[h2][1], a2 = a[h2][2], a3 = a[h2][3];
                    if (!isv) { a0 *= gg0; a1 *= gg1; a2 *= gg2; a3 *= gg3; }
                    float m = 0.f;
#pragma unroll
                    for (int i = 0; i < 4; ++i) m = fmaxf(m, fmaxf(fmaxf(fabsf(a0[i]), fabsf(a1[i])), fmaxf(fabsf(a2[i]), fabsf(a3[i]))));
                    m = wave_max(m, lane);
                    const float sc = m > 0.f ? 240.0f / m : 1.0f;
                    u32x4 w;
                    w.x = (unsigned)__builtin_amdgcn_cvt_pk_fp8_f32(a0[2] * sc, a0[3] * sc, __builtin_amdgcn_cvt_pk_fp8_f32(a0[0] * sc, a0[1] * sc, 0, false), true);
                    w.y = (unsigned)__builtin_amdgcn_cvt_pk_fp8_f32(a1[2] * sc, a1[3] * sc, __builtin_amdgcn_cvt_pk_fp8_f32(a1[0] * sc, a1[1] * sc, 0, false), true);
                    w.z = (unsigned)__builtin_amdgcn_cvt_pk_fp8_f32(a2[2] * sc, a2[3] * sc, __builtin_amdgcn_cvt_pk_fp8_f32(a2[0] * sc, a2[1] * sc, 0, false), true);
                    w.w = (unsigned)__builtin_amdgcn_cvt_pk_fp8_f32(a3[2] * sc, a3[3] * sc, __builtin_amdgcn_cvt_pk_fp8_f32(a3[0] * sc, a3[1] * sc, 0, false), true);
                    ((GAS u32x4*)(ws + (isv ? WS_V : WS_U)) + (size_t)e * 64)[lane] = w;
                    if (lane == 0) ((GAS float*)(ws + (isv ? WS_VSC : WS_USC)))[e] = m > 0.f ? m * (1.0f / 240.0f) : 1.0f;
                }
            }
        }
    }
    const size_t gt = (size_t)bid * NT + get_tid(), gn = (size_t)nb * NT;
    const f32x4* k4 = (const f32x4*)(p.peer_keys + (size_t)l * 8 * 2 * 128 * 128); u32x2* kb = (u32x2*)(ws + WS_KEYS);
    for (size_t i = gt; i < (size_t)8 * 2 * 128 * 128 / 4; i += gn) { const f32x4 a = k4[i]; u32x2 w; w.x = pk2(a.x, a.y); w.y = pk2(a.z, a.w); kb[i] = w; }
}

namespace pg8 {
#define PG8_LAS __attribute__((address_space(3)))
constexpr int BM = 256, BK = 64, HALF = 128, HTB = HALF * BK * 2  , STAGE_BYTES = 8 * HTB, NXCD = 8, WGM = 8;

__host__ __device__ __forceinline__ int lds_byte(int r, int c) { const int st = (r >> 4) * 2 + (c >> 5), rr = r & 15, cc = c & 31, ob = rr * 64 + cc * 2; return st * 1024 + (ob ^ (((ob >> 9) & 1) << 5)); }
__host__ __device__ __forceinline__ void stage_rc(int b, int& R, int& C) { const int st = b / 1024, sb = b % 1024, swz = sb ^ (((sb >> 9) & 1) << 5); R = (st >> 1) * 16 + swz / 64; C = (st & 1) * 32 + (swz % 64) / 2; }
__host__ __device__ __forceinline__ int perm32(int rho) { const int n = rho >> 4, i = rho & 15; return 8 * (i >> 2) + 4 * n + (i & 3); }

struct Unit { int pm, pn, pb; };
struct Gemm { const bf16_t* A; const bf16_t* Bt; int K; size_t a_bs, b_bs; };

struct StaticOrder {
    int nM, nN, nwg, G, c;
    __host__ __device__ void init(int M, int N, int G_, int c_) { nM = M / BM; nN = N / BM; nwg = nM * nN; G = G_; c = c_; }
    __host__ __device__ bool next(int i, Unit& u) const {
        const long L = (long)i * G + c; if (L >= nwg) return false;
        int wgid = (int)L; { const int q = nwg / NXCD, r = nwg % NXCD, xcd = wgid % NXCD, off = wgid / NXCD; wgid = (xcd < r ? xcd * (q + 1) : r * (q + 1) + (xcd - r) * q) + off; }
        const int nig = WGM * nN, gid = wgid / nig, fm = gid * WGM, gsz = (nM - fm) < WGM ? (nM - fm) : WGM;
        u.pm = fm + ((wgid % nig) % gsz); u.pn = (wgid % nig) / gsz; u.pb = 0; return true;
    }
    __device__ __forceinline__ void a_ready(const Unit&) const {}
    __device__ __forceinline__ void done(const Unit&) const {}
};
__device__ __forceinline__ unsigned cvt_pk_bf16(float lo, float hi) { unsigned r; asm volatile("v_cvt_pk_bf16_f32 %0, %1, %2" : "=v"(r) : "v"(lo), "v"(hi)); return r; }
typedef int i32x4_t __attribute__((ext_vector_type(4)));
typedef int i32x8_t __attribute__((ext_vector_type(8)));
__device__ __forceinline__ i32x8_t cat8(bf16x8 lo, bf16x8 hi) { return __builtin_shufflevector(__builtin_bit_cast(i32x4_t, lo), __builtin_bit_cast(i32x4_t, hi), 0, 1, 2, 3, 4, 5, 6, 7); }
template <class Epi, class Sched, bool ALIGN_EPI = false, bool SP2 = false, bool FP8 = false>
__device__ __forceinline__ void gemm_phase(PG8_LAS unsigned char* lds, const Gemm g, const Sched& S, const Epi& E) {
    const int tid = get_tid(), wid = __builtin_amdgcn_readfirstlane(tid >> 6), lane = tid & 63, wr = wid >> 2, wc = wid & 3, fr = lane & 15, fq = lane >> 4;
    int K = g.K; if constexpr (FP8) asm volatile("" : "+s"(K));
    const int nt = K / BK;
    unsigned voffA[2], voffB[2];
#pragma unroll
    for (int i = 0; i < 2; ++i) { int R, C; stage_rc(tid * 16 + i * 8192, R, C); const int Rb = Epi::PERM ? ((R & ~31) + perm32(R & 31)) : R;
        voffA[i] = (unsigned)(R * K + C) * 2u; voffB[i] = (unsigned)(Rb * K + C) * 2u; }
    const size_t kstep = (size_t)(BK * 2);
    const size_t hstep = (size_t)HALF * K * 2;
    const size_t tstep = 2 * hstep;
    const unsigned ldsw = (unsigned)wid * 1024u;
    const int aoff = lds_byte(wr * 64 + fr, fq * 8), boff = lds_byte(wc * 32 + fr, fq * 8);
#define PG8_SA(b, h) (((b) * 2 + (h)) * HTB)
#define PG8_SB(b, h) ((4 + (b) * 2 + (h)) * HTB)
#define PG8_STAGE(bufoff, gbase, voff) do { _Pragma("unroll") for (int _i = 0; _i < 2; ++_i) \
        __builtin_amdgcn_global_load_lds((const unsigned*)((const char*)(gbase) + (voff)[_i]), (PG8_LAS unsigned*)(lds + (bufoff) + ldsw + _i * 8192), 16, 0, 0); } while (0)
#define PG8_LDA(dst, b, h) do { _Pragma("unroll") for (int m = 0; m < 4; ++m) _Pragma("unroll") for (int k = 0; k < 2; ++k) dst[m][k] = *(const PG8_LAS bf16x8*)(lds + PG8_SA(b, h) + aoff + m * 2048 + k * 1024); } while (0)
#define PG8_LDB(dst, b, h) do { _Pragma("unroll") for (int n = 0; n < 2; ++n) _Pragma("unroll") for (int k = 0; k < 2; ++k) dst[n][k] = *(const PG8_LAS bf16x8*)(lds + PG8_SB(b, h) + boff + n * 2048 + k * 1024); } while (0)
#define PG8_MMA(ai, bj, At, Bt) do { __builtin_amdgcn_s_setprio(1); \
        if constexpr (FP8) { _Pragma("unroll") for (int m = 0; m < 4; ++m) _Pragma("unroll") for (int n = 0; n < 2; ++n) \
            asm volatile("v_mfma_f32_16x16x128_f8f6f4 %0, %1, %2, %0" : "+v"(acc[ai][bj][m][n]) : "v"(cat8(Bt[n][0], Bt[n][1])), "v"(cat8(At[m][0], At[m][1]))); } \
        else { _Pragma("unroll") for (int m = 0; m < 4; ++m) _Pragma("unroll") for (int n = 0; n < 2; ++n) _Pragma("unroll") for (int k = 0; k < 2; ++k) \
            acc[ai][bj][m][n] = __builtin_amdgcn_mfma_f32_16x16x32_bf16(Bt[n][k], At[m][k], acc[ai][bj][m][n], 0, 0, 0); } \
        __builtin_amdgcn_s_setprio(0); } while (0)
#define PG8_WAIT_V(n) asm volatile("s_waitcnt vmcnt(" #n ")" ::: "memory")
#define PG8_WAIT_L(n) asm volatile("s_waitcnt lgkmcnt(" #n ")" ::: "memory")
#define PG8_BAR __builtin_amdgcn_s_barrier()
#define PG8_SCHED __builtin_amdgcn_sched_barrier(0)
    Unit cur, nxt; int ui = 0;
    if (!S.next(0, cur)) return;
    f32x4 acc[2][2][4][2];
#pragma unroll
    for (int a = 0; a < 2; ++a)
#pragma unroll
        for (int b = 0; b < 2; ++b)
#pragma unroll
            for (int m = 0; m < 4; ++m)
#pragma unroll
                for (int n = 0; n < 2; ++n) acc[a][b][m][n] = (f32x4){0.f, 0.f, 0.f, 0.f};
    bf16x8 At[4][2], B0[2][2], B1[2][2];
    const char* cA = (const char*)g.A + (size_t)cur.pm * tstep + (size_t)cur.pb * g.a_bs; const char* cB = (const char*)g.Bt + (size_t)cur.pn * tstep + (size_t)cur.pb * g.b_bs;
    S.a_ready(cur);
    if constexpr (SP2) {
        PG8_STAGE(PG8_SB(0, 0), cB, voffB); PG8_STAGE(PG8_SB(0, 1), cB + hstep, voffB); PG8_STAGE(PG8_SA(0, 0), cA, voffA); PG8_STAGE(PG8_SA(0, 1), cA + hstep, voffA);
        if (wr == 1) PG8_BAR;
        PG8_WAIT_V(2); PG8_BAR;
        PG8_STAGE(PG8_SB(1, 0), cB + kstep, voffB); PG8_STAGE(PG8_SA(1, 0), cA + kstep, voffA); PG8_STAGE(PG8_SB(1, 1), cB + hstep + kstep, voffB);
        PG8_WAIT_V(6); PG8_BAR;
    } else {
        PG8_STAGE(PG8_SB(0, 0), cB, voffB); PG8_STAGE(PG8_SA(0, 0), cA, voffA); PG8_STAGE(PG8_SB(0, 1), cB + hstep, voffB); PG8_STAGE(PG8_SA(0, 1), cA + hstep, voffA);
        if (wr == 1) PG8_BAR;
        PG8_WAIT_V(4); PG8_BAR;
        PG8_STAGE(PG8_SB(1, 0), cB + kstep, voffB); PG8_STAGE(PG8_SA(1, 0), cA + kstep, voffA); PG8_STAGE(PG8_SB(1, 1), cB + hstep + kstep, voffB);
        PG8_WAIT_V(6); PG8_BAR;
    }
    for (;;) {
        const bool has_next = S.next(ui + 1, nxt);
        const char* nA = has_next ? (const char*)g.A + (size_t)nxt.pm * tstep + (size_t)nxt.pb * g.a_bs : cA; const char* nB = has_next ? (const char*)g.Bt + (size_t)nxt.pn * tstep + (size_t)nxt.pb * g.b_bs : cB;
        for (int t = 0; t < nt; t += 2) {
            const bool last = (t == nt - 2);
            const char* a1 = cA + (size_t)(t + 1) * kstep;
            const char* a2 = last ? nA : cA + (size_t)(t + 2) * kstep; const char* b2 = last ? nB : cB + (size_t)(t + 2) * kstep;
            const char* a3 = a2 + kstep; const char* b3 = b2 + kstep;
            if (last && has_next) S.a_ready(nxt);
            if constexpr (SP2) {
            PG8_LDB(B0, 0, 0); PG8_LDB(B1, 0, 1); PG8_SCHED; PG8_LDA(At, 0, 0); PG8_STAGE(PG8_SA(1, 1), a1 + hstep, voffA);
            PG8_WAIT_V(8); PG8_WAIT_L(0); PG8_BAR; PG8_MMA(0, 0, At, B0); PG8_MMA(0, 1, At, B1); PG8_BAR; PG8_SCHED;
            PG8_LDA(At, 0, 1); PG8_STAGE(PG8_SB(0, 0), b2, voffB); PG8_STAGE(PG8_SB(0, 1), b2 + hstep, voffB); PG8_STAGE(PG8_SA(0, 0), a2, voffA);
            PG8_WAIT_V(8); PG8_WAIT_L(0); PG8_BAR; PG8_MMA(1, 0, At, B0); PG8_MMA(1, 1, At, B1); PG8_BAR; PG8_SCHED;
            PG8_LDB(B0, 1, 0); PG8_LDB(B1, 1, 1); PG8_SCHED; PG8_LDA(At, 1, 0); PG8_STAGE(PG8_SA(0, 1), a2 + hstep, voffA);
            PG8_WAIT_V(8); PG8_WAIT_L(0); PG8_BAR; PG8_MMA(0, 0, At, B0); PG8_MMA(0, 1, At, B1); PG8_BAR; PG8_SCHED;
            PG8_LDA(At, 1, 1); PG8_STAGE(PG8_SB(1, 0), b3, voffB); PG8_STAGE(PG8_SB(1, 1), b3 + hstep, voffB); PG8_STAGE(PG8_SA(1, 0), a3, voffA);
            PG8_WAIT_V(8); PG8_WAIT_L(0); PG8_BAR; PG8_MMA(1, 0, At, B0); PG8_MMA(1, 1, At, B1); PG8_BAR; PG8_SCHED;
            } else {
            PG8_LDB(B0, 0, 0); PG8_SCHED; PG8_LDA(At, 0, 0); PG8_STAGE(PG8_SA(1, 1), a1 + hstep, voffA);
            PG8_WAIT_L(8); PG8_BAR; PG8_WAIT_L(0); PG8_MMA(0, 0, At, B0); PG8_BAR; PG8_SCHED;
            PG8_LDB(B1, 0, 1); PG8_STAGE(PG8_SB(0, 0), b2, voffB);
            PG8_BAR; PG8_WAIT_L(0); PG8_MMA(0, 1, At, B1); PG8_BAR;
            PG8_LDA(At, 0, 1); PG8_STAGE(PG8_SA(0, 0), a2, voffA);
            PG8_BAR; PG8_WAIT_L(0); PG8_MMA(1, 0, At, B0); PG8_BAR; PG8_SCHED;
            PG8_STAGE(PG8_SB(0, 1), b2 + hstep, voffB);
            PG8_WAIT_V(6); PG8_BAR; PG8_MMA(1, 1, At, B1); PG8_BAR;
            PG8_LDB(B0, 1, 0); PG8_SCHED; PG8_LDA(At, 1, 0); PG8_STAGE(PG8_SA(0, 1), a2 + hstep, voffA);
            PG8_WAIT_L(8); PG8_BAR; PG8_WAIT_L(0); PG8_MMA(0, 0, At, B0); PG8_BAR; PG8_SCHED;
            PG8_LDB(B1, 1, 1); PG8_STAGE(PG8_SB(1, 0), b3, voffB);
            PG8_BAR; PG8_WAIT_L(0); PG8_MMA(0, 1, At, B1); PG8_BAR;
            PG8_LDA(At, 1, 1); PG8_STAGE(PG8_SA(1, 0), a3, voffA);
            PG8_BAR; PG8_WAIT_L(0); PG8_MMA(1, 0, At, B0); PG8_BAR; PG8_SCHED;
            PG8_STAGE(PG8_SB(1, 1), b3 + hstep, voffB);
            PG8_WAIT_V(6); PG8_BAR; PG8_MMA(1, 1, At, B1); PG8_BAR;
            }
        }
        if constexpr (ALIGN_EPI) { if (wr == 0) PG8_BAR; }
        if constexpr (FP8) { asm volatile("s_nop 15\n\ts_nop 15" ::: "memory"); }
        if constexpr (!Epi::AFTER_DRAIN) { E(acc, cur, wr, wc, fr, fq); S.done(cur); }
        if (!has_next) break;
        if (!E.keep(cur))
#pragma unroll
        for (int a = 0; a < 2; ++a)
#pragma unroll
            for (int b = 0; b < 2; ++b)
#pragma unroll
                for (int m = 0; m < 4; ++m)
#pragma unroll
                    for (int n = 0; n < 2; ++n) acc[a][b][m][n] = (f32x4){0.f, 0.f, 0.f, 0.f};
        cur = nxt; cA = nA; cB = nB; ++ui;
        if constexpr (ALIGN_EPI) { if (wr == 1) PG8_BAR; }
    }
    PG8_WAIT_V(0);
    if constexpr (!ALIGN_EPI) { if (wr == 0) PG8_BAR; }
    PG8_BAR;
    if constexpr (Epi::AFTER_DRAIN) { E.fused(acc, cur, wr, wc, fr, fq, lds, wid, lane); S.done(cur); }
#undef PG8_SA
#undef PG8_SB
#undef PG8_STAGE
#undef PG8_LDA
#undef PG8_LDB
#undef PG8_MMA
#undef PG8_WAIT_V
#undef PG8_WAIT_L
#undef PG8_BAR
#undef PG8_SCHED
}

struct TripleOrder {
    StaticOrder so;
    __device__ void init(int M, int N, int G_, int c_) { so.init(M, N, G_, c_); }
    __device__ bool next(int i, Unit& u) const { if (!so.next(i / 3, u)) return false; u.pb = i % 3; return true; }
    __device__ __forceinline__ void a_ready(const Unit&) const {}
    __device__ __forceinline__ void done(const Unit&) const {}
};
struct GateOrder {
    StaticOrder so;
    __device__ void init(int M, int N, int G_, int c_) { so.init(M, N, G_, c_); }
    __device__ bool next(int i, Unit& u) const { if (!so.next(i / 3, u)) return false; u.pn += 4 * (i % 3); u.pb = 0; return true; }
    __device__ __forceinline__ void a_ready(const Unit&) const {}
    __device__ __forceinline__ void done(const Unit&) const {}
};
#define EPI_PIN8(a) asm volatile("" : "+v"(a[0][0]), "+v"(a[0][1]), "+v"(a[0][2]), "+v"(a[0][3]), "+v"(a[1][0]), "+v"(a[1][1]), "+v"(a[1][2]), "+v"(a[1][3]))
__device__ __forceinline__ void load_rs(const float* ssq, int row0, int fq, float (&rs)[2][4]) {
    f32x4 sv[2][4];
#pragma unroll
    for (int ai = 0; ai < 2; ++ai)
#pragma unroll
        for (int m = 0; m < 4; ++m) sv[ai][m] = *(const f32x4*)(ssq + (size_t)(row0 + ai * HALF + m * 16) * 16 + 4 * fq);
    EPI_PIN8(sv);
#pragma unroll
    for (int ai = 0; ai < 2; ++ai)
#pragma unroll
        for (int m = 0; m < 4; ++m) { const f32x4 v = sv[ai][m]; float t = (v.x + v.y) + (v.z + v.w); t = swap16_sum(t, t); t = swap32_sum(t, t); rs[ai][m] = rsqrtf(t * (1.0f / 1024.0f) + 1e-6f); }
}
template <bool BIAS>
struct EpiScaleT {
    static constexpr bool PERM = true, AFTER_DRAIN = false;
    bf16_t* O; int ldo; const float* ssq; int ncol0; float s0; bf16_t* VT;
    const float* bias; int bcol0;
    __device__ __forceinline__ bool keep(const Unit&) const { return false; }
    __device__ __forceinline__ void operator()(f32x4 (&acc)[2][2][4][2], const Unit& u, int wr, int wc, int fr, int fq) const {
        const int row0 = u.pm * BM + wr * 64 + fr, col0 = u.pn * BM + wc * 32 + 8 * fq;
        float rsv[2][4]; load_rs(ssq, row0, fq, rsv);
        f32x4 bv[2][2];
#pragma unroll
        for (int bj = 0; bj < 2; ++bj)
#pragma unroll
            for (int n = 0; n < 2; ++n) bv[bj][n] = (f32x4){0.f, 0.f, 0.f, 0.f};
        const bool gate = BIAS && (u.pn * BM >= bcol0);
        if constexpr (BIAS) { if (gate) {
#pragma unroll
            for (int bj = 0; bj < 2; ++bj)
#pragma unroll
                for (int n = 0; n < 2; ++n) bv[bj][n] = *(const f32x4*)(bias + (col0 + bj * HALF + 4 * n - bcol0));
        } }
#pragma unroll
        for (int ai = 0; ai < 2; ++ai)
#pragma unroll
            for (int m = 0; m < 4; ++m) {
                const int row = row0 + ai * HALF + m * 16;
                const float rs = rsv[ai][m];
#pragma unroll
                for (int bj = 0; bj < 2; ++bj) {
                    const int c = col0 + bj * HALF; const float sc = rs * (c < ncol0 ? s0 : 1.0f);
                    f32x4 v0 = acc[ai][bj][m][0] * sc, v1 = acc[ai][bj][m][1] * sc;
                    if constexpr (BIAS) { if (gate) {
                        v0 += bv[bj][0]; v1 += bv[bj][1];
#pragma unroll
                        for (int j = 0; j < 4; ++j) { v0[j] = 1.0f + __builtin_amdgcn_exp2f(fminf(v0[j] * -1.4426950408889634f, 43.28f)); v1[j] = 1.0f + __builtin_amdgcn_exp2f(fminf(v1[j] * -1.4426950408889634f, 43.28f)); }
                    } }
                    u32x4 w; w.x = cvt_pk_bf16(v0[0], v0[1]); w.y = cvt_pk_bf16(v0[2], v0[3]); w.z = cvt_pk_bf16(v1[0], v1[1]); w.w = cvt_pk_bf16(v1[2], v1[3]);
                    *(u32x4*)(O + (size_t)row * ldo + c) = w;
                    if (VT != nullptr && c >= 1024 && c < 1536) {
                        const int b = row >> 11, sq = row & 2047, cc = c - 1024;
                        bf16_t* vp = VT + ((size_t)(b * 512 + cc)) * 2048 + sq;
                        vp[0 * 2048] = (bf16_t)(w.x & 0xffffu); vp[1 * 2048] = (bf16_t)(w.x >> 16); vp[2 * 2048] = (bf16_t)(w.y & 0xffffu); vp[3 * 2048] = (bf16_t)(w.y >> 16);
                        vp[4 * 2048] = (bf16_t)(w.z & 0xffffu); vp[5 * 2048] = (bf16_t)(w.z >> 16); vp[6 * 2048] = (bf16_t)(w.w & 0xffffu); vp[7 * 2048] = (bf16_t)(w.w >> 16);
                    }
                }
            }
    }
};
typedef EpiScaleT<false> EpiScale;
struct EpiGate {
    static constexpr bool PERM = true, AFTER_DRAIN = false;
    unsigned char* O; int ldo; const float* ssq; const float* bias; float s0;
    __device__ __forceinline__ bool keep(const Unit&) const { return false; }
    __device__ __forceinline__ void operator()(f32x4 (&acc)[2][2][4][2], const Unit& u, int wr, int wc, int fr, int fq) const {
        asm volatile("" : "+v"(fr), "+v"(fq));
        const int row0 = u.pm * BM + wr * 64 + fr, col0 = u.pn * BM + wc * 32 + 8 * fq;
        float rsv[2][4]; load_rs(ssq, row0, fq, rsv);
        f32x4 bv[2][2];
#pragma unroll
        for (int bj = 0; bj < 2; ++bj)
#pragma unroll
            for (int n = 0; n < 2; ++n) bv[bj][n] = *(const f32x4*)(bias + col0 + bj * HALF + 4 * n) * -1.4426950408889634f;
#pragma unroll
        for (int ai = 0; ai < 2; ++ai)
#pragma unroll
            for (int m = 0; m < 4; ++m) {
                const int row = row0 + ai * HALF + m * 16;
                const float sc = rsv[ai][m] * s0 * -1.4426950408889634f;
#pragma unroll
                for (int bj = 0; bj < 2; ++bj) {
                    const int c = col0 + bj * HALF;
                    f32x4 v0 = acc[ai][bj][m][0] * sc + bv[bj][0], v1 = acc[ai][bj][m][1] * sc + bv[bj][1];
#pragma unroll
                    for (int j = 0; j < 4; ++j) {
                        v0[j] = __builtin_amdgcn_fmed3f(256.0f * __builtin_amdgcn_rcpf(1.0f + __builtin_amdgcn_exp2f(fminf(v0[j], 43.28f))), 1.0f, 255.0f);
                        v1[j] = __builtin_amdgcn_fmed3f(256.0f * __builtin_amdgcn_rcpf(1.0f + __builtin_amdgcn_exp2f(fminf(v1[j], 43.28f))), 1.0f, 255.0f); }
                    u32x2 w;
                    w.x = __builtin_amdgcn_cvt_pk_u8_f32(v0[3], 3, __builtin_amdgcn_cvt_pk_u8_f32(v0[2], 2, __builtin_amdgcn_cvt_pk_u8_f32(v0[1], 1, __builtin_amdgcn_cvt_pk_u8_f32(v0[0], 0, 0u))));
                    w.y = __builtin_amdgcn_cvt_pk_u8_f32(v1[3], 3, __builtin_amdgcn_cvt_pk_u8_f32(v1[2], 2, __builtin_amdgcn_cvt_pk_u8_f32(v1[1], 1, __builtin_amdgcn_cvt_pk_u8_f32(v1[0], 0, 0u))));
                    *(u32x2*)(O + (size_t)row * ldo + c) = w;
                }
            }
    }
};
struct EpiKV {
    static constexpr bool PERM = true, AFTER_DRAIN = false;
    bf16_t* O; bf16_t* VT; const float* ssq;
    __device__ __forceinline__ bool keep(const Unit&) const { return false; }
    __device__ __forceinline__ void operator()(f32x4 (&acc)[2][2][4][2], const Unit& u, int wr, int wc, int fr, int fq) const {
        const int row0 = u.pm * BM + wr * 64 + fr, col0 = u.pn * BM + wc * 32 + 8 * fq;
        float rsv[2][4]; load_rs(ssq, row0, fq, rsv);
#pragma unroll
        for (int ai = 0; ai < 2; ++ai)
#pragma unroll
            for (int m = 0; m < 4; ++m) {
                const int row = row0 + ai * HALF + m * 16;
                const float rs = rsv[ai][m];
#pragma unroll
                for (int bj = 0; bj < 2; ++bj) {
                    const int cfull = col0 + bj * HALF, layer = cfull >> 11, c = cfull & 2047;
                    const f32x4 v0 = acc[ai][bj][m][0] * rs, v1 = acc[ai][bj][m][1] * rs;
                    u32x4 w; w.x = cvt_pk_bf16(v0[0], v0[1]); w.y = cvt_pk_bf16(v0[2], v0[3]); w.z = cvt_pk_bf16(v1[0], v1[1]); w.w = cvt_pk_bf16(v1[2], v1[3]);
                    if (c < 1024) { *(u32x4*)(O + (size_t)layer * TM * 2048 + (size_t)row * 2048 + c) = w; }
                    else {
                        const int b = row >> 8, mem = row & 255, cc = c - 1024;
                        bf16_t* vp = VT + (size_t)layer * (8 * 4 * 256 * 256) + ((size_t)(b * 4 + (cc >> 8)) * 256 + (cc & 255)) * 256 + mem;
                        vp[0 * 256] = (bf16_t)(w.x & 0xffffu); vp[1 * 256] = (bf16_t)(w.x >> 16); vp[2 * 256] = (bf16_t)(w.y & 0xffffu); vp[3 * 256] = (bf16_t)(w.y >> 16);
                        vp[4 * 256] = (bf16_t)(w.z & 0xffffu); vp[5 * 256] = (bf16_t)(w.z >> 16); vp[6 * 256] = (bf16_t)(w.w & 0xffffu); vp[7 * 256] = (bf16_t)(w.w >> 16);
                    }
                }
            }
    }
};
template <bool W8>
struct EpiResidualT {
    static constexpr bool PERM = true, AFTER_DRAIN = false;
    bf16_t* HB; float* ssq;
    static constexpr float scale = 1.0f / (16.f * 512.f);
    __device__ __forceinline__ bool keep(const Unit&) const { return false; }
    __device__ __forceinline__ void operator()(f32x4 (&acc)[2][2][4][2], const Unit& u, int wr, int wc, int fr, int fq) const {
        asm volatile("" : "+v"(fr), "+v"(fq));
        const int row0 = u.pm * BM + wr * 64 + fr, col0 = u.pn * BM + wc * 32 + 8 * fq;
        u32x4 h0[2][4], h1[2][4];
#pragma unroll
        for (int ai = 0; ai < 2; ++ai)
#pragma unroll
            for (int m = 0; m < 4; ++m) { const bf16_t* hp = HB + (size_t)(row0 + ai * HALF + m * 16) * D + col0; h0[ai][m] = *(const u32x4*)hp; h1[ai][m] = *(const u32x4*)(hp + HALF); }
        EPI_PIN8(h0); EPI_PIN8(h1);
#pragma unroll
        for (int ai = 0; ai < 2; ++ai)
#pragma unroll
            for (int m = 0; m < 4; ++m) {
                const int row = row0 + ai * HALF + m * 16; float sq = 0.f;
#pragma unroll
                for (int bj = 0; bj < 2; ++bj) {
                    const int c = col0 + bj * HALF;
                    const u32x4 hv = bj ? h1[ai][m] : h0[ai][m];
                    const f32x4 a = (f32x4){bflo(hv.x), bfhi(hv.x), bflo(hv.y), bfhi(hv.y)} + acc[ai][bj][m][0] * scale, b = (f32x4){bflo(hv.z), bfhi(hv.z), bflo(hv.w), bfhi(hv.w)} + acc[ai][bj][m][1] * scale;
                    u32x4 w; w.x = cvt_pk_bf16(a[0], a[1]); w.y = cvt_pk_bf16(a[2], a[3]); w.z = cvt_pk_bf16(b[0], b[1]); w.w = cvt_pk_bf16(b[2], b[3]);
                    *(u32x4*)(HB + (size_t)row * D + c) = w;
                    const float r0 = bflo(w.x), r1 = bfhi(w.x), r2 = bflo(w.y), r3 = bfhi(w.y), r4 = bflo(w.z), r5 = bfhi(w.z), r6 = bflo(w.w), r7 = bfhi(w.w);
                    if constexpr (W8) { u32x2 q; q.x = pk4_fp8(r0, r1, r2, r3, 16.f); q.y = pk4_fp8(r4, r5, r6, r7, 16.f); *(u32x2*)((unsigned char*)HB + ((ptrdiff_t)WS_HB8 - (ptrdiff_t)WS_HB) + (size_t)row * D + c) = q; }
                    sq += (r0 * r0 + r1 * r1) + (r2 * r2 + r3 * r3) + (r4 * r4 + r5 * r5) + (r6 * r6 + r7 * r7);
                }
                sq = swap16_sum(sq, sq); sq = swap32_sum(sq, sq);
                if (fq == 0) ssq[(size_t)row * 16 + u.pn * 4 + wc] = sq;
            }
    }
};
struct EpiMerged {
    static constexpr bool PERM = true, AFTER_DRAIN = false;
    const unsigned char* Pg;
    unsigned char* O;
    __device__ __forceinline__ bool keep(const Unit& u) const { return u.pb < 2; }
    template <bool NX> __device__ __forceinline__ void body(f32x4 (&acc)[2][2][4][2], const Unit& u, int wr, int wc, int fr, int fq) const {
        const int row0 = u.pm * BM + wr * 64 + fr, col0 = u.pn * BM + wc * 32 + 8 * fq, b = u.pb;
#pragma unroll
        for (int ai = 0; ai < 2; ++ai) {
            u32x2 zb[2][4], zn[2][4];
#pragma unroll
            for (int m = 0; m < 4; ++m)
#pragma unroll
                for (int bj = 0; bj < 2; ++bj) {
                    const unsigned char* gp = Pg + (size_t)(row0 + ai * HALF + m * 16) * (INW * 2) + b * D + col0 + bj * HALF;
                    zb[bj][m] = *(const u32x2*)gp;
                    if constexpr (NX) zn[bj][m] = *(const u32x2*)(gp + D);
                }
            EPI_PIN8(zb); if constexpr (NX) EPI_PIN8(zn);
#pragma unroll
            for (int m = 0; m < 4; ++m) {
                const int row = row0 + ai * HALF + m * 16;
#pragma unroll
                for (int bj = 0; bj < 2; ++bj) {
                    const int c = col0 + bj * HALF;
                    float f[8];
#pragma unroll
                    for (int j = 0; j < 8; ++j) {
                        const float qb = (float)((zb[bj][m][j >> 2] >> (8 * (j & 3))) & 0xffu);
                        if constexpr (NX) { const float qn = (float)((zn[bj][m][j >> 2] >> (8 * (j & 3))) & 0xffu); f[j] = qb * __builtin_amdgcn_rcpf(qn); }
                        else f[j] = qb * (1.0f / 256.0f);
                    }
                    f32x4 v0 = acc[ai][bj][m][0], v1 = acc[ai][bj][m][1];
                    v0[0] *= f[0]; v0[1] *= f[1]; v0[2] *= f[2]; v0[3] *= f[3]; v1[0] *= f[4]; v1[1] *= f[5]; v1[2] *= f[6]; v1[3] *= f[7];
                    if constexpr (NX) { acc[ai][bj][m][0] = v0; acc[ai][bj][m][1] = v1; }
                    if constexpr (!NX) {
                        u32x2 w; w.x = pk4_fp8(v0[0], v0[1], v0[2], v0[3], 16.f); w.y = pk4_fp8(v1[0], v1[1], v1[2], v1[3], 16.f);
                        *(u32x2*)(O + (size_t)row * D + c) = w;
                    }
                }
            }
        }
    }
    __device__ __forceinline__ void operator()(f32x4 (&acc)[2][2][4][2], const Unit& u, int wr, int wc, int fr, int fq) const {
        if (u.pb < 2) body<true>(acc, u, wr, wc, fr, fq); else body<false>(acc, u, wr, wc, fr, fq);
    }
};
}

typedef __attribute__((address_space(3))) unsigned char* lds_ptr;
__device__ __forceinline__ void ph_gemm_p(const P& p, int l, int bid, int nb, lds_ptr lds) {
    {
        pg8::Gemm g{(const bf16_t*)(p.ws + WS_HB), (const bf16_t*)(p.ws + WS_WIN), D, 0, 0}; pg8::StaticOrder S; S.init(T, OFF_GATE, nb, bid);
        pg8::EpiScale E{(bf16_t*)(p.ws + WS_P), INW, (const float*)(p.ws + WS_SSQ), 512, 0.125f * 1.4426950408889634f, (bf16_t*)(p.ws + WS_SBVT), nullptr, 0};
        pg8::gemm_phase<pg8::EpiScale, pg8::StaticOrder, true, true>(lds, g, S, E);
    }
}
__device__ __forceinline__ void ph_gemm_kv(const P& p, int bid, int nb, lds_ptr lds) {
    pg8::Gemm g{(const bf16_t*)(p.ws + WS_MEMB), (const bf16_t*)(p.ws + WS_WKV2), D, 0, 0}; pg8::StaticOrder S; S.init(TM, 2 * 2 * D, nb, bid);
    pg8::EpiKV E{(bf16_t*)(p.ws + WS_KV2), (bf16_t*)(p.ws + WS_VT2), (const float*)(p.ws + WS_MEMSSQ)};
    pg8::gemm_phase<pg8::EpiKV, pg8::StaticOrder, true, true>(lds, g, S, E);
}
__device__ __forceinline__ void ph_merged(const P& p, int l, int bid, int nb, lds_ptr lds) {
    {
        pg8::Gemm g{(const bf16_t*)(p.ws + WS_HB8), (const bf16_t*)(p.ws + WS_WG8), D / 2, 0, 0}; pg8::GateOrder S; S.init(T, D, nb, bid);
        pg8::EpiGate E{p.ws + WS_P + (size_t)OFF_GATE * 2, INW * 2, (const float*)(p.ws + WS_SSQ), p.b_gate + (size_t)l * 3 * D, 1.0f / (16.f * 512.f)};
        pg8::gemm_phase<pg8::EpiGate, pg8::GateOrder, true, true, true>(lds, g, S, E);
    }
    pg8::Gemm g{(const bf16_t*)(p.ws + WS_Y), (const bf16_t*)(p.ws + WS_WBR), 512, (size_t)T * 512 * 2, (size_t)1024 * 512 * 2}; pg8::TripleOrder S; S.init(T, D, nb, bid);
    pg8::EpiMerged E{p.ws + WS_P + (size_t)OFF_GATE * 2, p.ws + WS_MERGED};
    pg8::gemm_phase<pg8::EpiMerged, pg8::TripleOrder, true, true>(lds, g, S, E);
}
__device__ __forceinline__ void ph_gemm_wout(const P& p, int bid, int nb, lds_ptr lds) {
    pg8::Gemm g{(const bf16_t*)(p.ws + WS_MERGED), (const bf16_t*)(p.ws + WS_WOUT), D / 2, 0, 0}; pg8::StaticOrder S; S.init(T, D, nb, bid);
    pg8::EpiResidualT<true> E{(bf16_t*)(p.ws + WS_HB), (float*)(p.ws + WS_SSQ)};
    pg8::gemm_phase<pg8::EpiResidualT<true>, pg8::StaticOrder, true, true, true>(lds, g, S, E);
}
__device__ __forceinline__ void ph_gemm_xq(const P& p, int bid, int nb, lds_ptr lds) {
    pg8::Gemm g{(const bf16_t*)(p.ws + WS_HB8), (const bf16_t*)(p.ws + WS_WXQ), D / 2, 0, 0}; pg8::StaticOrder S; S.init(T, D, nb, bid);
    pg8::EpiScale E{(bf16_t*)(p.ws + WS_XQ), D, (const float*)(p.ws + WS_SSQ), D, 0.0625f / (16.f * 512.f), nullptr, nullptr, 0};
    pg8::gemm_phase<pg8::EpiScale, pg8::StaticOrder, true, true, true>(lds, g, S, E);
}
__device__ __forceinline__ int xq_unit(int bid, int nb) { pg8::StaticOrder S; S.init(T, D, nb, bid); pg8::Unit u; if (!S.next(0, u)) return 1 << 30; return (u.pm >> 3) * 32 + u.pn * 8 + (u.pm & 7); }
__device__ __forceinline__ void ph_gemm_wo(const P& p, int bid, int nb, lds_ptr lds) {
    pg8::Gemm g{(const bf16_t*)(p.ws + WS_XO), (const bf16_t*)(p.ws + WS_WO), D / 2, 0, 0}; pg8::StaticOrder S; S.init(T, D, nb, bid);
    pg8::EpiResidualT<true> E{(bf16_t*)(p.ws + WS_HB), (float*)(p.ws + WS_SSQ)};
    pg8::gemm_phase<pg8::EpiResidualT<true>, pg8::StaticOrder, true, true, true>(lds, g, S, E);
}
__device__ __forceinline__ void ph_gemm_pq(const P& p, int bid, int nb, lds_ptr lds) {
    pg8::Gemm g{(const bf16_t*)(p.ws + WS_HB8), (const bf16_t*)(p.ws + WS_WPQ), D / 2, 0, 0}; pg8::StaticOrder S; S.init(T, PQW, nb, bid);
    pg8::EpiScale E{(bf16_t*)(p.ws + WS_PQ), PQW, (const float*)(p.ws + WS_SSQ), PQW, 1.0f / (16.f * 512.f), nullptr, nullptr, 0};
    pg8::gemm_phase<pg8::EpiScale, pg8::StaticOrder, true, true, true>(lds, g, S, E);
}

typedef float f32x16 __attribute__((ext_vector_type(16)));
typedef __bf16 bf16x2_t __attribute__((ext_vector_type(2)));
typedef float f32x2_t __attribute__((ext_vector_type(2)));
#define MFMA32(a, b, c) __builtin_amdgcn_mfma_f32_32x32x16_bf16((a), (b), (c), 0, 0, 0)
__device__ __forceinline__ unsigned cvtpk(float lo, float hi) { f32x2_t v = {lo, hi}; return __builtin_bit_cast(unsigned, __builtin_convertvector(v, bf16x2_t)); }
__device__ __forceinline__ bf16x8 pack8(const f32x16& x, int s2) {
    u32x4 w; w.x = cvtpk(x[8 * s2], x[8 * s2 + 1]); w.y = cvtpk(x[8 * s2 + 2], x[8 * s2 + 3]); w.z = cvtpk(x[8 * s2 + 4], x[8 * s2 + 5]); w.w = cvtpk(x[8 * s2 + 6], x[8 * s2 + 7]);
    return __builtin_bit_cast(bf16x8, w);
}
__device__ __forceinline__ void ph_sb_attn(const P& p, int bid, int nb, __attribute__((address_space(3))) unsigned char* lds) {
    const int tid = get_tid(), lane = tid & 63, wid = __builtin_amdgcn_readfirstlane(tid >> 6), r = lane & 31, hh = lane >> 5;
    GAS unsigned char* wsg = (GAS unsigned char*)p.ws;
    const GAS bf16_t* PP = (const GAS bf16_t*)(wsg + WS_P); const GAS bf16_t* VT = (const GAS bf16_t*)(wsg + WS_SBVT); GAS bf16_t* Y = (GAS bf16_t*)(wsg + WS_Y);
    bf16x8 uneg[2], oneg;
#pragma unroll
    for (int s2 = 0; s2 < 2; ++s2)
#pragma unroll
        for (int j = 0; j < 8; ++j) { const int k = 16 * s2 + 8 * (j >> 2) + 4 * hh + (j & 3); uneg[s2][j] = (k > r) ? (short)0xBF80 : (short)0; }
#pragma unroll
    for (int j = 0; j < 8; ++j) oneg[j] = (short)0xBF80;
    constexpr int KP = 144, VP = 912, VOFF = 448 * KP;
#pragma unroll 1
    for (int rnd = 0; rnd < 2; ++rnd) {
        if (bid >= 256) break;
        const int bh = bid & 63, b = bh >> 3, h = bh & 7;
        const int Q0 = (((bid >> 6) & 3) * 16 + rnd * 8) * 32, W0 = Q0 >= 192 ? Q0 - 192 : 0, wsz = Q0 + 256 - W0;
        const int qt = (Q0 >> 5) + wid, q0 = qt * 32;
        const GAS bf16_t* prow = PP + (size_t)(b * SEQ) * INW + h * 64 + 8 * hh;
        const GAS bf16_t* vtb = VT + ((size_t)bh * 64 + r) * 2048 + 4 * hh;
        {
            u32x4 rk[7], rv[7];
#pragma unroll
            for (int i = 0; i < 7; ++i) {
                const int c = tid + 512 * i, row = c >> 3, ck = c & 7;
                rk[i] = (u32x4){0u, 0u, 0u, 0u};
                if (row < wsz) rk[i] = *(const GAS u32x4*)(PP + (size_t)(b * SEQ + W0 + row) * INW + 512 + h * 64 + ck * 8);
                const int d = c / 56, cv = c - d * 56;
                rv[i] = (u32x4){0u, 0u, 0u, 0u};
                if (cv * 8 < wsz) rv[i] = *(const GAS u32x4*)(VT + ((size_t)bh * 64 + d) * 2048 + W0 + cv * 8);
            }
#pragma unroll
            for (int i = 0; i < 7; ++i) {
                const int c = tid + 512 * i, row = c >> 3, ck = c & 7, d = c / 56, cv = c - d * 56;
                *(__attribute__((address_space(3))) u32x4*)(lds + row * KP + ck * 16) = rk[i];
                *(__attribute__((address_space(3))) u32x4*)(lds + VOFF + d * VP + cv * 16) = rv[i];
            }
        }
        bf16x8 qf[4];
#pragma unroll
        for (int ks = 0; ks < 4; ++ks) qf[ks] = *(const GAS bf16x8*)(prow + (size_t)(q0 + r) * INW + 16 * ks);
        __syncthreads();
        f32x16 o0, o1, C;
#pragma unroll
        for (int i = 0; i < 16; ++i) { o0[i] = 0.f; o1[i] = 0.f; C[i] = 0.f; }
#pragma unroll 1
        for (int kt = qt; kt >= 0; --kt) {
            const int k0 = kt * 32;
            bf16x8 kf[4]; u32x2 vlo[2][2], vhi[2][2];
            if (k0 >= W0) {
                const __attribute__((address_space(3))) unsigned char* kl = lds + (k0 - W0 + r) * KP + 16 * hh;
#pragma unroll
                for (int ks = 0; ks < 4; ++ks) kf[ks] = *(const __attribute__((address_space(3))) bf16x8*)(kl + 32 * ks);
                const __attribute__((address_space(3))) unsigned char* vl = lds + VOFF + r * VP + (k0 - W0 + 4 * hh) * 2;
#pragma unroll
                for (int dt = 0; dt < 2; ++dt)
#pragma unroll
                    for (int s2 = 0; s2 < 2; ++s2) { vlo[dt][s2] = *(const __attribute__((address_space(3))) u32x2*)(vl + dt * 32 * VP + 32 * s2); vhi[dt][s2] = *(const __attribute__((address_space(3))) u32x2*)(vl + dt * 32 * VP + 32 * s2 + 16); }
            } else {
#pragma unroll
                for (int ks = 0; ks < 4; ++ks) kf[ks] = *(const GAS bf16x8*)(prow + (size_t)(k0 + r) * INW + 512 + 16 * ks);
#pragma unroll
                for (int dt = 0; dt < 2; ++dt)
#pragma unroll
                    for (int s2 = 0; s2 < 2; ++s2) { vlo[dt][s2] = *(const GAS u32x2*)(vtb + (size_t)dt * 32 * 2048 + k0 + 16 * s2); vhi[dt][s2] = *(const GAS u32x2*)(vtb + (size_t)dt * 32 * 2048 + k0 + 16 * s2 + 8); }
            }
            f32x16 z;
#pragma unroll
            for (int i = 0; i < 16; ++i) z[i] = 0.f;
#pragma unroll
            for (int ks = 0; ks < 4; ++ks) z = MFMA32(kf[ks], qf[ks], z);
            f32x16 X, LB;
            const bool diag = (kt == qt);
#pragma unroll
            for (int i = 0; i < 16; ++i) {
                const float zz = z[i];
                const float e = __builtin_amdgcn_exp2f(-fabsf(zz));
                const float sp = fmaxf(zz, 0.f) + __builtin_amdgcn_logf(1.0f + e);
                const bool valid = !diag || (((i & 3) + 8 * (i >> 2) + 4 * hh) < r);
                X[i] = valid ? sp : 0.f;
                LB[i] = valid ? (zz - sp) : -1.0e30f;
            }
            const bf16x8 x0 = pack8(X, 0), x1 = pack8(X, 1);
            f32x16 A = MFMA32(uneg[0], x0, C); A = MFMA32(uneg[1], x1, A);
            f32x16 Cn = MFMA32(oneg, x0, C); Cn = MFMA32(oneg, x1, Cn);
#pragma unroll
            for (int i = 0; i < 16; ++i) A[i] = __builtin_amdgcn_exp2f(LB[i] + A[i]);
            const bf16x8 p0 = pack8(A, 0), p1 = pack8(A, 1);
            { u32x4 a4; a4.x = vlo[0][0].x; a4.y = vlo[0][0].y; a4.z = vhi[0][0].x; a4.w = vhi[0][0].y; o0 = MFMA32(__builtin_bit_cast(bf16x8, a4), p0, o0); }
            { u32x4 a4; a4.x = vlo[0][1].x; a4.y = vlo[0][1].y; a4.z = vhi[0][1].x; a4.w = vhi[0][1].y; o0 = MFMA32(__builtin_bit_cast(bf16x8, a4), p1, o0); }
            { u32x4 a4; a4.x = vlo[1][0].x; a4.y = vlo[1][0].y; a4.z = vhi[1][0].x; a4.w = vhi[1][0].y; o1 = MFMA32(__builtin_bit_cast(bf16x8, a4), p0, o1); }
            { u32x4 a4; a4.x = vlo[1][1].x; a4.y = vlo[1][1].y; a4.z = vhi[1][1].x; a4.w = vhi[1][1].y; o1 = MFMA32(__builtin_bit_cast(bf16x8, a4), p1, o1); }
            C = Cn;
            if (__all(C[0] < -160.f)) break;
        }
        GAS bf16_t* yp = Y + (size_t)(b * SEQ + q0 + r) * 512 + h * 64 + 4 * hh;
#pragma unroll
        for (int g = 0; g < 4; ++g) {
            u32x2 w0; w0.x = cvtpk(o0[4 * g], o0[4 * g + 1]); w0.y = cvtpk(o0[4 * g + 2], o0[4 * g + 3]);
            u32x2 w1; w1.x = cvtpk(o1[4 * g], o1[4 * g + 1]); w1.y = cvtpk(o1[4 * g + 2], o1[4 * g + 3]);
            *(GAS u32x2*)(yp + 8 * g) = w0; *(GAS u32x2*)(yp + 32 + 8 * g) = w1;
        }
        __syncthreads();
    }
}
typedef __attribute__((address_space(3))) float* lds_fptr;
#define LASX __attribute__((address_space(3)))
__device__ __forceinline__ void ph_conv(const P& p, int l, int bid, int nb, LASX unsigned char* lds) {
    const int tid0 = get_tid(), wid = __builtin_amdgcn_readfirstlane(tid0 >> 6);
    GAS unsigned char* wsg = (GAS unsigned char*)p.ws;
    const GAS bf16_t* PP = (const GAS bf16_t*)(wsg + WS_P); GAS bf16_t* Y = (GAS bf16_t*)(wsg + WS_Y);
    const GAS float* dw = (const GAS float*)p.conv_dw_w + (size_t)l * 31 * 512; const GAS float* scw = (const GAS float*)p.sc_w + (size_t)l * 3 * 512;
    float w[31];
#pragma unroll
    for (int j = 0; j < 31; ++j) w[j] = dw[j * 512 + tid0];
    const float w0 = scw[tid0], w1 = scw[512 + tid0], w2 = scw[1024 + tid0];
    const float db = ((const GAS float*)p.conv_dw_b)[l * 512 + tid0], lg = ((const GAS float*)p.conv_ln_g)[l * 512 + tid0], lb = ((const GAS float*)p.conv_ln_b)[l * 512 + tid0];
    const LASX float* stat = (const LASX float*)(lds + 131072);
    LASX float* statw = (LASX float*)(lds + 131072);
#pragma unroll 1
    for (int it = bid; it < T / 32; it += nb) {
        const int tile = (nb == 256) ? ((it & 7) * 64 + ((it >> 3) & 31) + 32 * (it >> 8)) : it;
        const int tok0 = tile * 32, t0 = tok0 & (SEQ - 1);
        int tid = tid0; asm volatile("" : "+v"(tid));
        const int c = tid, lane = tid & 63;
        const GAS bf16_t* tb = PP + (size_t)tok0 * INW;
        {
            u32x4 r[16];
#pragma unroll
            for (int i = 0; i < 16; ++i) {
                const int ch = tid + 512 * i, row = ch >> 7, c16 = ch & 127; const bool ok = (t0 + row - 30 >= 0);
                r[i] = (u32x4){0u, 0u, 0u, 0u};
                if (i < 15 || ch < 62 * 128) { const u32x4 v = *(const GAS u32x4*)(tb + (ptrdiff_t)(ok ? row - 30 : 0) * INW + OFF_CV + c16 * 8); r[i] = ok ? v : (u32x4){0u, 0u, 0u, 0u}; }
            }
#pragma unroll
            for (int i = 0; i < 16; ++i) { const int ch = tid + 512 * i; if (i < 15 || ch < 62 * 128) *(LASX u32x4*)(lds + (ch >> 7) * 2048 + (ch & 127) * 16) = r[i]; }
        }
        __syncthreads();
        float o32[32];
        {
            float u[62];
#pragma unroll
            for (int i = 0; i < 62; ++i) {
                const float val = bf2f(*(const LASX bf16_t*)(lds + i * 2048 + c * 2)), gt = bf2f(*(const LASX bf16_t*)(lds + i * 2048 + 1024 + c * 2));
                u[i] = val * __builtin_amdgcn_rcpf(1.0f + __expf(-gt));
            }
#pragma unroll
            for (int i = 0; i < 32; ++i) {
                float acc = db;
#pragma unroll
                for (int j = 0; j < 31; ++j) asm("v_fmac_f32 %0, %1, %2" : "+v"(acc) : "v"(w[j]), "v"(u[i + j]));
                o32[i] = acc;
            }
        }
        {
            const bool h8 = (lane & 8) != 0, h4 = (lane & 4) != 0, h2 = (lane & 2) != 0, h1 = (lane & 1) != 0;
#pragma unroll
            for (int st = 0; st < 2; ++st) {
                float v[32];
#pragma unroll
                for (int i = 0; i < 32; ++i) { const float x = st ? o32[i] * o32[i] : o32[i]; v[i] = swap32_sum(x, x); }
#pragma unroll
                for (int i = 0; i < 16; ++i) v[i] = swap16_sum(v[i], v[i + 16]);
#pragma unroll
                for (int i = 0; i < 8; ++i) v[i] = (h8 ? v[i + 8] : v[i]) + dppf<0x128>(h8 ? v[i] : v[i + 8]);
#pragma unroll
                for (int i = 0; i < 4; ++i) v[i] = (h4 ? v[i + 4] : v[i]) + dppf<0x141>(dppf<0x1B>(h4 ? v[i] : v[i + 4]));
#pragma unroll
                for (int i = 0; i < 2; ++i) v[i] = (h2 ? v[i + 2] : v[i]) + dppf<0x4E>(h2 ? v[i] : v[i + 2]);
                v[0] = (h1 ? v[1] : v[0]) + dppf<0xB1>(h1 ? v[0] : v[1]);
                if (lane < 32) statw[st * 256 + wid * 32 + lane] = v[0];
            }
        }
        __syncthreads();
        if (tid < 64) { float t = 0.f; const int st = tid >> 5, tk = tid & 31;
#pragma unroll
            for (int k = 0; k < 8; ++k) t += stat[st * 256 + k * 32 + tk];
            statw[512 + tid] = t; }
        {
            u32x4 r[13];
#pragma unroll
            for (int i = 0; i < 13; ++i) {
                const int ch = tid + 512 * i;
                r[i] = (u32x4){0u, 0u, 0u, 0u};
                if (i < 8 || ch < 34 * 128) { const int row = ch >> 7, c16 = ch & 127; const bool ok = (t0 + row - 2 >= 0);
                    const u32x4 v = *(const GAS u32x4*)(tb + (ptrdiff_t)(ok ? row - 2 : 0) * INW + OFF_SC + 512 + c16 * 8); r[i] = ok ? v : (u32x4){0u, 0u, 0u, 0u}; }
                else if (ch < 34 * 128 + 32 * 64) { const int c2 = ch - 34 * 128; r[i] = *(const GAS u32x4*)(tb + (size_t)(c2 >> 6) * INW + OFF_SC + (c2 & 63) * 8); }
            }
#pragma unroll
            for (int i = 0; i < 13; ++i) {
                const int ch = tid + 512 * i;
                if (i < 8 || ch < 34 * 128) *(LASX u32x4*)(lds + (ch >> 7) * 2048 + (ch & 127) * 16) = r[i];
                else if (ch < 34 * 128 + 32 * 64) { const int c2 = ch - 34 * 128; *(LASX u32x4*)(lds + 69632 + (c2 >> 6) * 1024 + (c2 & 63) * 16) = r[i]; }
            }
        }
        __syncthreads();
        GAS bf16_t* ycv = Y + (size_t)T * 512 + (size_t)tok0 * 512;
#pragma unroll
        for (int i = 0; i < 32; ++i) {
            const float mean = stat[512 + i] * (1.0f / 512.0f), var = fmaxf(stat[512 + 32 + i] * (1.0f / 512.0f) - mean * mean, 0.f);
            const float yv = (o32[i] - mean) * rsqrtf(var + 1e-5f) * lg + lb;
            GAS bf16_t* yr = ycv + i * 512; asm volatile("" : "+s"(yr));
            yr[c] = (bf16_t)f2bf(yv * __builtin_amdgcn_rcpf(1.0f + __expf(-yv)));
        }
        {
            float gx[34];
#pragma unroll
            for (int i = 0; i < 34; ++i) gx[i] = bf2f(*(const LASX bf16_t*)(lds + i * 2048 + c * 2)) * bf2f(*(const LASX bf16_t*)(lds + i * 2048 + 1024 + c * 2));
            GAS bf16_t* ysc = Y + (size_t)2 * T * 512 + (size_t)tok0 * 512;
#pragma unroll
            for (int i = 0; i < 32; ++i) {
                const float sc = fmaf(w2, gx[i + 2], fmaf(w1, gx[i + 1], w0 * gx[i]));
                GAS bf16_t* yr = ysc + i * 512; asm volatile("" : "+s"(yr));
                yr[c] = (bf16_t)f2bf(bf2f(*(const LASX bf16_t*)(lds + 69632 + i * 1024 + c * 2)) * sc);
            }
        }
        __syncthreads();
    }
}

#define MFMA16(a, b, c) __builtin_amdgcn_mfma_f32_16x16x32_bf16((a), (b), (c), 0, 0, 0)
#define XA_PITCH 528
#define XA_LOAD(regs, src, pitch) do { int tl_ = tid; asm volatile("" : "+v"(tl_)); _Pragma("unroll") for (int i_ = 0; i_ < 16; ++i_) { const int ch_ = tl_ + 512 * i_; regs[i_] = *(const GAS u32x4*)((const GAS char*)(src) + (size_t)(ch_ >> 5) * (pitch) + (ch_ & 31) * 16); } } while (0)
#define XA_STORE(regs) do { int tl_ = tid; asm volatile("" : "+v"(tl_)); _Pragma("unroll") for (int i_ = 0; i_ < 16; ++i_) { const int ch_ = tl_ + 512 * i_; *(LASX u32x4*)(lds + (ch_ >> 5) * XA_PITCH + (ch_ & 31) * 16) = regs[i_]; } } while (0)
__device__ __forceinline__ void ph_xattn(const P& p, int l, int unit0, int nb, LASX unsigned char* lds) {
    const int tid = get_tid(), lane = tid & 63, wid = __builtin_amdgcn_readfirstlane(tid >> 6), r = lane & 31, hh = lane >> 5;
    GAS unsigned char* wsg = (GAS unsigned char*)p.ws;
    const GAS bf16_t* XQ = (const GAS bf16_t*)(wsg + WS_XQ); const GAS bf16_t* KV = (const GAS bf16_t*)(wsg + WS_KV2) + (size_t)l * TM * 2048; const GAS bf16_t* VT = (const GAS bf16_t*)(wsg + WS_VT2) + (size_t)l * (8 * 4 * 256 * 256);
    GAS unsigned char* XO = wsg + WS_XO;
    constexpr int NU = BATCH * 4 * 8;
    u32x4 st[16];
    if (unit0 < NU) { const int b = unit0 >> 5, hd = (unit0 >> 3) & 3; XA_LOAD(st, KV + (size_t)(b * NMEM) * 2048 + hd * 256, 4096); }
#pragma unroll 1
    for (int unit = unit0; unit < NU; unit += nb) {
        const int b = unit >> 5, hd = (unit >> 3) & 3, qt = unit & 7;
        const int tok0 = b * SEQ + qt * 256 + wid * 32;
        XA_STORE(st);
        const GAS bf16_t* qp = XQ + (size_t)(tok0 + r) * D + hd * 256 + hh * 8;
        bf16x8 qf[8];
#pragma unroll
        for (int ks = 0; ks < 8; ++ks) qf[ks] = *(const GAS bf16x8*)(qp + ks * 16);
        __syncthreads();
        f32x16 sacc[8];
        const LASX unsigned char* kl = lds + r * XA_PITCH + hh * 16;
#pragma unroll
        for (int t = 0; t < 8; ++t)
#pragma unroll
            for (int i = 0; i < 16; ++i) sacc[t][i] = 0.f;
#pragma unroll
        for (int hf = 0; hf < 2; ++hf) {
            if (hf == 1) {
#pragma unroll
                for (int ks = 0; ks < 8; ++ks) qf[ks] = *(const GAS bf16x8*)(qp + (8 + ks) * 16);
            }
#pragma unroll
            for (int t = 0; t < 8; ++t) {
#pragma unroll
                for (int ks = 0; ks < 8; ++ks) { const bf16x8 kf = *(const LASX bf16x8*)(kl + t * 32 * XA_PITCH + (8 * hf + ks) * 32); sacc[t] = MFMA32(kf, qf[ks], sacc[t]); }
            }
            __builtin_amdgcn_sched_barrier(0);
        }
        float mx = -3.0e38f;
#pragma unroll
        for (int t = 0; t < 8; ++t)
#pragma unroll
            for (int i = 0; i < 16; ++i) mx = fmaxf(mx, sacc[t][i]);
        { auto rr = __builtin_amdgcn_permlane32_swap(__float_as_uint(mx), __float_as_uint(mx), false, false); mx = fmaxf(__uint_as_float(rr[0]), __uint_as_float(rr[1])); }
        float sum = 0.f;
#pragma unroll
        for (int t = 0; t < 8; ++t)
#pragma unroll
            for (int i = 0; i < 16; ++i) { const float e = __expf(sacc[t][i] - mx); sacc[t][i] = e; sum += e; }
        sum = swap32_sum(sum, sum);
        const float inv = 1.0f / sum;
        bf16x8 pf[8][2];
#pragma unroll
        for (int t = 0; t < 8; ++t) { pf[t][0] = pack8(sacc[t], 0); pf[t][1] = pack8(sacc[t], 1); }
        __builtin_amdgcn_sched_barrier(0);
        XA_LOAD(st, VT + (size_t)(b * 4 + hd) * 256 * 256, 512);
        __syncthreads();
        XA_STORE(st);
        __syncthreads();
        if (unit + nb < NU) { const int u2 = unit + nb, b2 = u2 >> 5, hd2 = (u2 >> 3) & 3; XA_LOAD(st, KV + (size_t)(b2 * NMEM) * 2048 + hd2 * 256, 4096); }
        const LASX unsigned char* vl = lds + r * XA_PITCH + hh * 8;
        GAS unsigned char* op = XO + (size_t)(tok0 + r) * D + hd * 256 + 4 * hh;
#pragma unroll 1
        for (int dt = 0; dt < 8; ++dt) {
            f32x16 acc;
#pragma unroll
            for (int i = 0; i < 16; ++i) acc[i] = 0.f;
#pragma unroll
            for (int t = 0; t < 8; ++t)
#pragma unroll
                for (int s2 = 0; s2 < 2; ++s2) {
                    const u32x2 lo = *(const LASX u32x2*)(vl + dt * 32 * XA_PITCH + (32 * t + 16 * s2) * 2), hi = *(const LASX u32x2*)(vl + dt * 32 * XA_PITCH + (32 * t + 16 * s2) * 2 + 16);
                    u32x4 a4; a4.x = lo.x; a4.y = lo.y; a4.z = hi.x; a4.w = hi.y;
                    acc = MFMA32(__builtin_bit_cast(bf16x8, a4), pf[t][s2], acc);
                }
#pragma unroll
            for (int g = 0; g < 4; ++g) {
                *(GAS unsigned*)(op + dt * 32 + 8 * g) = pk4_fp8(acc[4 * g], acc[4 * g + 1], acc[4 * g + 2], acc[4 * g + 3], inv * 16.f);
            }
        }
        __syncthreads();
    }
}

typedef __attribute__((address_space(3))) int* lds_iptr;
#define TK_CE(a, b) do { const float hi_ = __builtin_fmaxf(a, b); b = __builtin_fminf(a, b); a = hi_; } while (0)
__device__ __forceinline__ void tk_sort16(float (&a)[16]) {
#pragma unroll
    for (int k = 2; k <= 16; k <<= 1)
#pragma unroll
        for (int j = k >> 1; j > 0; j >>= 1)
#pragma unroll
            for (int i = 0; i < 16; ++i) { const int l = i ^ j; if (l > i) { if ((i & k) == 0) TK_CE(a[i], a[l]); else TK_CE(a[l], a[i]); } }
}
__device__ __forceinline__ void tk_merge16(float (&L)[16], const float (&G)[16]) {
#pragma unroll
    for (int i = 0; i < 16; ++i) L[i] = __builtin_fmaxf(L[i], G[15 - i]);
#pragma unroll
    for (int j = 8; j > 0; j >>= 1)
#pragma unroll
        for (int i = 0; i < 16; ++i) { const int l = i ^ j; if (l > i) TK_CE(L[i], L[l]); }
}
__device__ __forceinline__ void ph_peer_score(const P& p, int bid, int nb, lds_fptr ldsf, int own = 0) {
    const int tid = get_tid(), lane = tid & 63, wid = __builtin_amdgcn_readfirstlane(tid >> 6), fr = lane & 15, fq = lane >> 4;
    GAS unsigned char* wsg = (GAS unsigned char*)p.ws;
    const GAS bf16_t* PQ = (const GAS bf16_t*)(wsg + WS_PQ); const GAS bf16_t* KEYS = (const GAS bf16_t*)(wsg + WS_KEYS);
    GAS int* PIDX = (GAS int*)(wsg + WS_PIDX); GAS float* PG = (GAS float*)(wsg + WS_PG);
    const lds_fptr sc = ldsf + wid * (64 * 68);
    const int gw = bid * 8 + wid, ngw = nb * 8;
#pragma unroll 1
    for (int task = gw; task < (T / 64) * 8; task += ngw) {
        int tok0 = (task >> 3) * 64, h = task & 7;
        if (own) { const int pm = 8 * (bid & 7) + ((bid >> 3) & 7); tok0 = (4 * pm + (wid & 3)) * 64; h = (bid >> 6) + 4 * (wid >> 2); }
        float L1[16], L2[16];
#pragma unroll
        for (int i = 0; i < 16; ++i) { L1[i] = -3.0e38f; L2[i] = -3.0e38f; }
        bf16x8 qf[4][4], kfa[4][4];
#define PS_LOADQ(pp_) do { _Pragma("unroll") for (int mt_ = 0; mt_ < 4; ++mt_) _Pragma("unroll") for (int ks_ = 0; ks_ < 4; ++ks_) \
            qf[mt_][ks_] = *(const GAS bf16x8*)(PQ + (size_t)(tok0 + 16 * mt_ + fr) * PQW + h * 256 + (pp_) * 128 + 32 * ks_ + 8 * fq); } while (0)
#define PS_LOADK(it_) do { const GAS bf16_t* kp_ = KEYS + ((size_t)h * 256 + (it_) * 64 + fr) * 128 + 8 * fq; _Pragma("unroll") for (int nt_ = 0; nt_ < 4; ++nt_) _Pragma("unroll") for (int ks_ = 0; ks_ < 4; ++ks_) \
            kfa[nt_][ks_] = *(const GAS bf16x8*)(kp_ + (size_t)nt_ * 16 * 128 + 32 * ks_); } while (0)
        PS_LOADQ(0); PS_LOADK(0);
        float Lr[16];
#pragma unroll
        for (int i = 0; i < 16; ++i) Lr[i] = -3.0e38f;
#pragma unroll 1
        for (int it = 0; it < 4; ++it) {
            const int half = it & 1;
#pragma unroll
            for (int nt = 0; nt < 4; ++nt) {
#pragma unroll
                for (int mt = 0; mt < 4; ++mt) {
                    f32x4 acc = (f32x4){0.f, 0.f, 0.f, 0.f};
#pragma unroll
                    for (int ks = 0; ks < 4; ++ks) acc = MFMA16(kfa[nt][ks], qf[mt][ks], acc);
                    *(__attribute__((address_space(3))) f32x4*)(sc + (16 * mt + fr) * 68 + 16 * nt + 4 * fq) = acc;
                }
            }
            __builtin_amdgcn_sched_barrier(0);
            if (it == 1) PS_LOADQ(1);
            if (it < 3) PS_LOADK(it + 1);
            __builtin_amdgcn_sched_barrier(0);
#pragma unroll
            for (int grp = 0; grp < 4; ++grp) {
                float G[16];
#pragma unroll
                for (int k4 = 0; k4 < 4; ++k4) {
                    const f32x4 v = *(const __attribute__((address_space(3))) f32x4*)(sc + lane * 68 + 16 * grp + 4 * k4);
#pragma unroll
                    for (int r = 0; r < 4; ++r) G[4 * k4 + r] = __uint_as_float((__float_as_uint(v[r]) & 0xffffff80u) | (unsigned)(half * 64 + 16 * grp + 4 * k4 + r));
                }
                tk_sort16(G);
                tk_merge16(Lr, G);
            }
            if (it == 1) {
#pragma unroll
                for (int i = 0; i < 16; ++i) { L1[i] = Lr[i]; Lr[i] = -3.0e38f; }
            }
        }
#pragma unroll
        for (int i = 0; i < 16; ++i) L2[i] = Lr[i];
#undef PS_LOADQ
#undef PS_LOADK
        const lds_iptr li = (lds_iptr)sc + lane * 33;
#pragma unroll
        for (int i = 0; i < 16; ++i) { li[i] = (int)(__float_as_uint(L1[i]) & 127u); li[16 + i] = (int)(__float_as_uint(L2[i]) & 127u); }
        float C[16];
        {
            float G[4][16];
#pragma unroll
            for (int a = 0; a < 4; ++a)
#pragma unroll
                for (int i = 0; i < 16; ++i) G[a][i] = -3.0e38f;
            int cnt = 0;
#pragma unroll
            for (int i = 0; i < 16; ++i)
#pragma unroll
                for (int j = 0; j < 16; ++j)
                    if ((i + 1) * (j + 1) <= 16) { const float sm = L1[i] + L2[j]; G[cnt >> 4][cnt & 15] = __uint_as_float((__float_as_uint(sm) & 0xffffff00u) | (unsigned)(i * 16 + j)); ++cnt; }
            tk_sort16(G[0]); tk_sort16(G[1]); tk_sort16(G[2]); tk_sort16(G[3]);
            tk_merge16(G[0], G[1]); tk_merge16(G[2], G[3]); tk_merge16(G[0], G[2]);
#pragma unroll
            for (int i = 0; i < 16; ++i) C[i] = G[0][i];
        }
        float e[16], es = 0.f;
#pragma unroll
        for (int k = 0; k < 16; ++k) { e[k] = __expf(C[k] - C[0]); es += e[k]; }
        const float inv = 1.0f / es;
        int ex[16];
#pragma unroll
        for (int k = 0; k < 16; ++k) { const unsigned ci = __float_as_uint(C[k]) & 255u; ex[k] = li[ci >> 4] * 128 + li[16 + (ci & 15)]; }
        GAS int* pi = PIDX + (size_t)(tok0 + lane) * 128 + h * 16; GAS float* pgp = PG + (size_t)(tok0 + lane) * 128 + h * 16;
#pragma unroll
        for (int k4 = 0; k4 < 4; ++k4) {
            typedef int i32x4 __attribute__((ext_vector_type(4)));
            i32x4 iv; iv.x = ex[4 * k4]; iv.y = ex[4 * k4 + 1]; iv.z = ex[4 * k4 + 2]; iv.w = ex[4 * k4 + 3];
            f32x4 gv; gv.x = e[4 * k4] * inv; gv.y = e[4 * k4 + 1] * inv; gv.z = e[4 * k4 + 2] * inv; gv.w = e[4 * k4 + 3] * inv;
            *(GAS i32x4*)(pi + 4 * k4) = iv; *(GAS f32x4*)(pgp + 4 * k4) = gv;
        }
    }
}
#define PG_CVT(f, q) do { const f32x2_t a_ = __builtin_amdgcn_cvt_pk_f32_fp8((int)(q).x, false), b_ = __builtin_amdgcn_cvt_pk_f32_fp8((int)(q).x, true), c_ = __builtin_amdgcn_cvt_pk_f32_fp8((int)(q).y, false), d_ = __builtin_amdgcn_cvt_pk_f32_fp8((int)(q).y, true), \
        e_ = __builtin_amdgcn_cvt_pk_f32_fp8((int)(q).z, false), f_ = __builtin_amdgcn_cvt_pk_f32_fp8((int)(q).z, true), g_ = __builtin_amdgcn_cvt_pk_f32_fp8((int)(q).w, false), h_ = __builtin_amdgcn_cvt_pk_f32_fp8((int)(q).w, true); \
        f[0] = a_[0]; f[1] = a_[1]; f[2] = b_[0]; f[3] = b_[1]; f[4] = c_[0]; f[5] = c_[1]; f[6] = d_[0]; f[7] = d_[1]; f[8] = e_[0]; f[9] = e_[1]; f[10] = f_[0]; f[11] = f_[1]; f[12] = g_[0]; f[13] = g_[1]; f[14] = h_[0]; f[15] = h_[1]; } while (0)
#define U2_ISSUE(buf, slot) do { _Pragma("unroll") for (int i_ = 0; i_ < 16; ++i_) { const unsigned e_ = *(const LASX unsigned*)(tab + (slot) * 512 + ((i_ & 7) * 8 + 64 * (i_ >> 3)) * 4 + g * 4); \
        buf[i_] = *(const GAS u32x4*)(Ux + (size_t)e_ * 1024u); } } while (0)
#define U2_TAB(slot, ilo, ihi) do { *(LASX unsigned*)(tab + (slot) * 512 + lane * 4) = (unsigned)(ilo); *(LASX unsigned*)(tab + (slot) * 512 + 256 + lane * 4) = (unsigned)(ihi); } while (0)
constexpr int U4_PITCH = 144, U4_IMG = 128 * U4_PITCH, U4_TABS = 8 * U4_IMG;
#define U4_STAGE(buf) do { _Pragma("unroll") for (int i_ = 0; i_ < 16; ++i_) *(LASX u32x4*)(img + ((i_ & 7) * 8 + 64 * (i_ >> 3) + g) * U4_PITCH + 16 * j) = buf[i_]; } while (0)
#define U3_META(ilo, ihi, xr, t_) do { const size_t o_ = (size_t)(t_) * 128 + lane; ilo = PIDX[o_]; ihi = PIDX[o_ + 64]; const GAS u32x4* xp_ = (const GAS u32x4*)(HB + (size_t)(t_) * D + x * 128 + kq * 32); \
        xr[0] = xp_[0]; xr[1] = xp_[1]; xr[2] = xp_[2]; xr[3] = xp_[3]; } while (0)
#define U3_Q(v_) __builtin_amdgcn_fmed3f((v_) * 16.f, -448.f, 448.f)
#define U3_X8(x8, xr) do { _Pragma("unroll") for (int q_ = 0; q_ < 4; ++q_) { \
        x8[2 * q_] = (unsigned)__builtin_amdgcn_cvt_pk_fp8_f32(U3_Q(bflo(xr[q_].y)), U3_Q(bfhi(xr[q_].y)), __builtin_amdgcn_cvt_pk_fp8_f32(U3_Q(bflo(xr[q_].x)), U3_Q(bfhi(xr[q_].x)), 0, false), true); \
        x8[2 * q_ + 1] = (unsigned)__builtin_amdgcn_cvt_pk_fp8_f32(U3_Q(bflo(xr[q_].w)), U3_Q(bfhi(xr[q_].w)), __builtin_amdgcn_cvt_pk_fp8_f32(U3_Q(bflo(xr[q_].z)), U3_Q(bfhi(xr[q_].z)), 0, false), true); } } while (0)
#define U3_L64(lo_, hi_) ((long)(((unsigned long long)(hi_) << 32) | (unsigned long long)(lo_)))
#define U4_DOT(x8, t_tok) do { f32x4 mine_ = (f32x4){0.f, 0.f, 0.f, 0.f}; _Pragma("unroll") for (int t_ = 0; t_ < 8; ++t_) { f32x4 acc_ = (f32x4){0.f, 0.f, 0.f, 0.f}; \
        const u32x4 r0_ = *(const LASX u32x4*)(img + (16 * t_ + i16) * U4_PITCH + 32 * kq), r1_ = *(const LASX u32x4*)(img + (16 * t_ + i16) * U4_PITCH + 32 * kq + 16); \
        acc_ = __builtin_amdgcn_mfma_f32_16x16x32_fp8_fp8(U3_L64(r0_.x, r0_.y), U3_L64(x8[0], x8[1]), acc_, 0, 0, 0); \
        acc_ = __builtin_amdgcn_mfma_f32_16x16x32_fp8_fp8(U3_L64(r0_.z, r0_.w), U3_L64(x8[2], x8[3]), acc_, 0, 0, 0); \
        acc_ = __builtin_amdgcn_mfma_f32_16x16x32_fp8_fp8(U3_L64(r1_.x, r1_.y), U3_L64(x8[4], x8[5]), acc_, 0, 0, 0); \
        acc_ = __builtin_amdgcn_mfma_f32_16x16x32_fp8_fp8(U3_L64(r1_.z, r1_.w), U3_L64(x8[6], x8[7]), acc_, 0, 0, 0); \
        if (i16 == t_) mine_ = acc_; } \
        if (i16 < 8) { u32x2 pw_; pw_.x = pk2(mine_[0], mine_[1]); pw_.y = pk2(mine_[2], mine_[3]); *(GAS u32x2*)(PD + ((size_t)x * T + (t_tok)) * 128 + 16 * i16 + 4 * kq) = pw_; } } while (0)
__device__ __forceinline__ void ph_peer_u4(const P& p, int bid, int nb, LASX unsigned char* ldsb) {
    const int tid = get_tid(), lane = tid & 63, wid = __builtin_amdgcn_readfirstlane(tid >> 6), g = lane >> 3, j = lane & 7, i16 = lane & 15, kq = lane >> 4;
    GAS unsigned char* wsg = (GAS unsigned char*)p.ws;
    const int x = bid & 7, nsl = nb >> 3;
    const GAS unsigned char* Ux = (const GAS unsigned char*)(wsg + WS_U) + x * 128 + j * 16;
    const GAS int* PIDX = (const GAS int*)(wsg + WS_PIDX); const GAS bf16_t* HB = (const GAS bf16_t*)(wsg + WS_HB); GAS bf16_t* PD = (GAS bf16_t*)(wsg + WS_PD);
    const int wv = (bid >> 3) * 8 + wid, nwv = nsl * 8;
    LASX unsigned char* img = ldsb + wid * U4_IMG;
    LASX unsigned char* tab = ldsb + U4_TABS + wid * 1024;
    int iloA, ihiA, iloB, ihiB; u32x4 xA[4], xB[4];
    u32x4 bA[16], bB[16];
    const int t0 = wv;
    if (t0 < T) { U3_META(iloA, ihiA, xA, t0); U2_TAB(0, iloA, ihiA); U2_ISSUE(bA, 0); }
    if (t0 + nwv < T) U3_META(iloB, ihiB, xB, t0 + nwv);
#pragma unroll 1
    for (int t = t0; t < T; t += 2 * nwv) {
        const int t1 = t + nwv, t2 = t + 2 * nwv, t3 = t + 3 * nwv;
        if (t1 < T) { U2_TAB(1, iloB, ihiB); U2_ISSUE(bB, 1); }
        { U4_STAGE(bA); unsigned x8[8]; U3_X8(x8, xA); U4_DOT(x8, t); }
        if (t2 < T) U3_META(iloA, ihiA, xA, t2);
        if (t1 < T) {
            if (t2 < T) { U2_TAB(0, iloA, ihiA); U2_ISSUE(bA, 0); }
            { U4_STAGE(bB); unsigned x8[8]; U3_X8(x8, xB); U4_DOT(x8, t1); }
            if (t3 < T) U3_META(iloB, ihiB, xB, t3);
        }
    }
}
__device__ __forceinline__ void ph_peer_w(const P& p, int bid, int nb) {
    const int tid = get_tid(), lane = tid & 63, wid = __builtin_amdgcn_readfirstlane(tid >> 6);
    GAS unsigned char* wsg = (GAS unsigned char*)p.ws;
    const GAS float* SSQ = (const GAS float*)(wsg + WS_SSQ); const GAS float* USC = (const GAS float*)(wsg + WS_USC); const GAS float* VSC = (const GAS float*)(wsg + WS_VSC);
    const GAS int* PIDX = (const GAS int*)(wsg + WS_PIDX); GAS float* PG = (GAS float*)(wsg + WS_PG); const GAS bf16_t* PD = (const GAS bf16_t*)(wsg + WS_PD);
#pragma unroll 2
    for (int tok = bid * 8 + wid; tok < T; tok += nb * 8) {
        const size_t o = (size_t)tok * 128 + lane;
        const int idx_lo = PIDX[o], idx_hi = PIDX[o + 64];
        float a0 = 0.f, a1 = 0.f;
#pragma unroll
        for (int xs = 0; xs < 8; ++xs) { a0 += bf2f(PD[(size_t)xs * T * 128 + o]); a1 += bf2f(PD[(size_t)xs * T * 128 + o + 64]); }
        const float g_lo = PG[o], g_hi = PG[o + 64];
        const float us_lo = USC[idx_lo], us_hi = USC[idx_hi], vs_lo = VSC[idx_lo], vs_hi = VSC[idx_hi];
        const float rs = rsqrtf(wave_sum2(lane < 16 ? SSQ[(size_t)tok * 16 + lane] : 0.f) * (1.0f / D) + 1e-6f);
        a0 *= us_lo * rs * 0.0625f; a1 *= us_hi * rs * 0.0625f;
        PG[o] = g_lo * vs_lo * 0.5f * a0 * (1.0f + erff(a0 * 0.70710678118654752f));
        PG[o + 64] = g_hi * vs_hi * 0.5f * a1 * (1.0f + erff(a1 * 0.70710678118654752f));
    }
}
#define V2_META(ilo, ihi, wlo, whi, hw, t_) do { const size_t o_ = (size_t)(t_) * 128 + lane; ilo = PIDX[o_]; ihi = PIDX[o_ + 64]; wlo = PW[o_]; whi = PW[o_ + 64]; hw = *(const GAS unsigned*)(HBW + (size_t)(t_) * D + col); } while (0)
#define V2_TAB(slot, ilo, ihi, wlo, whi) do { *(LASX u32x2*)(tab + (slot) * 1024 + lane * 8) = (u32x2){(unsigned)(ilo), __float_as_uint(wlo)}; *(LASX u32x2*)(tab + (slot) * 1024 + 512 + lane * 8) = (u32x2){(unsigned)(ihi), __float_as_uint(whi)}; } while (0)
#define V2_ISSUE(buf, slot) do { _Pragma("unroll") for (int i_ = 0; i_ < 16; ++i_) { const unsigned e_ = *(const LASX unsigned*)(tab + (slot) * 1024 + ((i_ & 7) * 8 + 64 * (i_ >> 3)) * 8 + g * 8); \
        buf[i_] = *(const GAS u32x4*)(Vx + (size_t)e_ * 1024u); } } while (0)
#define V2_PKF(k_, word_, hi_) do { const f32x2_t c_ = __builtin_amdgcn_cvt_pk_f32_fp8((int)(word_), hi_); asm("v_pk_fma_f32 %0, %1, %2, %0" : "+v"(o2[k_]) : "v"(c_), "v"(w2_)); } while (0)
#define V2_ACC(buf, slot) do { _Pragma("unroll") for (int i_ = 0; i_ < 16; ++i_) { const float w_ = *(const LASX float*)(tab + (slot) * 1024 + ((i_ & 7) * 8 + 64 * (i_ >> 3)) * 8 + g * 8 + 4); \
        f32x2_t w2_; w2_[0] = w_; w2_[1] = w_; const u32x4 q_ = buf[i_]; \
        V2_PKF(0, q_.x, false); V2_PKF(1, q_.x, true); V2_PKF(2, q_.y, false); V2_PKF(3, q_.y, true); V2_PKF(4, q_.z, false); V2_PKF(5, q_.z, true); V2_PKF(6, q_.w, false); V2_PKF(7, q_.w, true); } } while (0)
#define V2_FINISH(t_, hwreg) do { float r8_[8], r4_[4]; \
        _Pragma("unroll") for (int i_ = 0; i_ < 8; ++i_) r8_[i_] = swap32_sum(o2[i_ >> 1][i_ & 1], o2[(i_ + 8) >> 1][i_ & 1]); \
        _Pragma("unroll") for (int i_ = 0; i_ < 4; ++i_) r4_[i_] = swap16_sum(r8_[i_], r8_[i_ + 4]); \
        const float c0_ = (h8 ? r4_[2] : r4_[0]) + dppf<0x128>(h8 ? r4_[0] : r4_[2]), c1_ = (h8 ? r4_[3] : r4_[1]) + dppf<0x128>(h8 ? r4_[1] : r4_[3]); \
        GAS unsigned* hp_ = (GAS unsigned*)(HBW + (size_t)(t_) * D + col); const unsigned hw_ = (hwreg); const unsigned nw_ = pk2(bflo(hw_) + c0_, bfhi(hw_) + c1_); *hp_ = nw_; \
        const float n0_ = bflo(nw_), n1_ = bfhi(nw_); \
        *(GAS unsigned short*)(HB8W + (size_t)(t_) * D + col) = (unsigned short)__builtin_amdgcn_cvt_pk_fp8_f32(q8c(n0_, 16.f), q8c(n1_, 16.f), 0, false); \
        const float ss_ = wave_sum2(n0_ * n0_ + n1_ * n1_); if (lane < 2) SSQW[(size_t)(t_) * 16 + x + 8 * lane] = lane == 0 ? ss_ : 0.f; \
        _Pragma("unroll") for (int i_ = 0; i_ < 8; ++i_) { o2[i_][0] = 0.f; o2[i_][1] = 0.f; } } while (0)
__device__ __forceinline__ void ph_peer_v(const P& p, int bid, int nb, LASX unsigned char* ldsb) {
    const int tid = get_tid(), lane = tid & 63, wid = __builtin_amdgcn_readfirstlane(tid >> 6), g = lane >> 3, j = lane & 7;
    GAS unsigned char* wsg = (GAS unsigned char*)p.ws;
    const int x = bid & 7, nsl = nb >> 3;
    const GAS unsigned char* Vx = (const GAS unsigned char*)(wsg + WS_V) + x * 128 + j * 16;
    const GAS int* PIDX = (const GAS int*)(wsg + WS_PIDX); const GAS float* PW = (const GAS float*)(wsg + WS_PG);
    GAS bf16_t* HBW = (GAS bf16_t*)(wsg + WS_HB); GAS float* SSQW = (GAS float*)(wsg + WS_SSQ); GAS unsigned char* HB8W = wsg + WS_HB8;
    const bool h32 = (lane & 32) != 0, h16 = (lane & 16) != 0, h8 = (lane & 8) != 0;
    const int col = x * 128 + j * 16 + (h32 ? 8 : 0) + (h16 ? 4 : 0) + (h8 ? 2 : 0);
    const int wv = (bid >> 3) * 8 + wid, nwv = nsl * 8;
    LASX unsigned char* tab = ldsb + wid * 2048;
    f32x2_t o2[8];
#pragma unroll
    for (int i = 0; i < 8; ++i) { o2[i][0] = 0.f; o2[i][1] = 0.f; }
    int iloA, ihiA, iloB, ihiB; float wloA, whiA, wloB, whiB; unsigned hwA = 0u, hwB = 0u, hwC = 0u;
    u32x4 bA[16], bB[16];
    const int t0 = wv;
    if (t0 < T) { V2_META(iloA, ihiA, wloA, whiA, hwA, t0); V2_TAB(0, iloA, ihiA, wloA, whiA); V2_ISSUE(bA, 0); }
    if (t0 + nwv < T) V2_META(iloB, ihiB, wloB, whiB, hwB, t0 + nwv);
#pragma unroll 1
    for (int t = t0; t < T; t += 2 * nwv) {
        const int t1 = t + nwv, t2 = t + 2 * nwv, t3 = t + 3 * nwv;
        if (t1 < T) { V2_TAB(1, iloB, ihiB, wloB, whiB); V2_ISSUE(bB, 1); }
        V2_ACC(bA, 0);
        hwC = hwA;
        if (t2 < T) V2_META(iloA, ihiA, wloA, whiA, hwA, t2);
        V2_FINISH(t, hwC);
        if (t1 < T) {
            if (t2 < T) { V2_TAB(0, iloA, ihiA, wloA, whiA); V2_ISSUE(bA, 0); }
            V2_ACC(bB, 1);
            hwC = hwB;
            if (t3 < T) V2_META(iloB, ihiB, wloB, whiB, hwB, t3);
            V2_FINISH(t1, hwC);
        }
    }
}
__device__ __forceinline__ void ph_final_norm(const P& p, int bid, int nb) {
    const int tid = get_tid(), lane = tid & 63, wid = __builtin_amdgcn_readfirstlane(tid >> 6);
    GAS float* outg = (GAS float*)p.out; const GAS f32x4* fg = (const GAS f32x4*)p.final_g; const GAS float* SSQ = (const GAS float*)(p.ws + WS_SSQ);
    const GAS bf16_t* HB = (const GAS bf16_t*)(p.ws + WS_HB);
    const f32x4 g0 = fg[2 * lane], g1 = fg[2 * lane + 1], g2 = fg[128 + 2 * lane], g3 = fg[128 + 2 * lane + 1];
#pragma unroll 1
    for (int r = bid * 8 + wid; r < T; r += nb * 8) {
        const GAS u32x4* hr = (const GAS u32x4*)(HB + (size_t)r * D);
        const u32x4 w0 = hr[lane], w1 = hr[lane + 64];
        const float rs = rsqrtf(wave_sum(lane < 16 ? SSQ[(size_t)r * 16 + lane] : 0.f, lane) * (1.0f / D) + 1e-6f);
        GAS f32x4* o = (GAS f32x4*)(outg + (size_t)r * D);
        o[2 * lane] = (f32x4){bflo(w0.x), bfhi(w0.x), bflo(w0.y), bfhi(w0.y)} * rs * g0; o[2 * lane + 1] = (f32x4){bflo(w0.z), bfhi(w0.z), bflo(w0.w), bfhi(w0.w)} * rs * g1;
        o[128 + 2 * lane] = (f32x4){bflo(w1.x), bfhi(w1.x), bflo(w1.y), bfhi(w1.y)} * rs * g2; o[128 + 2 * lane + 1] = (f32x4){bflo(w1.z), bfhi(w1.z), bflo(w1.w), bfhi(w1.w)} * rs * g3;
    }
}

#define LAS __attribute__((address_space(3)))
#define XB_TMO      128
#define XB_XCNT(j)  (256  + 64 * (j))
#define XB_XSUB(j)  (1280 + 64 * (j))
#define XB_XGEN(j)  (2304 + 64 * (j))
#define XB_TOP      3328
#define XB_TOPGEN   3392
#define XCD_BAR_WORDS 3456
#define XB_SPIN_CAP (1u << 18)

__device__ __forceinline__ unsigned xb_ld(unsigned* p)              { return __hip_atomic_load(p, __ATOMIC_RELAXED, __HIP_MEMORY_SCOPE_AGENT); }
__device__ __forceinline__ unsigned xb_add(unsigned* p, unsigned v) { return __hip_atomic_fetch_add(p, v, __ATOMIC_RELAXED, __HIP_MEMORY_SCOPE_AGENT); }
__device__ __forceinline__ unsigned xb_xcc_id() { return (unsigned)__builtin_amdgcn_s_getreg((3 << 11) | 20) & 0xFu; }
#define XB_SPIN(cond, bar) do { unsigned _sp = 0; while (cond) { __builtin_amdgcn_s_sleep(1); \
    if ((++_sp & 255u) == 0u) { if (xb_ld(&(bar)[XB_TMO])) break; if (_sp > XB_SPIN_CAP) { atomicAdd(&(bar)[XB_TMO], 1u); break; } } } } while (0)

struct XcdBarrier {
    unsigned* bar; unsigned x;
    volatile LAS unsigned* st;
};

__device__ __forceinline__ XcdBarrier xcd_barrier_post(unsigned* bar, volatile LAS unsigned* st) {
    XcdBarrier b; b.bar = bar; b.x = xb_xcc_id(); b.st = st;
    if (get_tid() == 0) (void)xb_add(&bar[XB_XCNT(b.x)], 1u);
    return b;
}
__device__ __forceinline__ void xcd_barrier_complete(unsigned* bar, unsigned x, unsigned& nloc, unsigned& nx) {
    const unsigned G = gridDim.x * gridDim.y * gridDim.z;
    unsigned sum, cnt, mine, sp = 0u;
    for (;;) {
        sum = 0u; cnt = 0u; mine = 0u;
#pragma unroll
        for (unsigned j = 0; j < 16; ++j) { const unsigned c = xb_ld(&bar[XB_XCNT(j)]); sum += c; cnt += (c > 0u) ? 1u : 0u; mine = (j == x) ? c : mine; }
        if (sum == G) break;
        __builtin_amdgcn_s_sleep(1);
        if ((++sp & 255u) == 0u) { if (xb_ld(&bar[XB_TMO])) break; if (sp > XB_SPIN_CAP) { atomicAdd(&bar[XB_TMO], 1u); break; } }
    }
    nloc = mine > 0u ? mine : 1u; nx = cnt > 0u ? cnt : 1u;
}

__device__ __forceinline__ void xcd_barrier(const XcdBarrier& b) {
    asm volatile("s_waitcnt vmcnt(0)" ::: "memory");
    __syncthreads();
    if (get_tid() == 0) {
        unsigned* bar = b.bar;
        __builtin_amdgcn_s_waitcnt(0);
        unsigned nloc = b.st[0], nx = b.st[1];
        if (nloc == 0u) { xcd_barrier_complete(bar, b.x, nloc, nx); b.st[0] = nloc; b.st[1] = nx; }
        const unsigned old = xb_add(&bar[XB_XSUB(b.x)], 1u);
        const unsigned gen = old / nloc;
        if (old + 1u == (gen + 1u) * nloc) {
            __builtin_amdgcn_fence(__ATOMIC_RELEASE, "agent");
            asm volatile("s_waitcnt vmcnt(0)" ::: "memory");
            const unsigned og = xb_add(&bar[XB_TOP], 1u);
            const unsigned tg = og / nx;
            if (og + 1u == (tg + 1u) * nx) xb_add(&bar[XB_TOPGEN], 1u);
            else XB_SPIN(xb_ld(&bar[XB_TOPGEN]) == tg, bar);
            __builtin_amdgcn_fence(__ATOMIC_ACQUIRE, "agent");
            xb_add(&bar[XB_XGEN(b.x)], 1u);
            asm volatile("s_waitcnt vmcnt(0)" ::: "memory");
        } else {
            XB_SPIN(xb_ld(&bar[XB_XGEN(b.x)]) == gen, bar);
            __builtin_amdgcn_fence(__ATOMIC_ACQUIRE, "agent");
            asm volatile("s_waitcnt vmcnt(0)" ::: "memory");
        }
    }
    __syncthreads();
}

namespace cg = cooperative_groups;
__global__ void __launch_bounds__(NT, 2) mega_fwd(P p) {
    float* lds = (float*)smem;
    const lds_ptr ldsr = (lds_ptr)smem;
    const int bid = blockIdx.x, nb = gridDim.x;
    volatile LAS unsigned* MISC = (volatile LAS unsigned*)((LAS unsigned char*)smem + LDS_BYTES - 64);
    if (threadIdx.x < 2) MISC[threadIdx.x] = 0u;
    if ((threadIdx.x & 63) == 0) ((LAS int*)((LAS unsigned char*)smem + LDS_WTAB))[__builtin_amdgcn_s_getreg((5 << 11) | 4)] = (int)(threadIdx.x >> 6);
    __syncthreads();
    const XcdBarrier bar = xcd_barrier_post((unsigned*)(p.ws + WS_CTL), MISC);
#define GSYNC() xcd_barrier(bar)
#ifndef PROBE_A
#define PROBE_A -1
#endif
#ifndef PROBE_P
#define PROBE_P (PROBE_A - 1)
#endif
    unsigned long long* ts = (unsigned long long*)(p.ws + 512 * 1024);
#define STAMP(cat) do { if (PROBE_A >= 0 && bid == 0) ts[l * 16 + (cat)] = __builtin_amdgcn_s_memrealtime(); } while (0)
#define PH(call) do { const __attribute__((address_space(4))) unsigned long long* kp_ = (const __attribute__((address_space(4))) unsigned long long*)__builtin_amdgcn_kernarg_segment_ptr(); asm volatile("" : "+s"(kp_) :: "memory"); \
        P q; { unsigned long long* d_ = (unsigned long long*)&q; _Pragma("unroll") for (int i_ = 0; i_ < (int)(sizeof(P) / 8); ++i_) d_[i_] = kp_[i_]; } call; } while (0)
    if (PROBE_A >= 0 && bid == 0) ts[40] = __builtin_amdgcn_s_memrealtime();

#ifndef NO_ph_prologue
        PH(ph_prologue(q, bid, nb));
#endif

    { constexpr int l = 0;

        { int g0_ = bid, n0_ = nb; asm volatile("" : "+s"(g0_), "+s"(n0_)); PH(ph_prep_weights(q, l, g0_, n0_, (lds_fptr)smem, 0)); }
        GSYNC(); STAMP(0);
#pragma unroll 1
        for (int s2 = 0; s2 < 2; ++s2) {
            int g_ = bid; asm volatile("" : "+s"(g_));
            int n_ = nb; asm volatile("" : "+s"(n_));
            if ((s2 == 0) == (((g_ >> 3) & 1) == 0)) { PH(ph_prep_weights(q, l, g_, n_, (lds_fptr)smem, 1)); __syncthreads(); }
            else { PH(ph_gemm_p(q, l, bid, nb, ldsr)); if (l == 0) PH(ph_gemm_kv(q, bid, nb, ldsr)); }
        }
        GSYNC(); STAMP(1);

#pragma unroll 1
        for (int s2 = 0; s2 < 2; ++s2) {
            if ((s2 == 0) == (((bid >> 3) & 1) != 0)) { PH(ph_conv(q, l, bid, nb, (LASX unsigned char*)smem)); }
            else { PH(ph_sb_attn(q, bid, nb, (__attribute__((address_space(3))) unsigned char*)smem)); }
        }
        GSYNC(); STAMP(2);

#ifndef NO_ph_merged
        PH(ph_merged(q, l, bid, nb, ldsr));
#endif
        GSYNC(); STAMP(3);

#ifndef NO_ph_gemm_wout
        PH(ph_gemm_wout(q, bid, nb, ldsr));
#endif
        GSYNC(); STAMP(4);

#ifndef NO_ph_gemm_xq
        PH(ph_gemm_xq(q, bid, nb, ldsr));
#endif
        if (nb == 256) { asm volatile("s_waitcnt vmcnt(0)" ::: "memory"); __syncthreads(); } else { GSYNC(); }
        STAMP(5);
#ifndef NO_ph_xattn
        PH(ph_xattn(q, l, nb == 256 ? xq_unit(bid, nb) : bid, nb, (LASX unsigned char*)smem));
#endif
        GSYNC(); STAMP(6);

#ifndef NO_ph_gemm_wo
        PH(ph_gemm_wo(q, bid, nb, ldsr));
#endif
        GSYNC(); STAMP(7);

#ifndef NO_ph_gemm_pq
        PH(ph_gemm_pq(q, bid, nb, ldsr));
#endif
        if (nb == 256) { asm volatile("s_waitcnt vmcnt(0)" ::: "memory"); __syncthreads(); } else { GSYNC(); }
        STAMP(8);
#ifndef NO_ph_peer_score
        PH(ph_peer_score(q, bid, nb, (lds_fptr)smem, nb == 256 ? 1 : 0));
#endif
        GSYNC(); STAMP(9);

#ifndef NO_ph_peer_gather
        PH(ph_peer_u4(q, bid, nb, (LASX unsigned char*)smem)); GSYNC();
        PH(ph_peer_w(q, bid, nb)); GSYNC(); STAMP(12);
        PH(ph_peer_v(q, bid, nb, (LASX unsigned char*)smem));
        if (l == DEPTH - 1) { GSYNC(); PH(ph_final_norm(q, bid, nb)); }
#endif
        if (l < DEPTH - 1 || PROBE_A >= 0) GSYNC();
        STAMP(10);
    }
    { constexpr int l = 1;

        { int g0_ = bid, n0_ = nb; asm volatile("" : "+s"(g0_), "+s"(n0_)); PH(ph_prep_weights(q, l, g0_, n0_, (lds_fptr)smem, 0)); }
        GSYNC(); STAMP(0);
#pragma unroll 1
        for (int s2 = 0; s2 < 2; ++s2) {
            int g_ = bid; asm volatile("" : "+s"(g_));
            int n_ = nb; asm volatile("" : "+s"(n_));
            if ((s2 == 0) == (((g_ >> 3) & 1) == 0)) { PH(ph_prep_weights(q, l, g_, n_, (lds_fptr)smem, 1)); __syncthreads(); }
            else { PH(ph_gemm_p(q, l, bid, nb, ldsr)); if (l == 0) PH(ph_gemm_kv(q, bid, nb, ldsr)); }
        }
        GSYNC(); STAMP(1);

#pragma unroll 1
        for (int s2 = 0; s2 < 2; ++s2) {
            if ((s2 == 0) == (((bid >> 3) & 1) != 0)) { PH(ph_conv(q, l, bid, nb, (LASX unsigned char*)smem)); }
            else { PH(ph_sb_attn(q, bid, nb, (__attribute__((address_space(3))) unsigned char*)smem)); }
        }
        GSYNC(); STAMP(2);

#ifndef NO_ph_merged
        PH(ph_merged(q, l, bid, nb, ldsr));
#endif
        GSYNC(); STAMP(3);

#ifndef NO_ph_gemm_wout
        PH(ph_gemm_wout(q, bid, nb, ldsr));
#endif
        GSYNC(); STAMP(4);

#ifndef NO_ph_gemm_xq
        PH(ph_gemm_xq(q, bid, nb, ldsr));
#endif
        if (nb == 256) { asm volatile("s_waitcnt vmcnt(0)" ::: "memory"); __syncthreads(); } else { GSYNC(); }
        STAMP(5);
#ifndef NO_ph_xattn
        PH(ph_xattn(q, l, nb == 256 ? xq_unit(bid, nb) : bid, nb, (LASX unsigned char*)smem));
#endif
        GSYNC(); STAMP(6);

#ifndef NO_ph_gemm_wo
        PH(ph_gemm_wo(q, bid, nb, ldsr));
#endif
        GSYNC(); STAMP(7);

#ifndef NO_ph_gemm_pq
        PH(ph_gemm_pq(q, bid, nb, ldsr));
#endif
        if (nb == 256) { asm volatile("s_waitcnt vmcnt(0)" ::: "memory"); __syncthreads(); } else { GSYNC(); }
        STAMP(8);
#ifndef NO_ph_peer_score
        PH(ph_peer_score(q, bid, nb, (lds_fptr)smem, nb == 256 ? 1 : 0));
#endif
        GSYNC(); STAMP(9);

#ifndef NO_ph_peer_gather
        PH(ph_peer_u4(q, bid, nb, (LASX unsigned char*)smem)); GSYNC();
        PH(ph_peer_w(q, bid, nb)); GSYNC(); STAMP(12);
        PH(ph_peer_v(q, bid, nb, (LASX unsigned char*)smem));
        if (l == DEPTH - 1) { GSYNC(); PH(ph_final_norm(q, bid, nb)); }
#endif
        if (l < DEPTH - 1 || PROBE_A >= 0) GSYNC();
        STAMP(10);
    }
#if PROBE_A >= 0
    {
        __threadfence(); cg::this_grid().sync();
        if (bid == 0 && get_tid() == 0) {
            unsigned long long tot = 0;
            for (int l = 0; l < DEPTH; ++l) { const unsigned long long prev = (PROBE_P >= 0) ? ts[l * 16 + PROBE_P] : (l == 0 ? ts[40] : ts[(l - 1) * 16 + 10]); tot += ts[l * 16 + PROBE_A] - prev; }
            p.out[0] += (float)tot * 0.01f * 0.02f;
        }
    }
#endif
#undef PH
}

extern "C" void kernel_launch(void* const* d_in, const int* in_sizes, int n_in, void* d_out, int out_size, void* d_ws, size_t ws_size, hipStream_t stream) {
    static int grid = 0;
    if (grid == 0) {
        int dev = 0, cus = 0, per_cu = 0;
        hipGetDevice(&dev);
        hipDeviceGetAttribute(&cus, hipDeviceAttributeMultiprocessorCount, dev);
        hipFuncSetAttribute((const void*)mega_fwd, hipFuncAttributeMaxDynamicSharedMemorySize, LDS_BYTES);
        hipOccupancyMaxActiveBlocksPerMultiprocessor(&per_cu, (const void*)mega_fwd, NT, LDS_BYTES);
        if (per_cu < 1) per_cu = 1;
        grid = cus * per_cu;
        if (ws_size < WS_END) { fprintf(stderr, "kernel_launch: workspace too small (%zu < %zu)\n", ws_size, (size_t)WS_END); grid = -1; }
    }
    if (grid < 0) return;
    P p{};
    const float** pp = (const float**)&p;
    for (int i = 0; i < 23; ++i) pp[i] = (const float*)d_in[i];
    p.out = (float*)d_out; p.ws = (unsigned char*)d_ws;
    (void)hipMemsetAsync((char*)d_ws + WS_CTL, 0, 16384, stream);
    void* args[] = {&p};
    hipError_t e = hipLaunchCooperativeKernel((void*)mega_fwd, dim3(grid), dim3(NT), args, LDS_BYTES, stream);
    if (e != hipSuccess) fprintf(stderr, "cooperative launch failed: %s (grid %d)\n", hipGetErrorString(e), grid);
}
```
